# Optimizing an MI355X kernel written in HIP

```python
import numpy as np
import jax, jax.numpy as jnp
from jax import lax

D_MODEL = 1024
BATCH = 4
SEQ = 4096
DEPTH = 4

D_MIX = D_MODEL
D_LRU = D_MIX // 2
H_LRU = 8
LRU_BLK = D_LRU // H_LRU
CONV_W = 4
LRU_C = 8.0
D_NSA = D_MIX - D_LRU
HEAD_DIM = 64
N_HEADS = D_NSA // HEAD_DIM
N_KV = 2
GROUP = N_HEADS // N_KV
KV_W = N_KV * HEAD_DIM
CMP_LEN = 32
CMP_STRIDE = 16
CMP_HID = 256
SLC_BLK = 64
SLC_TOPK = 16
WINDOW = 512
WIN_QBLK = 128
SLC_QBLK = 64
ROPE_THETA = 10000.0
EPS = 1e-6
NEG = -1e30
FORCE_BONUS = 1e4
SCALE = HEAD_DIM ** -0.5
D_IN = 2 * D_LRU + 2 * D_NSA + 6 * KV_W + 3 * N_HEADS

kernel_name = 'hymba_griffin_nsa_hybrid'

F32 = jnp.float32


def rmsnorm(x, g):
    xf = x.astype(F32)
    y = xf * lax.rsqrt(jnp.mean(xf * xf, axis=-1, keepdims=True) + EPS)
    return (y * g.astype(F32)).astype(x.dtype)


def rope_tables(seq):
    inv = 1.0 / (ROPE_THETA ** (jnp.arange(0, HEAD_DIM, 2, dtype=F32) / HEAD_DIM))
    ang = jnp.arange(seq, dtype=F32)[:, None] * inv[None, :]
    return jnp.cos(ang), jnp.sin(ang)


def apply_rope(t, cos, sin):
    x1, x2 = jnp.split(t.astype(F32), 2, axis=-1)
    c = cos[None, :, None, :]
    s = sin[None, :, None, :]
    return jnp.concatenate([x1 * c - x2 * s, x2 * c + x1 * s], axis=-1).astype(t.dtype)


def causal_depthwise_conv(u, w, b):
    out = lax.conv_general_dilated(u, w[:, None, :].astype(u.dtype), window_strides=(1,), padding=[(CONV_W - 1, 0)], dimension_numbers=('NWC', 'WIO', 'NWC'), feature_group_count=u.shape[-1])
    return out + b


def rg_lru(u, wa, ba, wi, bi, lam):
    B, S, _ = u.shape
    uf = u.astype(F32)
    uh = uf.reshape(B, S, H_LRU, LRU_BLK)
    r = jax.nn.sigmoid(jnp.einsum('bshi,hij->bshj', uh, wa.astype(F32)).reshape(B, S, D_LRU) + ba.astype(F32))
    i = jax.nn.sigmoid(jnp.einsum('bshi,hij->bshj', uh, wi.astype(F32)).reshape(B, S, D_LRU) + bi.astype(F32))
    log_a = -LRU_C * r * jax.nn.softplus(-lam.astype(F32))
    a = jnp.exp(log_a)
    drive = jnp.sqrt(-jnp.expm1(2.0 * log_a)) * (i * uf)

    def combine(lhs, rhs):
        a1, b1 = lhs
        a2, b2 = rhs
        return a1 * a2, a2 * b1 + b2

    _, h = lax.associative_scan(combine, (a, drive), axis=1)
    return h


def compress(kv, pos, w1, w2):
    B, S, Hk, dh = kv.shape
    n_sub = S // CMP_STRIDE
    ratio = CMP_LEN // CMP_STRIDE
    nc = n_sub - ratio + 1
    sub = kv.reshape(B, n_sub, CMP_STRIDE, Hk, dh)
    blocks = jnp.concatenate([sub[:, r:r + nc] for r in range(ratio)], axis=2)
    blocks = blocks + pos[None, None, :, None, :]
    flat = jnp.moveaxis(blocks, 3, 2).reshape(B, nc, Hk, CMP_LEN * dh)
    return jax.nn.silu(flat @ w1) @ w2


def cmp_attention(q, kc, vc):
    B, S, H, dh = q.shape
    nc = kc.shape[1]
    qg = q.reshape(B, S, N_KV, GROUP, dh)
    s = jnp.einsum('bskgd,bckd->bkgsc', qg, kc, preferred_element_type=F32) * SCALE
    t = jnp.arange(S)
    blk_end = jnp.arange(nc) * CMP_STRIDE + CMP_LEN - 1
    valid = blk_end[None, :] <= t[:, None]
    s = jnp.where(valid, s, NEG)
    p = jnp.where(valid, jax.nn.softmax(s, axis=-1), 0.0)
    o = jnp.einsum('bkgsc,bckd->bskgd', p, vc.astype(F32)).reshape(B, S, H, dh)
    return o, p


def selection_indices(p_cmp, seq):
    nc = p_cmp.shape[-1]
    n_slc = seq // SLC_BLK
    c0 = np.arange(nc)[:, None] * CMP_STRIDE
    j0 = np.arange(n_slc)[None, :] * SLC_BLK
    overlap = np.clip(np.minimum(c0 + CMP_LEN, j0 + SLC_BLK) - np.maximum(c0, j0), 0, None) / CMP_LEN
    m = jnp.asarray(overlap, dtype=F32)
    p_slc = jnp.einsum('bkgsc,cj->bksj', p_cmp, m)
    cur = (jnp.arange(seq) // SLC_BLK)[:, None]
    jj = jnp.arange(n_slc)[None, :]
    forced = (jj == 0) | (jj == cur) | (jj == cur - 1)
    score = jnp.where(forced, p_slc + FORCE_BONUS, p_slc)
    score = jnp.where(jj <= cur, score, NEG)
    k = min(SLC_TOPK, n_slc)
    top_s, idx = lax.top_k(score, k)
    return idx, top_s > NEG / 2


def slc_attention(q, k, v, idx, ok):
    B, S, H, dh = q.shape
    n_slc = S // SLC_BLK
    kk = idx.shape[-1]
    nq = S // SLC_QBLK
    kb = jnp.moveaxis(k.reshape(B, n_slc, SLC_BLK, N_KV, dh), 3, 1)
    vb = jnp.moveaxis(v.reshape(B, n_slc, SLC_BLK, N_KV, dh), 3, 1)
    qc = jnp.moveaxis(q.reshape(B, nq, SLC_QBLK, N_KV, GROUP, dh), 1, 0)
    ic = jnp.moveaxis(idx.reshape(B, N_KV, nq, SLC_QBLK, kk), 2, 0)
    okc = jnp.moveaxis(ok.reshape(B, N_KV, nq, SLC_QBLK, kk), 2, 0)
    tc = jnp.arange(S).reshape(nq, SLC_QBLK)
    gather = jax.vmap(jax.vmap(lambda blocks, ix: blocks[ix]))

    def one_block(args):
        qb, ib, okb, tb = args
        ks = gather(kb, ib)
        vs = gather(vb, ib)
        s = jnp.einsum('bqkgd,bkqnpd->bkgqnp', qb, ks, preferred_element_type=F32) * SCALE
        tok = ib[..., None] * SLC_BLK + jnp.arange(SLC_BLK)
        mask = okb[..., None] & (tok <= tb[None, None, :, None, None])
        s = jnp.where(mask[:, :, None], s, NEG)
        p = jax.nn.softmax(s.reshape(B, N_KV, GROUP, SLC_QBLK, kk * SLC_BLK), axis=-1).reshape(s.shape)
        return jnp.einsum('bkgqnp,bkqnpd->bqkgd', p, vs.astype(F32))

    out = lax.map(one_block, (qc, ic, okc, tc))
    return jnp.moveaxis(out, 0, 1).reshape(B, S, H, dh)


def win_attention(q, k, v):
    B, S, H, dh = q.shape
    nb = S // WIN_QBLK
    nback = WINDOW // WIN_QBLK
    pad = ((0, 0), (WINDOW, 0), (0, 0), (0, 0))
    kp = jnp.pad(k, pad).reshape(B, nb + nback, WIN_QBLK, N_KV, dh)
    vp = jnp.pad(v, pad).reshape(B, nb + nback, WIN_QBLK, N_KV, dh)
    kw = jnp.concatenate([kp[:, j:j + nb] for j in range(nback + 1)], axis=2)
    vw = jnp.concatenate([vp[:, j:j + nb] for j in range(nback + 1)], axis=2)
    qb = q.reshape(B, nb, WIN_QBLK, N_KV, GROUP, dh)
    s = jnp.einsum('bnqkgd,bnpkd->bnkgqp', qb, kw, preferred_element_type=F32) * SCALE
    n_idx = jnp.arange(nb)[:, None]
    tq = n_idx * WIN_QBLK + jnp.arange(WIN_QBLK)[None, :]
    tk = n_idx * WIN_QBLK - WINDOW + jnp.arange((nback + 1) * WIN_QBLK)[None, :]
    diff = tq[:, :, None] - tk[:, None, :]
    mask = (diff >= 0) & (diff < WINDOW) & (tk[:, None, :] >= 0)
    s = jnp.where(mask[None, :, None, None], s, NEG)
    p = jax.nn.softmax(s, axis=-1)
    return jnp.einsum('bnkgqp,bnpkd->bnqkgd', p, vw.astype(F32)).reshape(B, S, H, dh)


def hybrid_layer(x, g, w_in, conv_w, conv_b, wa, ba, wi, bi, lam, pos_k, pos_v, kw1, kw2, vw1, vw2, w_out, cos, sin):
    B, S, _ = x.shape
    h = rmsnorm(x, g)
    z = h @ w_in
    splits = [int(c) for c in np.cumsum([D_LRU, D_LRU, D_NSA, D_NSA, KV_W, KV_W, KV_W, KV_W, KV_W, KV_W])]
    u_lru, g_lru, q, g_nsa, kc, vc, ks, vs, kwn, vwn, gate_logits = jnp.split(z, splits, axis=-1)
    y_lru = rg_lru(causal_depthwise_conv(u_lru, conv_w, conv_b), wa, ba, wi, bi, lam)
    heads = lambda t: t.reshape(B, S, N_KV, HEAD_DIM)
    q = q.reshape(B, S, N_HEADS, HEAD_DIM)
    o_cmp, p_cmp = cmp_attention(q, compress(heads(kc), pos_k, kw1, kw2), compress(heads(vc), pos_v, vw1, vw2))
    idx, ok = selection_indices(p_cmp, S)
    q_rot = apply_rope(q, cos, sin)
    o_slc = slc_attention(q_rot, apply_rope(heads(ks), cos, sin), heads(vs), idx, ok)
    o_win = win_attention(q_rot, apply_rope(heads(kwn), cos, sin), heads(vwn))
    gates = jax.nn.sigmoid(gate_logits.astype(F32)).reshape(B, S, N_HEADS, 3)
    y_nsa = (gates[..., 0:1] * o_cmp + gates[..., 1:2] * o_slc + gates[..., 2:3] * o_win).reshape(B, S, D_NSA)
    y = jnp.concatenate([y_lru * jax.nn.silu(g_lru.astype(F32)), y_nsa * jax.nn.silu(g_nsa.astype(F32))], axis=-1).astype(x.dtype)
    return x + y @ w_out


def setup_inputs(seed: int = 0) -> dict:
    key = jax.random.key(seed)
    ks = jax.random.split(key, 20)
    nrm = lambda k, shape, scale: jax.random.normal(k, shape, dtype=F32) * scale
    u = jax.random.uniform(ks[7], (DEPTH, D_LRU), dtype=F32, minval=0.9, maxval=0.999)
    a0 = u ** (1.0 / LRU_C)
    return {
        'x': nrm(ks[0], (BATCH, SEQ, D_MODEL), 1.0),
        'norm_g': 1.0 + nrm(ks[1], (DEPTH, D_MODEL), 0.02),
        'w_in': nrm(ks[2], (DEPTH, D_MODEL, D_IN), D_MODEL ** -0.5),
        'conv_w': nrm(ks[3], (DEPTH, CONV_W, D_LRU), CONV_W ** -0.5),
        'conv_b': nrm(ks[4], (DEPTH, D_LRU), 0.02),
        'lru_wa': nrm(ks[5], (DEPTH, H_LRU, LRU_BLK, LRU_BLK), LRU_BLK ** -0.5),
        'lru_ba': nrm(ks[6], (DEPTH, D_LRU), 0.02),
        'lru_wi': nrm(ks[8], (DEPTH, H_LRU, LRU_BLK, LRU_BLK), LRU_BLK ** -0.5),
        'lru_bi': nrm(ks[9], (DEPTH, D_LRU), 0.02),
        'lru_lambda': jnp.log(a0) - jnp.log1p(-a0),
        'cmp_pos_k': nrm(ks[10], (DEPTH, CMP_LEN, HEAD_DIM), 0.1),
        'cmp_pos_v': nrm(ks[11], (DEPTH, CMP_LEN, HEAD_DIM), 0.1),
        'cmp_k_w1': nrm(ks[12], (DEPTH, CMP_LEN * HEAD_DIM, CMP_HID), (CMP_LEN * HEAD_DIM) ** -0.5),
        'cmp_k_w2': nrm(ks[13], (DEPTH, CMP_HID, HEAD_DIM), CMP_HID ** -0.5),
        'cmp_v_w1': nrm(ks[14], (DEPTH, CMP_LEN * HEAD_DIM, CMP_HID), (CMP_LEN * HEAD_DIM) ** -0.5),
        'cmp_v_w2': nrm(ks[15], (DEPTH, CMP_HID, HEAD_DIM), CMP_HID ** -0.5),
        'w_out': nrm(ks[16], (DEPTH, D_MIX, D_MODEL), D_MIX ** -0.5),
        'final_g': 1.0 + nrm(ks[17], (D_MODEL,), 0.02),
    }


def reference(x, norm_g, w_in, conv_w, conv_b, lru_wa, lru_ba, lru_wi, lru_bi, lru_lambda, cmp_pos_k, cmp_pos_v, cmp_k_w1, cmp_k_w2, cmp_v_w1, cmp_v_w2, w_out, final_g):
    cos, sin = rope_tables(x.shape[1])
    h = x
    for l in range(DEPTH):
        h = hybrid_layer(h, norm_g[l], w_in[l], conv_w[l], conv_b[l], lru_wa[l], lru_ba[l], lru_wi[l], lru_bi[l], lru_lambda[l], cmp_pos_k[l], cmp_pos_v[l], cmp_k_w1[l], cmp_k_w2[l], cmp_v_w1[l], cmp_v_w2[l], w_out[l], cos, sin)
    return rmsnorm(h, final_g)
```

```cpp
#include <hip/hip_runtime.h>
#include <stdint.h>
#include <cstdio>

#ifndef PHSEL
#define PHSEL 0xFF
#endif
#ifndef MK_N_LAUNCHES
#define MK_N_LAUNCHES 0
#endif

typedef unsigned short bf16_t;
typedef short bf16x8 __attribute__((ext_vector_type(8)));
typedef float f32x4 __attribute__((ext_vector_type(4)));
typedef unsigned u32x4 __attribute__((ext_vector_type(4)));
typedef unsigned u32x2 __attribute__((ext_vector_type(2)));
#define LAS __attribute__((address_space(3)))

constexpr int NB = 4, S = 4096, T = NB * S, D = 1024, DEPTH = 4;
constexpr int DLRU = 512, HLRU = 8, DIN = 2840, NPAD = 3072, ZLD = 2848;
constexpr int ZU = 0, ZGL = 512, ZQ = 1024, ZGN = 1536, ZKC = 2048, ZVC = 2176, ZKS = 2304, ZVS = 2432, ZKW = 2560, ZVW = 2688, ZGATE = 2816;
constexpr int NC = 255, NCP = 256, CMPH = 256, CMPK = 2048;
constexpr float EPS = 1e-6f, NEGF = -1e30f, SCALE = 0.125f;
constexpr int NTHR = 512, NWAVE = 8;
constexpr int NPHASE = 2 + 4 * DEPTH;

constexpr size_t al256(size_t x) { return (x + 255) & ~(size_t)255; }
constexpr size_t WS_BAR   = 0;
constexpr size_t WS_WTIN  = 16384;
constexpr size_t WS_WTOUT = WS_WTIN  + al256((size_t)DEPTH * NPAD * D * 2);
constexpr size_t WS_W1T   = WS_WTOUT + al256((size_t)DEPTH * D * D * 2);
constexpr size_t WS_W2T   = WS_W1T   + al256((size_t)DEPTH * 2 * CMPH * CMPK * 2);
constexpr size_t WS_WAT   = WS_W2T   + al256((size_t)DEPTH * 2 * 64 * CMPH * 2);
constexpr size_t WS_BIAS1 = WS_WAT   + al256((size_t)DEPTH * 2 * HLRU * 64 * 64 * 2);
constexpr size_t WS_ROPEC = WS_BIAS1 + al256((size_t)DEPTH * 2 * CMPH * 4);
constexpr size_t WS_ROPES = WS_ROPEC + al256((size_t)S * 32 * 4);
constexpr size_t WS_XB    = WS_ROPES + al256((size_t)S * 32 * 4);
constexpr size_t WS_SSQ   = WS_XB    + al256((size_t)T * D * 2);
constexpr size_t WS_Z     = WS_SSQ   + al256((size_t)T * 16 * 4);
constexpr size_t WS_KR    = WS_Z     + al256((size_t)T * ZLD * 2);
constexpr size_t WS_KCMP  = WS_KR    + al256((size_t)T * 256 * 2);
constexpr size_t WS_VCMP  = WS_KCMP  + al256((size_t)NB * 2 * NCP * 64 * 2);
constexpr size_t WS_DBUF  = WS_VCMP  + al256((size_t)NB * 2 * NCP * 64 * 2);
constexpr size_t WS_AGG   = WS_DBUF  + al256((size_t)T * DLRU * 4);
constexpr size_t WS_YBUF  = WS_AGG   + al256((size_t)NB * 64 * DLRU * 2 * 4);
constexpr size_t WS_END   = WS_YBUF  + al256((size_t)T * D * 2);
static_assert(WS_END <= (size_t)256 * 1024 * 1024, "workspace map exceeds 256 MiB");

constexpr int LDS_BYTES = 150 * 1024;
constexpr int LDS_CTL = 0;
constexpr int LDS_WORK = 16;

struct Params {
    const float *x, *norm_g, *w_in, *conv_w, *conv_b, *lru_wa, *lru_ba, *lru_wi, *lru_bi, *lru_lambda, *pos_k, *pos_v, *k_w1, *k_w2, *v_w1, *v_w2, *w_out, *final_g;
    float* out; unsigned char* ws;
    int ph_lo, ph_hi;
};

__device__ __forceinline__ bf16_t f2bf(float f) { unsigned u = __float_as_uint(f); u += 0x7fffu + ((u >> 16) & 1u); return (bf16_t)(u >> 16); }
__device__ __forceinline__ float bf2f(bf16_t h) { return __uint_as_float(((unsigned)h) << 16); }
__device__ __forceinline__ unsigned pack2(float lo, float hi) { return (unsigned)f2bf(lo) | ((unsigned)f2bf(hi) << 16); }
__device__ __forceinline__ float bflo(unsigned w) { return __uint_as_float(w << 16); }
__device__ __forceinline__ float bfhi(unsigned w) { return __uint_as_float(w & 0xffff0000u); }
__device__ __forceinline__ float sigmoidf_(float x) { return 1.0f / (1.0f + __expf(-x)); }
__device__ __forceinline__ float siluf_(float x) { return x / (1.0f + __expf(-x)); }
__device__ __forceinline__ float wave_max(float v) {
#pragma unroll
    for (int o = 32; o > 0; o >>= 1) v = fmaxf(v, __shfl_xor(v, o));
    return v; }
__device__ __forceinline__ float wave_sum(float v) {
#pragma unroll
    for (int o = 32; o > 0; o >>= 1) v += __shfl_xor(v, o);
    return v; }

#define XB_TMO      128
#define XB_XCNT(j)  (256  + 64 * (j))
#define XB_XSUB(j)  (1280 + 64 * (j))
#define XB_XGEN(j)  (2304 + 64 * (j))
#define XB_TOP      3328
#define XB_TOPGEN   3392
#define XCD_BAR_WORDS 3456
#define XB_SPIN_CAP (1u << 22)
__device__ __forceinline__ unsigned xb_ld(unsigned* p)              { return __hip_atomic_load(p, __ATOMIC_RELAXED, __HIP_MEMORY_SCOPE_AGENT); }
__device__ __forceinline__ unsigned xb_add(unsigned* p, unsigned v) { return __hip_atomic_fetch_add(p, v, __ATOMIC_RELAXED, __HIP_MEMORY_SCOPE_AGENT); }
__device__ __forceinline__ unsigned xb_xcc_id() { return (unsigned)__builtin_amdgcn_s_getreg((3 << 11) | 20) & 0xFu; }
#define XB_SPIN(cond, bar) do { unsigned _sp = 0; while (cond) { __builtin_amdgcn_s_sleep(1); \
    if ((++_sp & 255u) == 0u) { if (xb_ld(&(bar)[XB_TMO])) break; if (_sp > XB_SPIN_CAP) { atomicAdd(&(bar)[XB_TMO], 1u); break; } } } } while (0)
struct XcdBarrier { unsigned* bar; unsigned x; volatile LAS unsigned* st; };
__device__ __forceinline__ XcdBarrier xcd_barrier_post(unsigned* bar, volatile LAS unsigned* st) {
    XcdBarrier b; b.bar = bar; b.x = xb_xcc_id(); b.st = st;
    if (threadIdx.x == 0) (void)xb_add(&bar[XB_XCNT(b.x)], 1u);
    return b;
}
__device__ __forceinline__ void xcd_barrier_complete(unsigned* bar, unsigned x, unsigned& nloc, unsigned& nx) {
    const unsigned G = gridDim.x * gridDim.y * gridDim.z;
    unsigned sum, cnt, mine, sp = 0u;
    for (;;) {
        sum = 0u; cnt = 0u; mine = 0u;
#pragma unroll
        for (unsigned j = 0; j < 16; ++j) { const unsigned c = xb_ld(&bar[XB_XCNT(j)]); sum += c; cnt += (c > 0u) ? 1u : 0u; mine = (j == x) ? c : mine; }
        if (sum == G) break;
        __builtin_amdgcn_s_sleep(1);
        if ((++sp & 255u) == 0u) { if (xb_ld(&bar[XB_TMO])) break; if (sp > XB_SPIN_CAP) { atomicAdd(&bar[XB_TMO], 1u); break; } }
    }
    nloc = mine > 0u ? mine : 1u; nx = cnt > 0u ? cnt : 1u;
}
__device__ __forceinline__ void xcd_barrier(const XcdBarrier& b) {
    asm volatile("s_waitcnt vmcnt(0)" ::: "memory");
    __syncthreads();
    if (threadIdx.x == 0) {
        unsigned* bar = b.bar;
        __builtin_amdgcn_s_waitcnt(0);
        unsigned nloc = b.st[0], nx = b.st[1];
        if (nloc == 0u) { xcd_barrier_complete(bar, b.x, nloc, nx); b.st[0] = nloc; b.st[1] = nx; }
        const unsigned old = xb_add(&bar[XB_XSUB(b.x)], 1u);
        const unsigned gen = old / nloc;
        if (old + 1u == (gen + 1u) * nloc) {
            __builtin_amdgcn_fence(__ATOMIC_RELEASE, "agent");
            asm volatile("s_waitcnt vmcnt(0)" ::: "memory");
            const unsigned og = xb_add(&bar[XB_TOP], 1u);
            const unsigned tg = og / nx;
            if (og + 1u == (tg + 1u) * nx) xb_add(&bar[XB_TOPGEN], 1u);
            else XB_SPIN(xb_ld(&bar[XB_TOPGEN]) == tg, bar);
            __builtin_amdgcn_fence(__ATOMIC_ACQUIRE, "agent");
            xb_add(&bar[XB_XGEN(b.x)], 1u);
            asm volatile("s_waitcnt vmcnt(0)" ::: "memory");
        } else {
            XB_SPIN(xb_ld(&bar[XB_XGEN(b.x)]) == gen, bar);
            __builtin_amdgcn_fence(__ATOMIC_ACQUIRE, "agent");
            asm volatile("s_waitcnt vmcnt(0)" ::: "memory");
        }
    }
    __syncthreads();
}

struct Frame {
    Params p;
    unsigned char* lds;
    int tid, lane, wave;
    __device__ __forceinline__ bf16_t* wt_in()  const { return (bf16_t*)(p.ws + WS_WTIN); }
    __device__ __forceinline__ bf16_t* wt_out() const { return (bf16_t*)(p.ws + WS_WTOUT); }
    __device__ __forceinline__ bf16_t* w1t()    const { return (bf16_t*)(p.ws + WS_W1T); }
    __device__ __forceinline__ bf16_t* w2t()    const { return (bf16_t*)(p.ws + WS_W2T); }
    __device__ __forceinline__ bf16_t* wat()    const { return (bf16_t*)(p.ws + WS_WAT); }
    __device__ __forceinline__ float*  bias1()  const { return (float*)(p.ws + WS_BIAS1); }
    __device__ __forceinline__ float*  ropec()  const { return (float*)(p.ws + WS_ROPEC); }
    __device__ __forceinline__ float*  ropes()  const { return (float*)(p.ws + WS_ROPES); }
    __device__ __forceinline__ bf16_t* xb()     const { return (bf16_t*)(p.ws + WS_XB); }
    __device__ __forceinline__ float*  abuf()   const { return (float*)(p.ws + WS_XB); }
    __device__ __forceinline__ float*  ssq()    const { return (float*)(p.ws + WS_SSQ); }
    __device__ __forceinline__ bf16_t* z()      const { return (bf16_t*)(p.ws + WS_Z); }
    __device__ __forceinline__ bf16_t* kr()     const { return (bf16_t*)(p.ws + WS_KR); }
    __device__ __forceinline__ bf16_t* kcmp()   const { return (bf16_t*)(p.ws + WS_KCMP); }
    __device__ __forceinline__ bf16_t* vcmp()   const { return (bf16_t*)(p.ws + WS_VCMP); }
    __device__ __forceinline__ float*  dbuf()   const { return (float*)(p.ws + WS_DBUF); }
    __device__ __forceinline__ float*  agg()    const { return (float*)(p.ws + WS_AGG); }
    __device__ __forceinline__ bf16_t* ybuf()   const { return (bf16_t*)(p.ws + WS_YBUF); }
};

template <int BM, int BN, int WM, int WN, class APtr>
__device__ __forceinline__ void gemm_mainloop(const APtr& aptr, const bf16_t* __restrict__ Bt, int ldb, int K, int n0, unsigned char* smem,
                                              f32x4 (&acc)[BM / WM / 16][BN / WN / 16], int tid) {
    constexpr int MT = BM / WM / 16, NT = BN / WN / 16;
    constexpr int ACH = BM * 8 / NTHR, BCH = BN * 8 / NTHR;
    static_assert(ACH >= 1 && BCH >= 1, "tile too small for 512 threads");
    constexpr int ABYTES = BM * 128, BBYTES = BN * 128;
    const int lane = tid & 63, wave = tid >> 6, wm = wave / WN, wn = wave % WN;
    const int fr = lane & 15, fq = lane >> 4;
#pragma unroll
    for (int i = 0; i < MT; ++i)
#pragma unroll
        for (int j = 0; j < NT; ++j) acc[i][j] = (f32x4){0.f, 0.f, 0.f, 0.f};
    u32x4 ra[ACH], rb[BCH];
    const int nk = K / 64;
#pragma unroll
    for (int i = 0; i < ACH; ++i) { const int idx = tid + NTHR * i, r = idx >> 3, c = idx & 7; ra[i] = *(const u32x4*)(aptr(r, 0) + c * 8); }
#pragma unroll
    for (int i = 0; i < BCH; ++i) { const int idx = tid + NTHR * i, r = idx >> 3, c = idx & 7; rb[i] = *(const u32x4*)(Bt + (size_t)(n0 + r) * ldb + c * 8); }
#pragma unroll
    for (int i = 0; i < ACH; ++i) { const int idx = tid + NTHR * i, r = idx >> 3, c = idx & 7; *(u32x4*)(smem + r * 128 + ((c ^ (r & 7)) << 4)) = ra[i]; }
#pragma unroll
    for (int i = 0; i < BCH; ++i) { const int idx = tid + NTHR * i, r = idx >> 3, c = idx & 7; *(u32x4*)(smem + 2 * ABYTES + r * 128 + ((c ^ (r & 7)) << 4)) = rb[i]; }
    __syncthreads();
    for (int kt = 0; kt < nk; ++kt) {
        const int cur = kt & 1;
        const bool more = (kt + 1 < nk);
        if (more) {
            const int k1 = (kt + 1) * 64;
#pragma unroll
            for (int i = 0; i < ACH; ++i) { const int idx = tid + NTHR * i, r = idx >> 3, c = idx & 7; ra[i] = *(const u32x4*)(aptr(r, k1) + c * 8); }
#pragma unroll
            for (int i = 0; i < BCH; ++i) { const int idx = tid + NTHR * i, r = idx >> 3, c = idx & 7; rb[i] = *(const u32x4*)(Bt + (size_t)(n0 + r) * ldb + k1 + c * 8); }
        }
        const unsigned char* As = smem + cur * ABYTES;
        const unsigned char* Bs = smem + 2 * ABYTES + cur * BBYTES;
#pragma unroll
        for (int kk = 0; kk < 2; ++kk) {
            bf16x8 af[MT], bfr[NT];
#pragma unroll
            for (int i = 0; i < MT; ++i) { const int r = wm * MT * 16 + i * 16 + fr, c = kk * 4 + fq; af[i] = *(const bf16x8*)(As + r * 128 + ((c ^ (r & 7)) << 4)); }
#pragma unroll
            for (int j = 0; j < NT; ++j) { const int r = wn * NT * 16 + j * 16 + fr, c = kk * 4 + fq; bfr[j] = *(const bf16x8*)(Bs + r * 128 + ((c ^ (r & 7)) << 4)); }
#pragma unroll
            for (int i = 0; i < MT; ++i)
#pragma unroll
                for (int j = 0; j < NT; ++j) acc[i][j] = __builtin_amdgcn_mfma_f32_16x16x32_bf16(bfr[j], af[i], acc[i][j], 0, 0, 0);
        }
        if (more) {
            unsigned char* An = smem + (cur ^ 1) * ABYTES;
            unsigned char* Bn = smem + 2 * ABYTES + (cur ^ 1) * BBYTES;
#pragma unroll
            for (int i = 0; i < ACH; ++i) { const int idx = tid + NTHR * i, r = idx >> 3, c = idx & 7; *(u32x4*)(An + r * 128 + ((c ^ (r & 7)) << 4)) = ra[i]; }
#pragma unroll
            for (int i = 0; i < BCH; ++i) { const int idx = tid + NTHR * i, r = idx >> 3, c = idx & 7; *(u32x4*)(Bn + r * 128 + ((c ^ (r & 7)) << 4)) = rb[i]; }
        }
        __syncthreads();
    }
}

struct APlain { const bf16_t* A; int lda; int m0; __device__ __forceinline__ const bf16_t* operator()(int r, int k0) const { return A + (size_t)(m0 + r) * lda + k0; } };

__device__ __forceinline__ void tr_tile(const Frame& F, const float* __restrict__ src, int R, int C, int ld_src, bf16_t* __restrict__ dst, int ld_dst, int Cpad, const float* __restrict__ rowscale, int r0, int c0) {
    float* tile = (float*)(F.lds + LDS_WORK);
    const int tx = F.tid & 63, ty = F.tid >> 6;
#pragma unroll
    for (int i = 0; i < 8; ++i) {
        const int r = r0 + ty + 8 * i, c = c0 + tx;
        float v = 0.f;
        if (r < R && c < C) { v = src[(size_t)r * ld_src + c]; if (rowscale) v *= rowscale[r]; }
        tile[(ty + 8 * i) * 65 + tx] = v;
    }
    __syncthreads();
#pragma unroll
    for (int i = 0; i < 8; ++i) {
        const int c = c0 + ty + 8 * i, r = r0 + tx;
        if (c < Cpad && r < R) dst[(size_t)c * ld_dst + r] = f2bf(tile[tx * 65 + ty + 8 * i]);
    }
    __syncthreads();
}

__device__ __forceinline__ void p0_prologue(const Frame& F) {
    const Params& p = F.p;
    const int G = gridDim.x, bid = blockIdx.x;
    constexpr int T_IN = 16 * 48, T_OUT = 16 * 16, T_W1 = 32 * 4, T_W2 = 4, T_G = 8;
    constexpr int PER_L = T_IN + T_OUT + 2 * T_W1 + 2 * T_W2 + 2 * T_G;
    for (int it = bid; it < DEPTH * PER_L; it += G) {
        const int l = it / PER_L; int j = it % PER_L;
        if (j < T_IN) { tr_tile(F, p.w_in + (size_t)l * D * DIN, D, DIN, DIN, F.wt_in() + (size_t)l * NPAD * D, D, NPAD, p.norm_g + l * D, (j % 16) * 64, (j / 16) * 64); continue; }
        j -= T_IN;
        if (j < T_OUT) { tr_tile(F, p.w_out + (size_t)l * D * D, D, D, D, F.wt_out() + (size_t)l * D * D, D, D, nullptr, (j % 16) * 64, (j / 16) * 64); continue; }
        j -= T_OUT;
        if (j < 2 * T_W1) { const int kv = j / T_W1, jj = j % T_W1; const float* src = (kv ? p.v_w1 : p.k_w1) + (size_t)l * CMPK * CMPH;
            tr_tile(F, src, CMPK, CMPH, CMPH, F.w1t() + (size_t)(l * 2 + kv) * CMPH * CMPK, CMPK, CMPH, nullptr, (jj % 32) * 64, (jj / 32) * 64); continue; }
        j -= 2 * T_W1;
        if (j < 2 * T_W2) { const int kv = j / T_W2, jj = j % T_W2; const float* src = (kv ? p.v_w2 : p.k_w2) + (size_t)l * CMPH * 64;
            tr_tile(F, src, CMPH, 64, 64, F.w2t() + (size_t)(l * 2 + kv) * 64 * CMPH, CMPH, 64, nullptr, jj * 64, 0); continue; }
        j -= 2 * T_W2;
        { const int gsel = j / T_G, h = j % T_G; const float* src = (gsel ? p.lru_wi : p.lru_wa) + ((size_t)l * HLRU + h) * 64 * 64;
            tr_tile(F, src, 64, 64, 64, F.wat() + ((size_t)(l * 2 + gsel) * HLRU + h) * 64 * 64, 64, 64, nullptr, 0, 0); }
    }
    {
        float* red = (float*)(F.lds + LDS_WORK);
        for (int it = bid; it < DEPTH * 2 * 4; it += G) {
            const int l = it >> 3, kv = (it >> 2) & 1, jb = it & 3;
            const float* w1 = (kv ? p.v_w1 : p.k_w1) + (size_t)l * CMPK * CMPH;
            const float* pos = (kv ? p.pos_v : p.pos_k) + (size_t)l * CMPK;
            const int j = jb * 64 + (F.tid & 63), ks = F.tid >> 6;
            float s = 0.f;
            for (int k = ks * 256; k < ks * 256 + 256; ++k) s += pos[k] * w1[(size_t)k * CMPH + j];
            red[ks * 64 + (F.tid & 63)] = s;
            __syncthreads();
            if (F.tid < 64) { float t = 0.f;
#pragma unroll
                for (int q = 0; q < 8; ++q) t += red[q * 64 + F.tid];
                F.bias1()[(l * 2 + kv) * CMPH + j] = t; }
            __syncthreads();
        }
    }
    for (int i = bid * NTHR + F.tid; i < S * 32; i += G * NTHR) {
        const int t = i >> 5, f = i & 31;
        const float inv = 1.0f / powf(10000.0f, (float)(2 * f) / 64.0f);
        const float ang = (float)t * inv;
        F.ropec()[i] = cosf(ang); F.ropes()[i] = sinf(ang);
    }
    for (int row = bid * NWAVE + F.wave; row < T; row += G * NWAVE) {
        const float* xr = p.x + (size_t)row * D;
        float ss = 0.f;
#pragma unroll
        for (int i = 0; i < 4; ++i) {
            const f32x4 v = *(const f32x4*)(xr + (i * 64 + F.lane) * 4);
            ss += v[0] * v[0] + v[1] * v[1] + v[2] * v[2] + v[3] * v[3];
            u32x2 w; w.x = pack2(v[0], v[1]); w.y = pack2(v[2], v[3]);
            *(u32x2*)(F.xb() + (size_t)row * D + (i * 64 + F.lane) * 4) = w;
        }
        ss = wave_sum(ss);
        if (F.lane < 16) F.ssq()[(size_t)row * 16 + F.lane] = (F.lane == 0) ? ss : 0.f;
    }
}

__device__ __forceinline__ void p1_inproj(const Frame& F, int l) {
    constexpr int BM = 256, BN = 128;
    unsigned char* smem = F.lds + LDS_WORK;
    float* rstd = (float*)(smem + 2 * BM * 128 + 2 * BN * 128);
    const bf16_t* Bt = F.wt_in() + (size_t)l * NPAD * D;
    const int nM = T / BM, nN = NPAD / BN;
    for (int it = blockIdx.x; it < nM * nN; it += gridDim.x) {
        const int pm = it % nM, pn = it / nM;
        const int m0 = pm * BM, n0 = pn * BN;
        if (F.tid < BM) { const float* s = F.ssq() + (size_t)(m0 + F.tid) * 16; float t = 0.f;
#pragma unroll
            for (int q = 0; q < 16; ++q) t += s[q];
            rstd[F.tid] = rsqrtf(t * (1.0f / D) + EPS); }
        f32x4 acc[4][4];
        APlain ap{F.xb(), D, m0};
        gemm_mainloop<BM, BN, 4, 2>(ap, Bt, D, D, n0, smem, acc, F.tid);
        const int wm = F.wave >> 1, wn = F.wave & 1, fr = F.lane & 15, fq = F.lane >> 4;
#pragma unroll
        for (int i = 0; i < 4; ++i) {
            const int rl = wm * 64 + i * 16 + fr; const float rs = rstd[rl];
            bf16_t* zr = F.z() + (size_t)(m0 + rl) * ZLD;
#pragma unroll
            for (int j = 0; j < 4; ++j) {
                const int col = n0 + wn * 64 + j * 16 + 4 * fq;
                if (col < DIN) { u32x2 w; w.x = pack2(acc[i][j][0] * rs, acc[i][j][1] * rs); w.y = pack2(acc[i][j][2] * rs, acc[i][j][3] * rs); *(u32x2*)(zr + col) = w; }
            }
        }
        __syncthreads();
    }
}

struct ACmp { const bf16_t* z; int zoff; int m0; __device__ __forceinline__ const bf16_t* operator()(int r, int k0) const {
    int m = m0 + r; if (m > NB * NC * 2 - 1) m = NB * NC * 2 - 1;
    const int h = m & 1, bc = m >> 1, b = bc / NC, c = bc % NC;
    return z + (size_t)(b * S + 16 * c + (k0 >> 6)) * ZLD + zoff + h * 64; } };

__device__ __forceinline__ void p2_compress_item(const Frame& F, int l, int item) {
    constexpr int BM = 64, BN = 256;
    const int kv = item & 1, mt0 = item >> 1;
    unsigned char* smem = F.lds + LDS_WORK;
    bf16_t* hid = (bf16_t*)(smem + 2 * BM * 128 + 2 * BN * 128);
    constexpr int HLD = 264;
    f32x4 acc[4][2];
    ACmp ap{F.z(), kv ? ZVC : ZKC, mt0 * BM};
    gemm_mainloop<BM, BN, 1, 8>(ap, F.w1t() + (size_t)(l * 2 + kv) * CMPH * CMPK, CMPK, CMPK, 0, smem, acc, F.tid);
    const int fr = F.lane & 15, fq = F.lane >> 4;
    const float* b1 = F.bias1() + (l * 2 + kv) * CMPH;
#pragma unroll
    for (int i = 0; i < 4; ++i)
#pragma unroll
        for (int j = 0; j < 2; ++j) {
            const int col = F.wave * 32 + j * 16 + 4 * fq, row = i * 16 + fr;
            const f32x4 bb = *(const f32x4*)(b1 + col);
            u32x2 w; w.x = pack2(siluf_(acc[i][j][0] + bb[0]), siluf_(acc[i][j][1] + bb[1])); w.y = pack2(siluf_(acc[i][j][2] + bb[2]), siluf_(acc[i][j][3] + bb[3]));
            *(u32x2*)(hid + row * HLD + col) = w;
        }
    __syncthreads();
    const bf16_t* w2 = F.w2t() + (size_t)(l * 2 + kv) * 64 * CMPH;
    const int mt = F.wave >> 1;
    f32x4 o[2] = {(f32x4){0.f, 0.f, 0.f, 0.f}, (f32x4){0.f, 0.f, 0.f, 0.f}};
#pragma unroll
    for (int kk = 0; kk < 8; ++kk) {
        const bf16x8 a = *(const bf16x8*)(hid + (mt * 16 + fr) * HLD + kk * 32 + fq * 8);
#pragma unroll
        for (int j = 0; j < 2; ++j) {
            const int n = ((F.wave & 1) * 2 + j) * 16 + fr;
            const bf16x8 b = *(const bf16x8*)(w2 + (size_t)n * CMPH + kk * 32 + fq * 8);
            o[j] = __builtin_amdgcn_mfma_f32_16x16x32_bf16(b, a, o[j], 0, 0, 0);
        }
    }
    const int m = mt0 * BM + mt * 16 + fr;
    if (m < NB * NC * 2) {
        const int h = m & 1, bc = m >> 1, b = bc / NC, c = bc % NC;
        bf16_t* dst = (kv ? F.vcmp() : F.kcmp()) + ((size_t)(b * 2 + h) * NCP + c) * 64;
#pragma unroll
        for (int j = 0; j < 2; ++j) { const int col = ((F.wave & 1) * 2 + j) * 16 + 4 * fq; u32x2 w; w.x = pack2(o[j][0], o[j][1]); w.y = pack2(o[j][2], o[j][3]); *(u32x2*)(dst + col) = w; }
    }
    __syncthreads();
}

__device__ __forceinline__ void p2_lru_item(const Frame& F, int l, int item) {
    const Params& p = F.p;
    const int b = item >> 6, ch = item & 63, t0 = ch * 64;
    const size_t tok0 = (size_t)b * S + t0;
    constexpr int ULD = 520;
    bf16_t* U = (bf16_t*)(F.lds + LDS_WORK);
    bf16_t* UC = U + 67 * ULD + 8;
    constexpr int CLD = 72;
    for (int idx = F.tid; idx < 67 * 64; idx += NTHR) {
        const int r = idx >> 6, c = idx & 63; const int t = t0 - 3 + r;
        u32x4 v = (u32x4){0u, 0u, 0u, 0u};
        if (t >= 0) v = *(const u32x4*)(F.z() + ((size_t)b * S + t) * ZLD + ZU + c * 8);
        *(u32x4*)(U + r * ULD + c * 8) = v;
    }
    __syncthreads();
    const int h = F.wave, fr = F.lane & 15, fq = F.lane >> 4;
    bf16_t* uc = UC + F.wave * 64 * CLD;
    const float* cw = p.conv_w + (size_t)l * 4 * DLRU; const float* cb = p.conv_b + (size_t)l * DLRU;
#pragma unroll 1
    for (int nt = 0; nt < 4; ++nt) {
        const int chn = 64 * h + 16 * nt + fr;
        const float w0 = cw[chn], w1 = cw[DLRU + chn], w2 = cw[2 * DLRU + chn], w3 = cw[3 * DLRU + chn], bb = cb[chn];
#pragma unroll
        for (int mt = 0; mt < 4; ++mt) {
            float u[7];
#pragma unroll
            for (int q = 0; q < 7; ++q) u[q] = bf2f(U[(16 * mt + 4 * fq + q) * ULD + chn]);
#pragma unroll
            for (int r = 0; r < 4; ++r) uc[(16 * mt + 4 * fq + r) * CLD + 16 * nt + fr] = f2bf(w0 * u[r] + w1 * u[r + 1] + w2 * u[r + 2] + w3 * u[r + 3] + bb);
        }
    }
    __builtin_amdgcn_s_waitcnt(0xC07F);
    __builtin_amdgcn_wave_barrier();
    const bf16_t* wr_ = F.wat() + ((size_t)(l * 2 + 0) * HLRU + h) * 4096;
    const bf16_t* wi_ = F.wat() + ((size_t)(l * 2 + 1) * HLRU + h) * 4096;
    const float* ba = p.lru_ba + (size_t)l * DLRU; const float* bi_ = p.lru_bi + (size_t)l * DLRU; const float* lam = p.lru_lambda + (size_t)l * DLRU;
    float* abuf = F.abuf(); float* dbuf = F.dbuf();
#pragma unroll 1
    for (int mt = 0; mt < 4; ++mt) {
        f32x4 ar[4], ai[4];
#pragma unroll
        for (int j = 0; j < 4; ++j) { ar[j] = (f32x4){0.f, 0.f, 0.f, 0.f}; ai[j] = (f32x4){0.f, 0.f, 0.f, 0.f}; }
#pragma unroll
        for (int kk = 0; kk < 2; ++kk) {
            const bf16x8 af = *(const bf16x8*)(uc + (16 * mt + fr) * CLD + kk * 32 + fq * 8);
#pragma unroll
            for (int j = 0; j < 4; ++j) {
                const int n = 16 * j + fr;
                const bf16x8 br = *(const bf16x8*)(wr_ + n * 64 + kk * 32 + fq * 8), bi = *(const bf16x8*)(wi_ + n * 64 + kk * 32 + fq * 8);
                ar[j] = __builtin_amdgcn_mfma_f32_16x16x32_bf16(af, br, ar[j], 0, 0, 0); ai[j] = __builtin_amdgcn_mfma_f32_16x16x32_bf16(af, bi, ai[j], 0, 0, 0);
            }
        }
        float* ap_ = abuf + (tok0 + 16 * mt + 4 * fq) * DLRU + 64 * h + fr;
        float* dp_ = dbuf + (tok0 + 16 * mt + 4 * fq) * DLRU + 64 * h + fr;
#pragma unroll
        for (int j = 0; j < 4; ++j) {
            const int chn = 64 * h + 16 * j + fr;
            const float w0 = cw[chn], w1 = cw[DLRU + chn], w2 = cw[2 * DLRU + chn], w3 = cw[3 * DLRU + chn], bb = cb[chn];
            const float bra = ba[chn], bri = bi_[chn], lm = lam[chn];
            const float sp = (lm > 20.f) ? __expf(-lm) : log1pf(__expf(-lm));
            float u[7];
#pragma unroll
            for (int q = 0; q < 7; ++q) u[q] = bf2f(U[(16 * mt + 4 * fq + q) * ULD + chn]);
#pragma unroll
            for (int r = 0; r < 4; ++r) {
                const float ucv = w0 * u[r] + w1 * u[r + 1] + w2 * u[r + 2] + w3 * u[r + 3] + bb;
                const float rg = sigmoidf_(ar[j][r] + bra), ig = sigmoidf_(ai[j][r] + bri);
                const float log_a = -8.0f * rg * sp;
                const float av = expf(log_a);
                const float dr = sqrtf(-expm1f(2.0f * log_a)) * (ig * ucv);
                ap_[r * DLRU + 16 * j] = av; dp_[r * DLRU + 16 * j] = dr;
            }
        }
    }
    __threadfence_block();
    __syncthreads();
    {
        const int chn = F.tid; float hh = 0.f, A = 1.f;
        for (int t = 0; t < 64; ++t) { const size_t o = (tok0 + t) * DLRU + chn; const float av = F.abuf()[o], dv = F.dbuf()[o]; hh = av * hh + dv; A *= av; }
        float* ag = F.agg() + ((size_t)(b * 64 + ch) * DLRU + chn) * 2; ag[0] = A; ag[1] = hh;
    }
    __syncthreads();
}

__device__ __forceinline__ void p2_ropek_item(const Frame& F, int item) {
    for (int e = F.tid; e < 256 * 4 * 32; e += NTHR) {
        const int f = e & 31, hh = (e >> 5) & 3, tl = e >> 7;
        const int tok = item * 256 + tl, t = tok & (S - 1);
        const int src = (hh < 2 ? ZKS : ZKW) + (hh & 1) * 64;
        const bf16_t* zr = F.z() + (size_t)tok * ZLD + src;
        const float x1 = bf2f(zr[f]), x2 = bf2f(zr[f + 32]);
        const float c = F.ropec()[t * 32 + f], s = F.ropes()[t * 32 + f];
        bf16_t* d = F.kr() + (size_t)tok * 256 + hh * 64;
        d[f] = f2bf(x1 * c - x2 * s); d[f + 32] = f2bf(x2 * c + x1 * s);
    }
}

__device__ __forceinline__ void dot4(const bf16_t* krow, const float* qs, float& d0, float& d1, float& d2, float& d3) {
    d0 = 0.f; d1 = 0.f; d2 = 0.f; d3 = 0.f;
#pragma unroll
    for (int c = 0; c < 8; ++c) {
        const u32x4 kw = *(const u32x4*)(krow + c * 8);
        const float kf[8] = {bflo(kw.x), bfhi(kw.x), bflo(kw.y), bfhi(kw.y), bflo(kw.z), bfhi(kw.z), bflo(kw.w), bfhi(kw.w)};
#pragma unroll
        for (int e4 = 0; e4 < 2; ++e4) {
            const f32x4 q0 = *(const f32x4*)(qs + c * 8 + e4 * 4), q1 = *(const f32x4*)(qs + 64 + c * 8 + e4 * 4), q2 = *(const f32x4*)(qs + 128 + c * 8 + e4 * 4), q3 = *(const f32x4*)(qs + 192 + c * 8 + e4 * 4);
#pragma unroll
            for (int e = 0; e < 4; ++e) { const float kk = kf[e4 * 4 + e]; d0 += q0[e] * kk; d1 += q1[e] * kk; d2 += q2[e] * kk; d3 += q3[e] * kk; }
        }
    }
}

struct OS { float m[4], l[4], o[4]; };
__device__ __forceinline__ void os_init(OS& s) {
#pragma unroll
    for (int g = 0; g < 4; ++g) { s.m[g] = NEGF; s.l[g] = 0.f; s.o[g] = 0.f; } }
__device__ __forceinline__ void os_segment(OS& s, int st, const float* qs_, float* pb, const bf16_t* kbase, const bf16_t* vbase, int t, int lane) {
    const float* qs = qs_; asm volatile("" : "+v"(qs));
    const int key = st + lane;
    const bool valid = key >= 0 && key <= t;
    float d[4] = {0.f, 0.f, 0.f, 0.f};
    if (valid) dot4(kbase + (size_t)key * 256, qs, d[0], d[1], d[2], d[3]);
    float pv[4];
#pragma unroll
    for (int g = 0; g < 4; ++g) {
        const float sc = valid ? d[g] * SCALE : NEGF;
        const float mn = fmaxf(s.m[g], wave_max(sc));
        const float alpha = __expf(s.m[g] - mn);
        pv[g] = valid ? __expf(sc - mn) : 0.f;
        s.l[g] = s.l[g] * alpha + wave_sum(pv[g]); s.o[g] *= alpha; s.m[g] = mn;
    }
    *(f32x4*)(pb + lane * 4) = (f32x4){pv[0], pv[1], pv[2], pv[3]};
    __builtin_amdgcn_s_waitcnt(0xC07F);
    __builtin_amdgcn_wave_barrier();
    const int k0 = st < 0 ? -st : 0;
    const int k1 = (t - st + 1) < 64 ? (t - st + 1) : 64;
    for (int kx = k0; kx < k1; ++kx) {
        const f32x4 pq = *(const f32x4*)(pb + kx * 4);
        const float vv = bf2f(vbase[(size_t)(st + kx) * ZLD + lane]);
        s.o[0] += pq[0] * vv; s.o[1] += pq[1] * vv; s.o[2] += pq[2] * vv; s.o[3] += pq[3] * vv;
    }
    __builtin_amdgcn_wave_barrier();
}

__device__ __forceinline__ void p3_nsa_task(const Frame& F, int l, int tok, int kvh, float* wl  ) {
    const int lane = F.lane;
    const int b = tok >> 12, t = tok & (S - 1);
    float* qs = wl; float* qr = wl + 256; float* pc = wl + 512; float* pb = wl + 1536;
    const bf16_t* zr = F.z() + (size_t)tok * ZLD;
    if (lane < 32) {
        const bf16_t* qp = zr + ZQ + kvh * 256;
        const float c = F.ropec()[t * 32 + lane], s = F.ropes()[t * 32 + lane];
#pragma unroll
        for (int g = 0; g < 4; ++g) {
            const float x1 = bf2f(qp[g * 64 + lane]), x2 = bf2f(qp[g * 64 + lane + 32]);
            qs[g * 64 + lane] = x1; qs[g * 64 + lane + 32] = x2;
            qr[g * 64 + lane] = x1 * c - x2 * s; qr[g * 64 + lane + 32] = x2 * c + x1 * s;
        }
    }
    __builtin_amdgcn_s_waitcnt(0xC07F);
    __builtin_amdgcn_wave_barrier();
    const int nv = (t >= 31) ? (((t - 31) >> 4) + 1) : 0;
    const bf16_t* kc = F.kcmp() + (size_t)(b * 2 + kvh) * NCP * 64;
    const bf16_t* vc = F.vcmp() + (size_t)(b * 2 + kvh) * NCP * 64;
    float ocmp[4] = {0.f, 0.f, 0.f, 0.f};
#pragma unroll 1
    for (int ps = 0; ps < 4; ++ps) {
        const float* qq = qs; asm volatile("" : "+v"(qq));
        const int c = lane + 64 * ps; const bool valid = c < nv;
        float d0 = 0.f, d1 = 0.f, d2 = 0.f, d3 = 0.f;
        if (valid) dot4(kc + (size_t)c * 64, qq, d0, d1, d2, d3);
        pc[c] = valid ? d0 * SCALE : NEGF; pc[256 + c] = valid ? d1 * SCALE : NEGF; pc[512 + c] = valid ? d2 * SCALE : NEGF; pc[768 + c] = valid ? d3 * SCALE : NEGF;
    }
    __builtin_amdgcn_s_waitcnt(0xC07F);
    __builtin_amdgcn_wave_barrier();
#pragma unroll
    for (int g = 0; g < 4; ++g) {
        float sc[4];
#pragma unroll
        for (int ps = 0; ps < 4; ++ps) sc[ps] = pc[g * 256 + lane + 64 * ps];
        const float mm = wave_max(fmaxf(fmaxf(sc[0], sc[1]), fmaxf(sc[2], sc[3])));
        float e[4], su = 0.f;
#pragma unroll
        for (int ps = 0; ps < 4; ++ps) { e[ps] = (sc[ps] > -1e29f) ? __expf(sc[ps] - mm) : 0.f; su += e[ps]; }
        su = wave_sum(su);
        const float inv = (nv > 0) ? 1.0f / su : 0.f;
#pragma unroll
        for (int ps = 0; ps < 4; ++ps) pc[g * 256 + lane + 64 * ps] = e[ps] * inv;
    }
    __builtin_amdgcn_s_waitcnt(0xC07F);
    __builtin_amdgcn_wave_barrier();
    for (int c = 0; c < nv; ++c) {
        const float vv = bf2f(vc[(size_t)c * 64 + lane]);
        ocmp[0] += pc[c] * vv; ocmp[1] += pc[256 + c] * vv; ocmp[2] += pc[512 + c] * vv; ocmp[3] += pc[768 + c] * vv;
    }
    unsigned long long selmask;
    {
        const int j = lane, cur = t >> 6;
        float pslc = 0.f;
#pragma unroll
        for (int q = -1; q <= 3; ++q) {
            const int c = 4 * j + q;
            if (c >= 0 && c < NC) { const float ps = (pc[c] + pc[256 + c]) + (pc[512 + c] + pc[768 + c]); pslc += (q == -1 || q == 3) ? 0.5f * ps : ps; }
        }
        const bool cand = j <= cur;
        const bool forced = (j == 0) || (j == cur) || (j == cur - 1);
        const float score = cand ? (forced ? pslc + 1e4f : pslc) : NEGF;
        int rank = 0;
        for (int i = 0; i < 64; ++i) { const float si = __shfl(score, i); rank += (si > score || (si == score && i < j)) ? 1 : 0; }
        selmask = __ballot(cand && rank < 16);
    }
    __builtin_amdgcn_wave_barrier();
    OS ss; os_init(ss);
    {
        const bf16_t* kb = F.kr() + (size_t)b * S * 256 + kvh * 64;
        const bf16_t* vb = F.z() + (size_t)b * S * ZLD + ZVS + kvh * 64;
        unsigned long long m = selmask;
        while (m) { const int j = (int)__builtin_ctzll(m); m &= (m - 1); os_segment(ss, j * 64, qr, pb, kb, vb, t, lane); }
    }
    OS sw; os_init(sw);
    {
        const bf16_t* kb = F.kr() + (size_t)b * S * 256 + 128 + kvh * 64;
        const bf16_t* vb = F.z() + (size_t)b * S * ZLD + ZVW + kvh * 64;
#pragma unroll 1
        for (int i = 0; i < 8; ++i) { const int st = t - 511 + 64 * i; if (st + 63 >= 0) os_segment(sw, st, qr, pb, kb, vb, t, lane); }
    }
    bf16_t* yb = F.ybuf();
#pragma unroll
    for (int g = 0; g < 4; ++g) {
        const int head = kvh * 4 + g;
        const float g0 = sigmoidf_(bf2f(zr[ZGATE + head * 3 + 0])), g1 = sigmoidf_(bf2f(zr[ZGATE + head * 3 + 1])), g2 = sigmoidf_(bf2f(zr[ZGATE + head * 3 + 2]));
        const float y = g0 * ocmp[g] + g1 * (ss.o[g] / ss.l[g]) + g2 * (sw.o[g] / sw.l[g]);
        const float gn = bf2f(zr[ZGN + head * 64 + lane]);
        yb[(size_t)tok * D + DLRU + head * 64 + lane] = f2bf(y * siluf_(gn));
    }
    __builtin_amdgcn_wave_barrier();
}

__device__ __forceinline__ void p3_lru_item(const Frame& F, int item) {
    const int b = item >> 6, ch = item & 63;
    const int chn = F.tid;
    float hh = 0.f;
    for (int c = 0; c < ch; ++c) { const float* ag = F.agg() + ((size_t)(b * 64 + c) * DLRU + chn) * 2; hh = ag[0] * hh + ag[1]; }
    const size_t tok0 = (size_t)b * S + ch * 64;
    for (int t = 0; t < 64; ++t) {
        const size_t o = (tok0 + t) * DLRU + chn;
        hh = F.abuf()[o] * hh + F.dbuf()[o];
        const float gl = bf2f(F.z()[(tok0 + t) * ZLD + ZGL + chn]);
        F.ybuf()[(tok0 + t) * D + chn] = f2bf(hh * siluf_(gl));
    }
}

__device__ __forceinline__ void p4_outproj(const Frame& F, int l) {
    constexpr int BM = 256, BN = 128;
    unsigned char* smem = F.lds + LDS_WORK;
    const bf16_t* Bt = F.wt_out() + (size_t)l * D * D;
    const float* xin = (l == 0) ? F.p.x : F.p.out;
    const int nM = T / BM, nN = D / BN;
    for (int it = blockIdx.x; it < nM * nN; it += gridDim.x) {
        const int pm = it % nM, pn = it / nM;
        const int m0 = pm * BM, n0 = pn * BN;
        f32x4 acc[4][4];
        APlain ap{F.ybuf(), D, m0};
        gemm_mainloop<BM, BN, 4, 2>(ap, Bt, D, D, n0, smem, acc, F.tid);
        const int wm = F.wave >> 1, wn = F.wave & 1, fr = F.lane & 15, fq = F.lane >> 4;
#pragma unroll
        for (int i = 0; i < 4; ++i) {
            const int row = m0 + wm * 64 + i * 16 + fr;
            float ss = 0.f;
#pragma unroll
            for (int j = 0; j < 4; ++j) {
                const int col = n0 + wn * 64 + j * 16 + 4 * fq;
                const f32x4 xo = *(const f32x4*)(xin + (size_t)row * D + col);
                const f32x4 xn = xo + acc[i][j];
                *(f32x4*)(F.p.out + (size_t)row * D + col) = xn;
                u32x2 w; w.x = pack2(xn[0], xn[1]); w.y = pack2(xn[2], xn[3]);
                *(u32x2*)(F.xb() + (size_t)row * D + col) = w;
                ss += (xn[0] * xn[0] + xn[1] * xn[1]) + (xn[2] * xn[2] + xn[3] * xn[3]);
            }
            ss += __shfl_xor(ss, 16); ss += __shfl_xor(ss, 32);
            if (fq == 0) F.ssq()[(size_t)row * 16 + pn * 2 + wn] = ss;
        }
    }
}

__device__ __forceinline__ void p5_final(const Frame& F) {
    for (int row = blockIdx.x * NWAVE + F.wave; row < T; row += gridDim.x * NWAVE) {
        float* xr = F.p.out + (size_t)row * D;
        f32x4 v[4]; float ss = 0.f;
#pragma unroll
        for (int i = 0; i < 4; ++i) { v[i] = *(const f32x4*)(xr + (i * 64 + F.lane) * 4); ss += v[i][0] * v[i][0] + v[i][1] * v[i][1] + v[i][2] * v[i][2] + v[i][3] * v[i][3]; }
        ss = wave_sum(ss);
        const float rs = rsqrtf(ss * (1.0f / D) + EPS);
#pragma unroll
        for (int i = 0; i < 4; ++i) { const f32x4 g = *(const f32x4*)(F.p.final_g + (i * 64 + F.lane) * 4); *(f32x4*)(xr + (i * 64 + F.lane) * 4) = v[i] * rs * g; }
    }
}

__global__ void __launch_bounds__(NTHR, 2) mk_fwd(Params p) {
    extern __shared__ __attribute__((aligned(16))) unsigned char lds[];
    Frame F0;
    F0.p = p; F0.lds = lds; F0.tid = threadIdx.x; F0.lane = F0.tid & 63; F0.wave = __builtin_amdgcn_readfirstlane(F0.tid >> 6);
    unsigned char* ws = p.ws;
    volatile LAS unsigned* ctl = (volatile LAS unsigned*)(LAS unsigned char*)lds;
    if (F0.tid < 4) ctl[F0.tid] = 0u;
    __syncthreads();
    const int lo = p.ph_lo, hi = p.ph_hi;
    XcdBarrier bar; bar.bar = (unsigned*)(ws + WS_BAR); bar.x = 0; bar.st = ctl;
    if (hi - lo > 1) bar = xcd_barrier_post((unsigned*)(ws + WS_BAR), ctl);

    for (int ph = lo; ph < hi; ++ph) {
        Frame G = F0;
        asm volatile("" : "+s"(G.p.ws), "+s"(G.p.out), "+s"(G.lds));
        asm volatile("" : "+v"(G.tid));
        G.lane = G.tid & 63; G.wave = __builtin_amdgcn_readfirstlane(G.tid >> 6);
        const Frame& F = G;
        if (ph == 0) { if (PHSEL & 1) p0_prologue(F); }
        else if (ph == NPHASE - 1) { if (PHSEL & 2) p5_final(F); }
        else {
            const int l = (ph - 1) >> 2, s = (ph - 1) & 3;
            if (s == 0) { if (PHSEL & 4) p1_inproj(F, l); }
            else if (s == 1) {
                for (int it = blockIdx.x; it < 64 + 256 + 64; it += gridDim.x) {
                    asm volatile("" : "+s"(G.p.ws), "+s"(G.lds));
                    asm volatile("" : "+v"(G.tid));
                    G.lane = G.tid & 63; G.wave = __builtin_amdgcn_readfirstlane(G.tid >> 6);
                    if (it < 64) { if (PHSEL & 8) p2_compress_item(F, l, it); }
                    else if (it < 320) { if (PHSEL & 16) p2_lru_item(F, l, it - 64); }
                    else { if (PHSEL & 1) p2_ropek_item(F, it - 320); }
                }
            } else if (s == 2) {
                float* wl = (float*)(F.lds + LDS_WORK) + F.wave * 2048;
                for (int it = blockIdx.x; it < 4096 + 256; it += gridDim.x) {
                    if (it < 256) { if (PHSEL & 1) p3_lru_item(F, it); }
                    else { if (PHSEL & 32) { const int task = (it - 256) * NWAVE + F.wave; p3_nsa_task(F, l, task >> 1, task & 1, wl); } }
                }
            } else { if (PHSEL & 64) p4_outproj(F, l); }
        }
        if (ph + 1 < hi) xcd_barrier(bar);
    }
}

extern "C" void kernel_launch(void* const* d_in, const int* in_sizes, int n_in, void* d_out, int out_size, void* d_ws, size_t ws_size, hipStream_t stream) {
    static int grid = 0;
    if (grid == 0) {
        if (n_in != 18 || out_size != T * D || ws_size < WS_END) { fprintf(stderr, "kernel_launch: unexpected shapes (n_in %d out %d ws %zu need %zu)\n", n_in, out_size, ws_size, (size_t)WS_END); grid = -1; return; }
        int dev = 0, cus = 0;
        if (hipGetDevice(&dev) != hipSuccess || hipDeviceGetAttribute(&cus, hipDeviceAttributeMultiprocessorCount, dev) != hipSuccess) { grid = -1; return; }
        if (hipFuncSetAttribute((const void*)mk_fwd, hipFuncAttributeMaxDynamicSharedMemorySize, LDS_BYTES) != hipSuccess) { fprintf(stderr, "kernel_launch: hipFuncSetAttribute failed\n"); grid = -1; return; }
        grid = cus;
    }
    if (grid < 0) return;
    (void)hipMemsetAsync((char*)d_ws + WS_BAR, 0, 16384, stream);
    Params p{};
    const float** pp = (const float**)&p;
    for (int i = 0; i < 18; ++i) pp[i] = (const float*)d_in[i];
    p.out = (float*)d_out; p.ws = (unsigned char*)d_ws;
#if MK_N_LAUNCHES == 1
    p.ph_lo = 0; p.ph_hi = NPHASE;
    hipLaunchKernelGGL(mk_fwd, dim3(grid), dim3(NTHR), LDS_BYTES, stream, p);
#else
    for (int ph = 0; ph < NPHASE; ++ph) { p.ph_lo = ph; p.ph_hi = ph + 1; hipLaunchKernelGGL(mk_fwd, dim3(grid), dim3(NTHR), LDS_BYTES, stream, p); }
#endif
}
```

```cpp
#include <hip/hip_runtime.h>
#include <stdint.h>
#include <cstdio>

#ifndef NSA_MODE
#define NSA_MODE 1
#endif
#define NSA_PROBE (NSA_MODE == 2)
#ifndef REP_PH
#define REP_PH 0
#endif
#ifndef PHSEL
#define PHSEL 0xFF
#endif
#ifndef MK_N_LAUNCHES
#define MK_N_LAUNCHES 1
#endif

typedef unsigned short bf16_t;
typedef short bf16x8 __attribute__((ext_vector_type(8)));
typedef float f32x4 __attribute__((ext_vector_type(4)));
typedef unsigned u32x4 __attribute__((ext_vector_type(4)));
typedef unsigned u32x2 __attribute__((ext_vector_type(2)));
#define LAS __attribute__((address_space(3)))
#define GAS __attribute__((address_space(1)))
typedef GAS const float* gcf;
template <class Tp> __device__ __forceinline__ Tp* asg(Tp* p) { return (Tp*)(GAS Tp*)p; }

constexpr int NB = 4, S = 4096, T = NB * S, D = 1024, DEPTH = 4;
constexpr int DLRU = 512, HLRU = 8, DIN = 2840, NPAD = 3072, ZLD = 2848;
constexpr int ZU = 0, ZGL = 512, ZQ = 1024, ZGN = 1536, ZKC = 2048, ZVC = 2176, ZKS = 2304, ZVS = 2432, ZKW = 2560, ZVW = 2688, ZGATE = 2816;
constexpr int NC = 255, NCP = 256, CMPH = 256, CMPK = 2048;
constexpr float EPS = 1e-6f, NEGF = -1e30f, SCALE = 0.125f;
constexpr int NTHR = 512, NWAVE = 8;
constexpr int NPHASE = 2 + 4 * DEPTH;

constexpr size_t al256(size_t x) { return (x + 255) & ~(size_t)255; }
constexpr size_t WS_PANEL = 14400;
constexpr size_t WS_PROBE = 15360;
constexpr size_t WS_BAR   = 0;
constexpr size_t WS_WTIN  = 16384;
constexpr size_t WS_WTOUT = WS_WTIN  + al256((size_t)DEPTH * NPAD * D * 2);
constexpr size_t WS_W1T   = WS_WTOUT + al256((size_t)DEPTH * D * D * 2);
constexpr size_t WS_W2T   = WS_W1T   + al256((size_t)DEPTH * 2 * CMPH * CMPK * 2);
constexpr size_t WS_WAT   = WS_W2T   + al256((size_t)DEPTH * 2 * 64 * CMPH * 2);
constexpr size_t WS_BIAS1 = WS_WAT   + al256((size_t)DEPTH * 2 * HLRU * 64 * 64 * 2);
constexpr size_t WS_LRUC  = WS_BIAS1 + al256((size_t)DEPTH * 2 * CMPH * 4);
constexpr size_t WS_ROPEC = WS_LRUC  + al256((size_t)DEPTH * DLRU * 4);
constexpr size_t WS_ROPES = WS_ROPEC + al256((size_t)S * 32 * 4);
constexpr size_t WS_XB    = WS_ROPES + al256((size_t)S * 32 * 4);
constexpr size_t WS_SSQ   = WS_XB    + al256((size_t)T * D * 2);
constexpr size_t WS_Z     = WS_SSQ   + al256((size_t)T * 16 * 4);
constexpr size_t WS_KR    = WS_Z     + al256((size_t)T * ZLD * 2);
constexpr size_t WS_KCMP  = WS_KR    + al256((size_t)T * 256 * 2);
constexpr size_t WS_VCMP  = WS_KCMP  + al256((size_t)NB * 2 * NCP * 64 * 2);
constexpr size_t WS_DBUF  = WS_VCMP  + al256((size_t)NB * 2 * NCP * 64 * 2);
constexpr size_t WS_AGG   = WS_DBUF  + al256((size_t)T * DLRU * 4);
constexpr size_t WS_YBUF  = WS_AGG   + al256((size_t)NB * 128 * DLRU * 2 * 4);
constexpr size_t WS_END   = WS_YBUF  + al256((size_t)T * D * 2);
static_assert(WS_END <= (size_t)256 * 1024 * 1024, "workspace map exceeds 256 MiB");
#ifndef WT_MASK
#define WT_MASK 255
#endif
typedef unsigned wt_u32x4 __attribute__((ext_vector_type(4)));
__device__ __forceinline__ void st16wt(const unsigned char* ws, const void* ptr, wt_u32x4 v) {
    const __amdgpu_buffer_rsrc_t r = __builtin_amdgcn_make_buffer_rsrc((void*)ws, (short)0, (int)WS_END, 0x00020000);
    __builtin_amdgcn_raw_buffer_store_b128(v, r, (unsigned)((const unsigned char*)ptr - ws), 0,   16);
}
__device__ __forceinline__ void st16wt_out(const float* out, const void* ptr, wt_u32x4 v) {
    const __amdgpu_buffer_rsrc_t r = __builtin_amdgcn_make_buffer_rsrc((void*)out, (short)0, (int)((size_t)T * D * 4), 0x00020000);
    __builtin_amdgcn_raw_buffer_store_b128(v, r, (unsigned)((const unsigned char*)ptr - (const unsigned char*)out), 0,   16);
}

constexpr int LDS_BYTES = 156 * 1024;
constexpr int LDS_CTL = 0;
constexpr int LDS_INP = 16;
constexpr int LDS_WORK = 256;

struct Params {
    const float *x, *norm_g, *w_in, *conv_w, *conv_b, *lru_wa, *lru_ba, *lru_wi, *lru_bi, *lru_lambda, *pos_k, *pos_v, *k_w1, *k_w2, *v_w1, *v_w2, *w_out, *final_g;
    float* out; unsigned char* ws;
    int ph_lo, ph_hi;
};

__device__ __forceinline__ bf16_t f2bf(float f) { unsigned u = __float_as_uint(f); u += 0x7fffu + ((u >> 16) & 1u); return (bf16_t)(u >> 16); }
__device__ __forceinline__ float bf2f(bf16_t h) { return __uint_as_float(((unsigned)h) << 16); }
__device__ __forceinline__ unsigned pack2(float lo, float hi) { return (unsigned)f2bf(lo) | ((unsigned)f2bf(hi) << 16); }
__device__ __forceinline__ unsigned cvtpk_(float lo, float hi) { unsigned r; asm("v_cvt_pk_bf16_f32 %0, %1, %2" : "=v"(r) : "v"(lo), "v"(hi)); return r; }
__device__ __forceinline__ float bflo(unsigned w) { return __uint_as_float(w << 16); }
__device__ __forceinline__ float bfhi(unsigned w) { return __uint_as_float(w & 0xffff0000u); }
__device__ __forceinline__ float sigmoidf_(float x) { return 1.0f / (1.0f + __expf(-x)); }
__device__ __forceinline__ float siluf_(float x) { return x / (1.0f + __expf(-x)); }
__device__ __forceinline__ float wave_max(float v) {
#pragma unroll
    for (int o = 32; o > 0; o >>= 1) v = fmaxf(v, __shfl_xor(v, o));
    return v; }
__device__ __forceinline__ float wave_sum(float v) {
#pragma unroll
    for (int o = 32; o > 0; o >>= 1) v += __shfl_xor(v, o);
    return v; }

#define XB_TMO      128
#define XB_XCNT(j)  (256  + 64 * (j))
#define XB_XSUB(j)  (1280 + 64 * (j))
#define XB_XGEN(j)  (2304 + 64 * (j))
#define XB_TOP      3328
#define XB_TOPGEN   3392
#define XCD_BAR_WORDS 3456
#define XB_SPIN_CAP (1u << 22)
__device__ __forceinline__ unsigned xb_ld(unsigned* p)              { return __hip_atomic_load(p, __ATOMIC_RELAXED, __HIP_MEMORY_SCOPE_AGENT); }
__device__ __forceinline__ unsigned xb_add(unsigned* p, unsigned v) { return __hip_atomic_fetch_add(p, v, __ATOMIC_RELAXED, __HIP_MEMORY_SCOPE_AGENT); }
__device__ __forceinline__ unsigned xb_xcc_id() { return (unsigned)__builtin_amdgcn_s_getreg((3 << 11) | 20) & 0xFu; }
#define XB_SPIN(cond, bar) do { unsigned _sp = 0; while (cond) { __builtin_amdgcn_s_sleep(1); \
    if ((++_sp & 255u) == 0u) { if (xb_ld(&(bar)[XB_TMO])) break; if (_sp > XB_SPIN_CAP) { atomicAdd(&(bar)[XB_TMO], 1u); break; } } } } while (0)
struct XcdBarrier { unsigned* bar; unsigned x; volatile LAS unsigned* st; };
__device__ __forceinline__ XcdBarrier xcd_barrier_post(unsigned* bar, volatile LAS unsigned* st) {
    XcdBarrier b; b.bar = bar; b.x = xb_xcc_id(); b.st = st;
    if (threadIdx.x == 0) (void)xb_add(&bar[XB_XCNT(b.x)], 1u);
    return b;
}
__device__ __forceinline__ void xcd_barrier_complete(unsigned* bar, unsigned x, unsigned& nloc, unsigned& nx) {
    const unsigned G = gridDim.x * gridDim.y * gridDim.z;
    unsigned sum, cnt, mine, sp = 0u;
    for (;;) {
        sum = 0u; cnt = 0u; mine = 0u;
#pragma unroll
        for (unsigned j = 0; j < 16; ++j) { const unsigned c = xb_ld(&bar[XB_XCNT(j)]); sum += c; cnt += (c > 0u) ? 1u : 0u; mine = (j == x) ? c : mine; }
        if (sum == G) break;
        __builtin_amdgcn_s_sleep(1);
        if ((++sp & 255u) == 0u) { if (xb_ld(&bar[XB_TMO])) break; if (sp > XB_SPIN_CAP) { atomicAdd(&bar[XB_TMO], 1u); break; } }
    }
    nloc = mine > 0u ? mine : 1u; nx = cnt > 0u ? cnt : 1u;
}
__device__ __forceinline__ void xcd_barrier(const XcdBarrier& b) {
    asm volatile("s_waitcnt vmcnt(0)" ::: "memory");
    __syncthreads();
    if (threadIdx.x == 0) {
        unsigned* bar = b.bar;
        __builtin_amdgcn_s_waitcnt(0);
        unsigned nloc = b.st[0], nx = b.st[1];
        if (nloc == 0u) { xcd_barrier_complete(bar, b.x, nloc, nx); b.st[0] = nloc; b.st[1] = nx; }
        const unsigned old = xb_add(&bar[XB_XSUB(b.x)], 1u);
        const unsigned gen = old / nloc;
        if (old + 1u == (gen + 1u) * nloc) {
            __builtin_amdgcn_fence(__ATOMIC_RELEASE, "agent");
            asm volatile("s_waitcnt vmcnt(0)" ::: "memory");
            const unsigned og = xb_add(&bar[XB_TOP], 1u);
            const unsigned tg = og / nx;
            if (og + 1u == (tg + 1u) * nx) xb_add(&bar[XB_TOPGEN], 1u);
            else XB_SPIN(xb_ld(&bar[XB_TOPGEN]) == tg, bar);
            __builtin_amdgcn_fence(__ATOMIC_ACQUIRE, "agent");
            xb_add(&bar[XB_XGEN(b.x)], 1u);
            asm volatile("s_waitcnt vmcnt(0)" ::: "memory");
        } else {
            XB_SPIN(xb_ld(&bar[XB_XGEN(b.x)]) == gen, bar);
            __builtin_amdgcn_fence(__ATOMIC_ACQUIRE, "agent");
            asm volatile("s_waitcnt vmcnt(0)" ::: "memory");
        }
    }
    __syncthreads();
}

struct Frame {
    Params p;
    LAS unsigned char* lds;
    int tid, lane, wave, bid;
    __device__ __forceinline__ gcf in(int i) const { const unsigned long long v = *(const LAS unsigned long long*)(lds + LDS_INP + 8 * i);
        const unsigned lo = __builtin_amdgcn_readfirstlane((unsigned)v), hi = __builtin_amdgcn_readfirstlane((unsigned)(v >> 32)); return (gcf)(((unsigned long long)hi << 32) | lo); }
    __device__ __forceinline__ bf16_t* wt_in()  const { return (bf16_t*)(p.ws + WS_WTIN); }
    __device__ __forceinline__ bf16_t* wt_out() const { return (bf16_t*)(p.ws + WS_WTOUT); }
    __device__ __forceinline__ bf16_t* w1t()    const { return (bf16_t*)(p.ws + WS_W1T); }
    __device__ __forceinline__ bf16_t* w2t()    const { return (bf16_t*)(p.ws + WS_W2T); }
    __device__ __forceinline__ bf16_t* wat()    const { return (bf16_t*)(p.ws + WS_WAT); }
    __device__ __forceinline__ float*  bias1()  const { return (float*)(p.ws + WS_BIAS1); }
    __device__ __forceinline__ float*  lruc()   const { return (float*)(p.ws + WS_LRUC); }
    __device__ __forceinline__ float*  ropec()  const { return (float*)(p.ws + WS_ROPEC); }
    __device__ __forceinline__ float*  ropes()  const { return (float*)(p.ws + WS_ROPES); }
    __device__ __forceinline__ bf16_t* xb()     const { return (bf16_t*)(p.ws + WS_XB); }
    __device__ __forceinline__ unsigned* lrus()  const { return (unsigned*)(p.ws + WS_DBUF); }
    __device__ __forceinline__ float*  abuf()   const { return (float*)(p.ws + WS_XB); }
    __device__ __forceinline__ float*  ssq()    const { return (float*)(p.ws + WS_SSQ); }
    __device__ __forceinline__ bf16_t* z()      const { return (bf16_t*)(p.ws + WS_Z); }
    __device__ __forceinline__ bf16_t* kr()     const { return (bf16_t*)(p.ws + WS_KR); }
    __device__ __forceinline__ bf16_t* kcmp()   const { return (bf16_t*)(p.ws + WS_KCMP); }
    __device__ __forceinline__ bf16_t* vcmp()   const { return (bf16_t*)(p.ws + WS_VCMP); }
    __device__ __forceinline__ float*  dbuf()   const { return (float*)(p.ws + WS_DBUF); }
    __device__ __forceinline__ float*  agg()    const { return (float*)(p.ws + WS_AGG); }
    __device__ __forceinline__ bf16_t* ybuf()   const { return (bf16_t*)(p.ws + WS_YBUF); }
};

template <int BM, int BN, int WM, int WN, int PF, class APtr>
__device__ __forceinline__ void gemm_mainloop(const APtr& aptr, const bf16_t* __restrict__ Bt, int ldb, int K, int n0, LAS unsigned char* smem,
                                              f32x4 (&acc)[BM / WM / 16][BN / WN / 16], int tid) {
    constexpr int MT = BM / WM / 16, NT = BN / WN / 16;
    constexpr int ACH = BM * 8 / NTHR, BCH = BN * 8 / NTHR;
    static_assert(ACH >= 1 && BCH >= 1, "tile too small for 512 threads");
    constexpr int ABYTES = BM * 128, BBYTES = BN * 128;
    const int lane = tid & 63, wave = tid >> 6, wm = wave / WN, wn = wave % WN;
    const int fr = lane & 15, fq = lane >> 4;
#pragma unroll
    for (int i = 0; i < MT; ++i)
#pragma unroll
        for (int j = 0; j < NT; ++j) acc[i][j] = (f32x4){0.f, 0.f, 0.f, 0.f};
    u32x4 ra[PF][ACH], rb[PF][BCH];
    const int nk = K / 64;
#define GM_LOAD(slot, kt_) do { const int k1_ = (kt_) * 64; \
        _Pragma("unroll") for (int i = 0; i < ACH; ++i) { const int idx = tid + NTHR * i, r = idx >> 3, c = idx & 7; ra[slot][i] = *(const u32x4*)(aptr(r, k1_) + c * 8); } \
        _Pragma("unroll") for (int i = 0; i < BCH; ++i) { const int idx = tid + NTHR * i, r = idx >> 3, c = idx & 7; rb[slot][i] = *(const u32x4*)(Bt + (size_t)(n0 + r) * ldb + k1_ + c * 8); } } while (0)
#define GM_WRITE(slot, buf_) do { LAS unsigned char* An = smem + (buf_) * ABYTES; LAS unsigned char* Bn = smem + 2 * ABYTES + (buf_) * BBYTES; \
        _Pragma("unroll") for (int i = 0; i < ACH; ++i) { const int idx = tid + NTHR * i, r = idx >> 3, c = idx & 7; *(LAS u32x4*)(An + r * 128 + ((c ^ (r & 7)) << 4)) = ra[slot][i]; } \
        _Pragma("unroll") for (int i = 0; i < BCH; ++i) { const int idx = tid + NTHR * i, r = idx >> 3, c = idx & 7; *(LAS u32x4*)(Bn + r * 128 + ((c ^ (r & 7)) << 4)) = rb[slot][i]; } } while (0)
#pragma unroll
    for (int s = 0; s < PF; ++s) if (s < nk) GM_LOAD(s, s);
    GM_WRITE(0, 0);
    __syncthreads();
    for (int kt0 = 0; kt0 < nk; kt0 += PF) {
#pragma unroll
        for (int u = 0; u < PF; ++u) {
            const int kt = kt0 + u;
            if (kt < nk) {
                const int cur = kt & 1;
                if (kt + PF < nk) GM_LOAD(u, kt + PF);
                const LAS unsigned char* As = smem + cur * ABYTES;
                const LAS unsigned char* Bs = smem + 2 * ABYTES + cur * BBYTES;
#pragma unroll
                for (int kk = 0; kk < 2; ++kk) {
                    bf16x8 af[MT], bfr[NT];
#pragma unroll
                    for (int i = 0; i < MT; ++i) { const int r = wm * MT * 16 + i * 16 + fr, c = kk * 4 + fq; af[i] = *(const LAS bf16x8*)(As + r * 128 + ((c ^ (r & 7)) << 4)); }
#pragma unroll
                    for (int j = 0; j < NT; ++j) { const int r = wn * NT * 16 + j * 16 + fr, c = kk * 4 + fq; bfr[j] = *(const LAS bf16x8*)(Bs + r * 128 + ((c ^ (r & 7)) << 4)); }
#pragma unroll
                    for (int i = 0; i < MT; ++i)
#pragma unroll
                        for (int j = 0; j < NT; ++j) acc[i][j] = __builtin_amdgcn_mfma_f32_16x16x32_bf16(bfr[j], af[i], acc[i][j], 0, 0, 0);
                }
                if (kt + 1 < nk) GM_WRITE((u + 1) % PF, cur ^ 1);
                __syncthreads();
            }
        }
    }
#undef GM_LOAD
#undef GM_WRITE
}

struct APlain { const bf16_t* A; int lda; int m0; __device__ __forceinline__ const bf16_t* operator()(int r, int k0) const { return A + (size_t)(m0 + r) * lda + k0; } };

namespace pg8 {
#define PG8_LAS __attribute__((address_space(3)))
typedef unsigned short bf16_t;
typedef short bf16x8 __attribute__((ext_vector_type(8)));
typedef float f32x4 __attribute__((ext_vector_type(4)));
typedef unsigned u32x4 __attribute__((ext_vector_type(4)));
constexpr int BM = 256, BK = 64, HALF = 128, HTB = HALF * BK * 2  , STAGE_BYTES = 8 * HTB, NXCD = 8, WGM = 8;

__host__ __device__ __forceinline__ int lds_byte(int r, int c) { const int st = (r >> 4) * 2 + (c >> 5), rr = r & 15, cc = c & 31, ob = rr * 64 + cc * 2; return st * 1024 + (ob ^ (((ob >> 9) & 1) << 5)); }
__host__ __device__ __forceinline__ void stage_rc(int b, int& R, int& C) { const int st = b / 1024, sb = b % 1024, swz = sb ^ (((sb >> 9) & 1) << 5); R = (st >> 1) * 16 + swz / 64; C = (st & 1) * 32 + (swz % 64) / 2; }
__host__ __device__ __forceinline__ int perm32(int rho) { const int n = rho >> 4, i = rho & 15; return 8 * (i >> 2) + 4 * n + (i & 3); }

struct Unit { int pm, pn; };
struct Gemm { const bf16_t* A; const bf16_t* Bt; int M, N, K; };

struct StaticOrder {
    int nM, nN, nwg, G, c;
    __host__ __device__ void init(int M, int N, int G_, int c_) { nM = M / BM; nN = N / BM; nwg = nM * nN; G = G_; c = c_; }
    __host__ __device__ bool next(int i, Unit& u) const {
        const long L = (long)i * G + c; if (L >= nwg) return false;
        int wgid = (int)L; { const int q = nwg / NXCD, r = nwg % NXCD, xcd = wgid % NXCD, off = wgid / NXCD; wgid = (xcd < r ? xcd * (q + 1) : r * (q + 1) + (xcd - r) * q) + off; }
        const int nig = WGM * nN, gid = wgid / nig, fm = gid * WGM, gsz = (nM - fm) < WGM ? (nM - fm) : WGM;
        u.pm = fm + ((wgid % nig) % gsz); u.pn = (wgid % nig) / gsz; return true;
    }
    __device__ __forceinline__ void a_ready(const Unit&) const {}
    __device__ __forceinline__ void done(const Unit&) const {}
};

__device__ __forceinline__ unsigned cvt_pk_bf16(float lo, float hi) { unsigned r; asm volatile("v_cvt_pk_bf16_f32 %0, %1, %2" : "=v"(r) : "v"(lo), "v"(hi)); return r; }
struct EpiInProj {
    static constexpr bool PERM = true, AFTER_DRAIN = false;
    bf16_t* Z; const float* ssq; int ldz, ncol; const unsigned char* ws;
    __device__ __forceinline__ void operator()(const f32x4 (&acc)[2][2][4][2], const Unit& u, int wr, int wc, int fr, int fq) const {
        const int row0 = u.pm * BM + wr * 64 + fr, col0 = u.pn * BM + wc * 32 + 8 * fq;
#pragma unroll
        for (int ai = 0; ai < 2; ++ai)
#pragma unroll
            for (int m = 0; m < 4; ++m) {
                const int row = row0 + ai * HALF + m * 16;
                const f32x4* sp = (const f32x4*)(ssq + (size_t)row * 16);
                const f32x4 s4 = (sp[0] + sp[1]) + (sp[2] + sp[3]);
                const float rs = __builtin_amdgcn_rsqf(((s4[0] + s4[1]) + (s4[2] + s4[3])) * (1.0f / 1024.0f) + 1e-6f);
                bf16_t* rowp = Z + (size_t)row * ldz;
#pragma unroll
                for (int bj = 0; bj < 2; ++bj) {
                    const int col = col0 + bj * HALF;
                    if (col < ncol) { const f32x4 v0 = acc[ai][bj][m][0] * rs, v1 = acc[ai][bj][m][1] * rs;
                        u32x4 w; w.x = cvt_pk_bf16(v0[0], v0[1]); w.y = cvt_pk_bf16(v0[2], v0[3]); w.z = cvt_pk_bf16(v1[0], v1[1]); w.w = cvt_pk_bf16(v1[2], v1[3]);
                        if constexpr ((WT_MASK & 1) != 0) st16wt(ws, rowp + col, w); else *(u32x4*)(rowp + col) = w; }
                }
            }
    }
};
template <bool FIRST> struct EpiOutProj {
    static constexpr bool PERM = true, AFTER_DRAIN = false;
    GAS const float* xin; bf16_t* xb; float* ssq; const unsigned char* ws;
    __device__ __forceinline__ void operator()(const f32x4 (&acc)[2][2][4][2], const Unit& u, int wr, int wc, int fr, int fq) const {
        const int row0 = u.pm * BM + wr * 64 + fr, col0 = u.pn * BM + wc * 32 + 8 * fq;
#pragma unroll
        for (int ai = 0; ai < 2; ++ai)
#pragma unroll
            for (int m = 0; m < 4; ++m) {
                const int row = row0 + ai * HALF + m * 16;
                float ss = 0.f;
#pragma unroll
                for (int bj = 0; bj < 2; ++bj) {
                    const size_t o = (size_t)row * 1024 + col0 + bj * HALF;
                    f32x4 v0, v1;
                    if constexpr (FIRST) { v0 = __builtin_nontemporal_load((GAS const f32x4*)(xin + o)) + acc[ai][bj][m][0]; v1 = __builtin_nontemporal_load((GAS const f32x4*)(xin + o + 4)) + acc[ai][bj][m][1]; }
                    else { const u32x4 xw = *(const u32x4*)(xb + o);
                        v0 = (f32x4){__uint_as_float(xw.x << 16), __uint_as_float(xw.x & 0xffff0000u), __uint_as_float(xw.y << 16), __uint_as_float(xw.y & 0xffff0000u)} + acc[ai][bj][m][0];
                        v1 = (f32x4){__uint_as_float(xw.z << 16), __uint_as_float(xw.z & 0xffff0000u), __uint_as_float(xw.w << 16), __uint_as_float(xw.w & 0xffff0000u)} + acc[ai][bj][m][1]; }
                    u32x4 w; w.x = cvt_pk_bf16(v0[0], v0[1]); w.y = cvt_pk_bf16(v0[2], v0[3]); w.z = cvt_pk_bf16(v1[0], v1[1]); w.w = cvt_pk_bf16(v1[2], v1[3]);
                    if constexpr ((WT_MASK & 2) != 0) st16wt(ws, xb + o, w); else *(u32x4*)(xb + o) = w;
                    ss += ((v0[0] * v0[0] + v0[1] * v0[1]) + (v0[2] * v0[2] + v0[3] * v0[3])) + ((v1[0] * v1[0] + v1[1] * v1[1]) + (v1[2] * v1[2] + v1[3] * v1[3]));
                }
                ss += __shfl_xor(ss, 16); ss += __shfl_xor(ss, 32);
                if (fq == 0) ssq[(size_t)row * 16 + u.pn * 4 + wc] = ss;
            }
    }
};

struct EpiOutFinal {
    static constexpr bool PERM = true, AFTER_DRAIN = true;
    const bf16_t* xb; float* out; GAS const float* gain; unsigned* slot; unsigned* cnt; unsigned* tmo;
    __device__ __forceinline__ void operator()(const f32x4 (&)[2][2][4][2], const Unit&, int, int, int, int) const {}
    __device__ __forceinline__ void fused(f32x4 (&acc)[2][2][4][2], const Unit& u, int wr, int wc, int fr, int fq, PG8_LAS unsigned char* lds, int wid, int lane) const {
        PG8_LAS float* P = (PG8_LAS float*)lds;
        PG8_LAS float* Sr = (PG8_LAS float*)(lds + 4096);
        const int row0 = u.pm * BM + wr * 64 + fr, col0 = u.pn * BM + wc * 32 + 8 * fq;
#pragma unroll
        for (int ai = 0; ai < 2; ++ai)
#pragma unroll
            for (int m = 0; m < 4; ++m) {
                const int row = row0 + ai * HALF + m * 16;
                float ss = 0.f;
#pragma unroll
                for (int bj = 0; bj < 2; ++bj) {
                    const u32x4 xw = *(const u32x4*)(xb + (size_t)row * 1024 + col0 + bj * HALF);
                    const f32x4 v0 = (f32x4){__uint_as_float(xw.x << 16), __uint_as_float(xw.x & 0xffff0000u), __uint_as_float(xw.y << 16), __uint_as_float(xw.y & 0xffff0000u)} + acc[ai][bj][m][0];
                    const f32x4 v1 = (f32x4){__uint_as_float(xw.z << 16), __uint_as_float(xw.z & 0xffff0000u), __uint_as_float(xw.w << 16), __uint_as_float(xw.w & 0xffff0000u)} + acc[ai][bj][m][1];
                    acc[ai][bj][m][0] = v0; acc[ai][bj][m][1] = v1;
                    ss += ((v0[0] * v0[0] + v0[1] * v0[1]) + (v0[2] * v0[2] + v0[3] * v0[3])) + ((v1[0] * v1[0] + v1[1] * v1[1]) + (v1[2] * v1[2] + v1[3] * v1[3]));
                }
                ss += __shfl_xor(ss, 16); ss += __shfl_xor(ss, 32);
                if (fq == 0) P[(ai * HALF + wr * 64 + m * 16 + fr) * 4 + wc] = ss;
            }
        asm volatile("s_waitcnt lgkmcnt(0)" ::: "memory"); __builtin_amdgcn_s_barrier(); asm volatile("" ::: "memory");
        const int rowl = wid * 32 + (lane & 31);
        if (lane < 32) { const f32x4 p4 = *(const PG8_LAS f32x4*)(P + rowl * 4);
            __hip_atomic_store(slot + (size_t)(u.pm * BM + rowl) * 4 + u.pn, __float_as_uint((p4[0] + p4[1]) + (p4[2] + p4[3])), __ATOMIC_RELAXED, __HIP_MEMORY_SCOPE_AGENT); }
        asm volatile("s_waitcnt vmcnt(0)" ::: "memory");
        if (lane == 0) __hip_atomic_fetch_add(cnt + 2 * u.pm, 1u, __ATOMIC_RELAXED, __HIP_MEMORY_SCOPE_AGENT);
        if (wid == 0) {
            unsigned sp = 0u;
            for (;;) {
                if ((unsigned)__builtin_amdgcn_readfirstlane(__hip_atomic_load(cnt + 2 * u.pm, __ATOMIC_RELAXED, __HIP_MEMORY_SCOPE_AGENT)) >= 32u) break;
                __builtin_amdgcn_s_sleep(2);
                if ((++sp & 255u) == 0u) { if (__hip_atomic_load(tmo, __ATOMIC_RELAXED, __HIP_MEMORY_SCOPE_AGENT)) break; if (sp > (1u << 22)) { if (lane == 0) __hip_atomic_fetch_add(tmo, 1u, __ATOMIC_RELAXED, __HIP_MEMORY_SCOPE_AGENT); break; } }
            }
            __builtin_amdgcn_fence(__ATOMIC_ACQUIRE, "agent");
        }
        asm volatile("s_waitcnt vmcnt(0) lgkmcnt(0)" ::: "memory"); __builtin_amdgcn_s_barrier(); asm volatile("" ::: "memory");
        if (lane < 32) { const unsigned* sl = slot + (size_t)(u.pm * BM + rowl) * 4; float t = 0.f;
#pragma unroll
            for (int k = 0; k < 4; ++k) t += __uint_as_float(__hip_atomic_load(sl + k, __ATOMIC_RELAXED, __HIP_MEMORY_SCOPE_AGENT));
            Sr[rowl] = 1.0f / sqrtf(t * (1.0f / 1024.0f) + 1e-6f); }
        asm volatile("s_waitcnt lgkmcnt(0)" ::: "memory"); __builtin_amdgcn_s_barrier(); asm volatile("" ::: "memory");
        f32x4 g[2][2];
#pragma unroll
        for (int bj = 0; bj < 2; ++bj)
#pragma unroll
            for (int n = 0; n < 2; ++n) g[bj][n] = *(GAS const f32x4*)(gain + col0 + bj * HALF + 4 * n);
#pragma unroll
        for (int ai = 0; ai < 2; ++ai)
#pragma unroll
            for (int m = 0; m < 4; ++m) {
                const int row = row0 + ai * HALF + m * 16;
                const float rs = Sr[ai * HALF + wr * 64 + m * 16 + fr];
#pragma unroll
                for (int bj = 0; bj < 2; ++bj)
#pragma unroll
                    for (int n = 0; n < 2; ++n) *(f32x4*)(out + (size_t)row * 1024 + col0 + bj * HALF + 4 * n) = acc[ai][bj][m][n] * rs * g[bj][n];
            }
    }
};

template <class Epi, class Sched, bool ALIGN_EPI = false, bool SP2 = false>
__device__ __forceinline__ void gemm_phase(PG8_LAS unsigned char* lds, const Gemm g, const Sched& S, const Epi& E, const int tid_in) {
    const int tid = tid_in, wid = __builtin_amdgcn_readfirstlane(tid >> 6), lane = tid & 63, wr = wid >> 2, wc = wid & 3, fr = lane & 15, fq = lane >> 4;
    const int K = g.K, nt = K / BK;
    unsigned voffA[2], voffB[2];
#pragma unroll
    for (int i = 0; i < 2; ++i) { int R, C; stage_rc(tid * 16 + i * 8192, R, C); const int Rb = Epi::PERM ? ((R & ~31) + perm32(R & 31)) : R;
        voffA[i] = (unsigned)(R * K + C) * 2u; voffB[i] = (unsigned)(Rb * K + C) * 2u; }
    const size_t kstep = (size_t)(BK * 2);
    const size_t hstep = (size_t)HALF * K * 2;
    const size_t tstep = 2 * hstep;
    const unsigned ldsw = (unsigned)wid * 1024u;
    const int aoff = lds_byte(wr * 64 + fr, fq * 8), boff = lds_byte(wc * 32 + fr, fq * 8);
#define PG8_SA(b, h) (((b) * 2 + (h)) * HTB)
#define PG8_SB(b, h) ((4 + (b) * 2 + (h)) * HTB)
#define PG8_STAGE(bufoff, gbase, voff) do { _Pragma("unroll") for (int _i = 0; _i < 2; ++_i) \
        __builtin_amdgcn_global_load_lds((const unsigned*)((const char*)(gbase) + (voff)[_i]), (PG8_LAS unsigned*)(lds + (bufoff) + ldsw + _i * 8192), 16, 0, 0); } while (0)
#define PG8_LDA(dst, b, h) do { _Pragma("unroll") for (int m = 0; m < 4; ++m) _Pragma("unroll") for (int k = 0; k < 2; ++k) dst[m][k] = *(const PG8_LAS bf16x8*)(lds + PG8_SA(b, h) + aoff + m * 2048 + k * 1024); } while (0)
#define PG8_LDB(dst, b, h) do { _Pragma("unroll") for (int n = 0; n < 2; ++n) _Pragma("unroll") for (int k = 0; k < 2; ++k) dst[n][k] = *(const PG8_LAS bf16x8*)(lds + PG8_SB(b, h) + boff + n * 2048 + k * 1024); } while (0)
#define PG8_MMA(ai, bj, At, Bt) do { __builtin_amdgcn_s_setprio(1); _Pragma("unroll") for (int m = 0; m < 4; ++m) _Pragma("unroll") for (int n = 0; n < 2; ++n) _Pragma("unroll") for (int k = 0; k < 2; ++k) \
        acc[ai][bj][m][n] = __builtin_amdgcn_mfma_f32_16x16x32_bf16(Bt[n][k], At[m][k], acc[ai][bj][m][n], 0, 0, 0); __builtin_amdgcn_s_setprio(0); } while (0)
#define PG8_WAIT_V(n) asm volatile("s_waitcnt vmcnt(" #n ")" ::: "memory")
#define PG8_WAIT_L(n) asm volatile("s_waitcnt lgkmcnt(" #n ")" ::: "memory")
#define PG8_BAR __builtin_amdgcn_s_barrier()
#define PG8_SCHED __builtin_amdgcn_sched_barrier(0)
    Unit cur, nxt; int ui = 0;
    if (!S.next(0, cur)) return;
    f32x4 acc[2][2][4][2];
#pragma unroll
    for (int a = 0; a < 2; ++a)
#pragma unroll
        for (int b = 0; b < 2; ++b)
#pragma unroll
            for (int m = 0; m < 4; ++m)
#pragma unroll
                for (int n = 0; n < 2; ++n) acc[a][b][m][n] = (f32x4){0.f, 0.f, 0.f, 0.f};
    bf16x8 At[4][2], B0[2][2], B1[2][2];
    const char* cA = (const char*)g.A + (size_t)cur.pm * tstep; const char* cB = (const char*)g.Bt + (size_t)cur.pn * tstep;
    S.a_ready(cur);
    if constexpr (SP2) {
        PG8_STAGE(PG8_SB(0, 0), cB, voffB); PG8_STAGE(PG8_SB(0, 1), cB + hstep, voffB); PG8_STAGE(PG8_SA(0, 0), cA, voffA); PG8_STAGE(PG8_SA(0, 1), cA + hstep, voffA);
        if (wr == 1) PG8_BAR;
        PG8_WAIT_V(2); PG8_BAR;
        PG8_STAGE(PG8_SB(1, 0), cB + kstep, voffB); PG8_STAGE(PG8_SA(1, 0), cA + kstep, voffA); PG8_STAGE(PG8_SB(1, 1), cB + hstep + kstep, voffB);
        PG8_WAIT_V(6); PG8_BAR;
    } else {
        PG8_STAGE(PG8_SB(0, 0), cB, voffB); PG8_STAGE(PG8_SA(0, 0), cA, voffA); PG8_STAGE(PG8_SB(0, 1), cB + hstep, voffB); PG8_STAGE(PG8_SA(0, 1), cA + hstep, voffA);
        if (wr == 1) PG8_BAR;
        PG8_WAIT_V(4); PG8_BAR;
        PG8_STAGE(PG8_SB(1, 0), cB + kstep, voffB); PG8_STAGE(PG8_SA(1, 0), cA + kstep, voffA); PG8_STAGE(PG8_SB(1, 1), cB + hstep + kstep, voffB);
        PG8_WAIT_V(6); PG8_BAR;
    }
    for (;;) {
        const bool has_next = S.next(ui + 1, nxt);
        const char* nA = has_next ? (const char*)g.A + (size_t)nxt.pm * tstep : cA; const char* nB = has_next ? (const char*)g.Bt + (size_t)nxt.pn * tstep : cB;
        for (int t = 0; t < nt; t += 2) {
            const bool last = (t == nt - 2);
            const char* a1 = cA + (size_t)(t + 1) * kstep;
            const char* a2 = last ? nA : cA + (size_t)(t + 2) * kstep; const char* b2 = last ? nB : cB + (size_t)(t + 2) * kstep;
            const char* a3 = a2 + kstep; const char* b3 = b2 + kstep;
            if (last && has_next) S.a_ready(nxt);
            if constexpr (SP2) {
            PG8_LDB(B0, 0, 0); PG8_LDB(B1, 0, 1); PG8_SCHED; PG8_LDA(At, 0, 0); PG8_STAGE(PG8_SA(1, 1), a1 + hstep, voffA);
            PG8_WAIT_V(8); PG8_WAIT_L(0); PG8_BAR; PG8_MMA(0, 0, At, B0); PG8_MMA(0, 1, At, B1); PG8_BAR; PG8_SCHED;
            PG8_LDA(At, 0, 1); PG8_STAGE(PG8_SB(0, 0), b2, voffB); PG8_STAGE(PG8_SB(0, 1), b2 + hstep, voffB); PG8_STAGE(PG8_SA(0, 0), a2, voffA);
            PG8_WAIT_V(8); PG8_WAIT_L(0); PG8_BAR; PG8_MMA(1, 0, At, B0); PG8_MMA(1, 1, At, B1); PG8_BAR; PG8_SCHED;
            PG8_LDB(B0, 1, 0); PG8_LDB(B1, 1, 1); PG8_SCHED; PG8_LDA(At, 1, 0); PG8_STAGE(PG8_SA(0, 1), a2 + hstep, voffA);
            PG8_WAIT_V(8); PG8_WAIT_L(0); PG8_BAR; PG8_MMA(0, 0, At, B0); PG8_MMA(0, 1, At, B1); PG8_BAR; PG8_SCHED;
            PG8_LDA(At, 1, 1); PG8_STAGE(PG8_SB(1, 0), b3, voffB); PG8_STAGE(PG8_SB(1, 1), b3 + hstep, voffB); PG8_STAGE(PG8_SA(1, 0), a3, voffA);
            PG8_WAIT_V(8); PG8_WAIT_L(0); PG8_BAR; PG8_MMA(1, 0, At, B0); PG8_MMA(1, 1, At, B1); PG8_BAR; PG8_SCHED;
            } else {
            PG8_LDB(B0, 0, 0); PG8_SCHED; PG8_LDA(At, 0, 0); PG8_STAGE(PG8_SA(1, 1), a1 + hstep, voffA);
            PG8_WAIT_L(8); PG8_BAR; PG8_WAIT_L(0); PG8_MMA(0, 0, At, B0); PG8_BAR; PG8_SCHED;
            PG8_LDB(B1, 0, 1); PG8_STAGE(PG8_SB(0, 0), b2, voffB);
            PG8_BAR; PG8_WAIT_L(0); PG8_MMA(0, 1, At, B1); PG8_BAR;
            PG8_LDA(At, 0, 1); PG8_STAGE(PG8_SA(0, 0), a2, voffA);
            PG8_BAR; PG8_WAIT_L(0); PG8_MMA(1, 0, At, B0); PG8_BAR; PG8_SCHED;
            PG8_STAGE(PG8_SB(0, 1), b2 + hstep, voffB);
            PG8_WAIT_V(6); PG8_BAR; PG8_MMA(1, 1, At, B1); PG8_BAR;
            PG8_LDB(B0, 1, 0); PG8_SCHED; PG8_LDA(At, 1, 0); PG8_STAGE(PG8_SA(0, 1), a2 + hstep, voffA);
            PG8_WAIT_L(8); PG8_BAR; PG8_WAIT_L(0); PG8_MMA(0, 0, At, B0); PG8_BAR; PG8_SCHED;
            PG8_LDB(B1, 1, 1); PG8_STAGE(PG8_SB(1, 0), b3, voffB);
            PG8_BAR; PG8_WAIT_L(0); PG8_MMA(0, 1, At, B1); PG8_BAR;
            PG8_LDA(At, 1, 1); PG8_STAGE(PG8_SA(1, 0), a3, voffA);
            PG8_BAR; PG8_WAIT_L(0); PG8_MMA(1, 0, At, B0); PG8_BAR; PG8_SCHED;
            PG8_STAGE(PG8_SB(1, 1), b3 + hstep, voffB);
            PG8_WAIT_V(6); PG8_BAR; PG8_MMA(1, 1, At, B1); PG8_BAR;
            }
        }
        if constexpr (ALIGN_EPI) { if (wr == 0) PG8_BAR; }
        if constexpr (!Epi::AFTER_DRAIN) { E(acc, cur, wr, wc, fr, fq); S.done(cur); }
        if (!has_next) break;
#pragma unroll
        for (int a = 0; a < 2; ++a)
#pragma unroll
            for (int b = 0; b < 2; ++b)
#pragma unroll
                for (int m = 0; m < 4; ++m)
#pragma unroll
                    for (int n = 0; n < 2; ++n) acc[a][b][m][n] = (f32x4){0.f, 0.f, 0.f, 0.f};
        cur = nxt; cA = nA; cB = nB; ++ui;
        if constexpr (ALIGN_EPI) { if (wr == 1) PG8_BAR; }
    }
    PG8_WAIT_V(0);
    if constexpr (!ALIGN_EPI) { if (wr == 0) PG8_BAR; }
    PG8_BAR;
    if constexpr (Epi::AFTER_DRAIN) { E.fused(acc, cur, wr, wc, fr, fq, lds, wid, lane); S.done(cur); }
#undef PG8_SA
#undef PG8_SB
#undef PG8_STAGE
#undef PG8_LDA
#undef PG8_LDB
#undef PG8_MMA
#undef PG8_WAIT_V
#undef PG8_WAIT_L
#undef PG8_BAR
#undef PG8_SCHED
}
}

__device__ __forceinline__ void tr_tile(const Frame& F, gcf src, int R, int C, int ld_src, bf16_t* __restrict__ dst, int ld_dst, int Cpad, gcf rowscale, int r0, int c0) {
    LAS float* tile = (LAS float*)(F.lds + LDS_WORK);
#pragma unroll
    for (int i = 0; i < 2; ++i) {
        const int idx = F.tid + NTHR * i, rl = idx >> 4, c4 = (idx & 15) * 4;
        const int r = r0 + rl, c = c0 + c4;
        f32x4 v = (f32x4){0.f, 0.f, 0.f, 0.f};
        if (c < C) { v = __builtin_nontemporal_load((GAS const f32x4*)(src + (size_t)r * ld_src + c)); if (rowscale) v = v * rowscale[r]; }
        tile[rl * 65 + c4] = v[0]; tile[rl * 65 + c4 + 1] = v[1]; tile[rl * 65 + c4 + 2] = v[2]; tile[rl * 65 + c4 + 3] = v[3];
    }
    __syncthreads();
    {
        const int cl = F.tid >> 3, rg = (F.tid & 7) * 8;
        const int c = c0 + cl;
        if (c < Cpad) {
            u32x4 w;
            w.x = pack2(tile[(rg + 0) * 65 + cl], tile[(rg + 1) * 65 + cl]); w.y = pack2(tile[(rg + 2) * 65 + cl], tile[(rg + 3) * 65 + cl]);
            w.z = pack2(tile[(rg + 4) * 65 + cl], tile[(rg + 5) * 65 + cl]); w.w = pack2(tile[(rg + 6) * 65 + cl], tile[(rg + 7) * 65 + cl]);
            if constexpr ((WT_MASK & 4) != 0) st16wt(F.p.ws, dst + (size_t)c * ld_dst + r0 + rg, w); else *(u32x4*)(dst + (size_t)c * ld_dst + r0 + rg) = w;
        }
    }
    __syncthreads();
}

__device__ __forceinline__ void prep_layer(const Frame& F, int l) {
    const int G = gridDim.x, bid = F.bid;
    constexpr int T_IN = 16 * 48, T_OUT = 16 * 16, T_W1 = 32 * 4, T_W2 = 4, T_G = 8;
    constexpr int PER_L = T_IN + T_OUT + 2 * T_W1 + 2 * T_W2 + 2 * T_G;
    for (int it = bid; it < PER_L; it += G) {
        int j = it;
        if (j < T_IN) { tr_tile(F, F.in(2) + (size_t)l * D * DIN, D, DIN, DIN, F.wt_in() + (size_t)l * NPAD * D, D, NPAD, F.in(1) + l * D, (j % 16) * 64, (j / 16) * 64); continue; }
        j -= T_IN;
        if (j < T_OUT) { tr_tile(F, F.in(16) + (size_t)l * D * D, D, D, D, F.wt_out() + (size_t)l * D * D, D, D, nullptr, (j % 16) * 64, (j / 16) * 64); continue; }
        j -= T_OUT;
        if (j < 2 * T_W1) { const int kv = j / T_W1, jj = j % T_W1; gcf src = (kv ? F.in(14) : F.in(12)) + (size_t)l * CMPK * CMPH;
            tr_tile(F, src, CMPK, CMPH, CMPH, F.w1t() + (size_t)(l * 2 + kv) * CMPH * CMPK, CMPK, CMPH, nullptr, (jj % 32) * 64, (jj / 32) * 64); continue; }
        j -= 2 * T_W1;
        if (j < 2 * T_W2) { const int kv = j / T_W2, jj = j % T_W2; gcf src = (kv ? F.in(15) : F.in(13)) + (size_t)l * CMPH * 64;
            tr_tile(F, src, CMPH, 64, 64, F.w2t() + (size_t)(l * 2 + kv) * 64 * CMPH, CMPH, 64, nullptr, jj * 64, 0); continue; }
        j -= 2 * T_W2;
        { const int gsel = j / T_G, h = j % T_G; gcf src = (gsel ? F.in(7) : F.in(5)) + ((size_t)l * HLRU + h) * 64 * 64;
            tr_tile(F, src, 64, 64, 64, F.wat() + ((size_t)(l * 2 + gsel) * HLRU + h) * 64 * 64, 64, 64, nullptr, 0, 0); }
    }
    {
        LAS float* red = (LAS float*)(F.lds + LDS_WORK);
        for (int it = G - 1 - bid; it < 2 * 8; it += G) {
            const int kv = (it >> 3) & 1, jb = it & 7;
            gcf w1 = (kv ? F.in(14) : F.in(12)) + (size_t)l * CMPK * CMPH;
            gcf pos = (kv ? F.in(11) : F.in(10)) + (size_t)l * CMPK;
            const int j = jb * 32 + (F.tid & 31), ks = F.tid >> 5;
            float s = 0.f;
#pragma unroll 1
            for (int k0 = ks * 128; k0 < ks * 128 + 128; k0 += 16) {
                float wv[16], pv[16];
#pragma unroll
                for (int i = 0; i < 16; ++i) { wv[i] = w1[(size_t)(k0 + i) * CMPH + j]; pv[i] = pos[k0 + i]; }
#pragma unroll
                for (int i = 0; i < 16; ++i) s += pv[i] * wv[i];
            }
            red[ks * 32 + (F.tid & 31)] = s;
            __syncthreads();
            if (F.tid < 32) { float t = 0.f;
#pragma unroll
                for (int q = 0; q < 16; ++q) t += red[q * 32 + F.tid];
                F.bias1()[(l * 2 + kv) * CMPH + j] = t; }
            __syncthreads();
        }
    }
    for (int i = bid * NTHR + F.tid; i < DLRU; i += G * NTHR) {
        const float lm = F.in(9)[l * DLRU + i];
        const float sp = (lm > 20.f) ? expf(-lm) : log1pf(expf(-lm));
        F.lruc()[l * DLRU + i] = -8.0f * sp * 1.4426950408889634f;
    }
}

__device__ __forceinline__ void p0_prologue(const Frame& F) {
    const int G = gridDim.x, bid = F.bid;
    prep_layer(F, 0);
    for (int i = bid * NTHR + F.tid; i < S * 32; i += G * NTHR) {
        const int t = i >> 5, f = i & 31;
        const float inv = 1.0f / powf(10000.0f, (float)(2 * f) / 64.0f);
        const float ang = (float)t * inv;
        F.ropec()[i] = cosf(ang); F.ropes()[i] = sinf(ang);
    }
    for (int row = bid * NWAVE + F.wave; row < T; row += G * NWAVE) {
        gcf xr = F.in(0) + (size_t)row * D;
        float ss = 0.f;
#pragma unroll
        for (int i = 0; i < 2; ++i) {
            const f32x4 v = __builtin_nontemporal_load((GAS const f32x4*)(xr + (i * 64 + F.lane) * 8)), v2 = __builtin_nontemporal_load((GAS const f32x4*)(xr + (i * 64 + F.lane) * 8 + 4));
            ss += (v[0] * v[0] + v[1] * v[1] + v[2] * v[2] + v[3] * v[3]) + (v2[0] * v2[0] + v2[1] * v2[1] + v2[2] * v2[2] + v2[3] * v2[3]);
            u32x4 w; w.x = pack2(v[0], v[1]); w.y = pack2(v[2], v[3]); w.z = pack2(v2[0], v2[1]); w.w = pack2(v2[2], v2[3]);
            if constexpr ((WT_MASK & 64) != 0) st16wt(F.p.ws, F.xb() + (size_t)row * D + (i * 64 + F.lane) * 8, w); else *(u32x4*)(F.xb() + (size_t)row * D + (i * 64 + F.lane) * 8) = w;
        }
        ss = wave_sum(ss);
        if (F.lane < 16) F.ssq()[(size_t)row * 16 + F.lane] = (F.lane == 0) ? ss : 0.f;
    }
}

__device__ __forceinline__ void p1_inproj(const Frame& F, int l) {
    pg8::Gemm g{F.xb(), F.wt_in() + (size_t)l * NPAD * D, T, NPAD, D};
    pg8::StaticOrder So; So.init(T, NPAD, (int)gridDim.x, F.bid);
    pg8::EpiInProj E{F.z(), F.ssq(), ZLD, DIN, F.p.ws};
    pg8::gemm_phase<pg8::EpiInProj, pg8::StaticOrder, true, true>(F.lds + LDS_WORK, g, So, E, F.tid);
}

struct ACmp { const bf16_t* z; int zoff; int m0; __device__ __forceinline__ const bf16_t* operator()(int r, int k0) const {
    int m = m0 + r; if (m > NB * NC * 2 - 1) m = NB * NC * 2 - 1;
    const int h = m & 1, bc = m >> 1, b = bc / NC, c = bc % NC;
    return z + (size_t)(b * S + 16 * c + (k0 >> 6)) * ZLD + zoff + h * 64; } };

__device__ __forceinline__ void p2_compress_item(const Frame& F, int l, int item) {
    constexpr int BM = 64, BN = 256;
    const int kv = item & 1, mt0 = item >> 1;
    LAS unsigned char* smem = F.lds + LDS_WORK;
    LAS bf16_t* hid = (LAS bf16_t*)(smem + 2 * BM * 128 + 2 * BN * 128);
    constexpr int HLD = 264;
    f32x4 acc[4][2];
    ACmp ap{F.z(), kv ? ZVC : ZKC, mt0 * BM};
    gemm_mainloop<BM, BN, 1, 8, 3>(ap, F.w1t() + (size_t)(l * 2 + kv) * CMPH * CMPK, CMPK, CMPK, 0, smem, acc, F.tid);
    const int fr = F.lane & 15, fq = F.lane >> 4;
    const float* b1 = F.bias1() + (l * 2 + kv) * CMPH;
#pragma unroll
    for (int i = 0; i < 4; ++i)
#pragma unroll
        for (int j = 0; j < 2; ++j) {
            const int col = F.wave * 32 + j * 16 + 4 * fq, row = i * 16 + fr;
            const f32x4 bb = *(const f32x4*)(b1 + col);
            u32x2 w; w.x = pack2(siluf_(acc[i][j][0] + bb[0]), siluf_(acc[i][j][1] + bb[1])); w.y = pack2(siluf_(acc[i][j][2] + bb[2]), siluf_(acc[i][j][3] + bb[3]));
            *(LAS u32x2*)(hid + row * HLD + col) = w;
        }
    __syncthreads();
    const bf16_t* w2 = F.w2t() + (size_t)(l * 2 + kv) * 64 * CMPH;
    const int mt = F.wave >> 1;
    f32x4 o[2] = {(f32x4){0.f, 0.f, 0.f, 0.f}, (f32x4){0.f, 0.f, 0.f, 0.f}};
#pragma unroll
    for (int kk = 0; kk < 8; ++kk) {
        const bf16x8 a = *(const LAS bf16x8*)(hid + (mt * 16 + fr) * HLD + kk * 32 + fq * 8);
#pragma unroll
        for (int j = 0; j < 2; ++j) {
            const int n = ((F.wave & 1) * 2 + j) * 16 + fr;
            const bf16x8 b = *(const bf16x8*)(w2 + (size_t)n * CMPH + kk * 32 + fq * 8);
            o[j] = __builtin_amdgcn_mfma_f32_16x16x32_bf16(b, a, o[j], 0, 0, 0);
        }
    }
    const int m = mt0 * BM + mt * 16 + fr;
    if (m < NB * NC * 2) {
        const int h = m & 1, bc = m >> 1, b = bc / NC, c = bc % NC;
        bf16_t* dst = (kv ? F.vcmp() : F.kcmp()) + ((size_t)(b * 2 + h) * NCP + c) * 64;
#pragma unroll
        for (int j = 0; j < 2; ++j) { const int col = ((F.wave & 1) * 2 + j) * 16 + 4 * fq; u32x2 w; w.x = pack2(o[j][0], o[j][1]); w.y = pack2(o[j][2], o[j][3]); *(u32x2*)(dst + col) = w; }
    }
    __syncthreads();
}

__device__ __forceinline__ void p2_lru_item(const Frame& F, int l, int item) {
    const Params& p = F.p;
    const int b = item >> 7, ch = item & 127, t0 = ch * 32;
    const size_t tok0 = (size_t)b * S + t0;
    constexpr int ULD = 520;
    LAS bf16_t* U = (LAS bf16_t*)(F.lds + LDS_WORK);
    LAS bf16_t* UC = U + 35 * ULD + 8;
    constexpr int CLD = 72;
    float kw0[4], kw1[4], kw2[4], kw3[4], kbb[4], kbra[4], kbri[4], kc1[4];
    {
        gcf cw_ = F.in(3) + (size_t)l * 4 * DLRU; gcf cb_ = F.in(4) + (size_t)l * DLRU; gcf ba_ = F.in(6) + (size_t)l * DLRU; gcf bi2_ = F.in(8) + (size_t)l * DLRU; const float* lc_ = F.lruc() + (size_t)l * DLRU;
#pragma unroll
        for (int j = 0; j < 4; ++j) { const int chn = 64 * F.wave + 16 * j + (F.lane & 15);
            kw0[j] = cw_[chn]; kw1[j] = cw_[DLRU + chn]; kw2[j] = cw_[2 * DLRU + chn]; kw3[j] = cw_[3 * DLRU + chn]; kbb[j] = cb_[chn];
            kbra[j] = ba_[chn] * -1.4426950408889634f; kbri[j] = bi2_[chn] * -1.4426950408889634f; kc1[j] = lc_[chn]; }
    }
    for (int idx = F.tid; idx < 35 * 64; idx += NTHR) {
        const int r = idx >> 6, c = idx & 63; const int t = t0 - 3 + r;
        u32x4 v = (u32x4){0u, 0u, 0u, 0u};
        if (t >= 0) v = *(const u32x4*)(F.z() + ((size_t)b * S + t) * ZLD + ZU + c * 8);
        *(LAS u32x4*)(U + r * ULD + c * 8) = v;
    }
    __syncthreads();
    const int h = F.wave, fr = F.lane & 15, fq = F.lane >> 4;
    LAS bf16_t* uc = UC + F.wave * 32 * CLD;
#pragma unroll
    for (int nt = 0; nt < 4; ++nt) {
        const int chn = 64 * h + 16 * nt + fr;
        const float w0 = kw0[nt], w1 = kw1[nt], w2 = kw2[nt], w3 = kw3[nt], bb = kbb[nt];
#pragma unroll
        for (int mt = 0; mt < 2; ++mt) {
            float u[7];
#pragma unroll
            for (int q = 0; q < 7; ++q) u[q] = bf2f(U[(16 * mt + 4 * fq + q) * ULD + chn]);
#pragma unroll
            for (int r = 0; r < 4; ++r) uc[(16 * mt + 4 * fq + r) * CLD + 16 * nt + fr] = f2bf(w0 * u[r] + w1 * u[r + 1] + w2 * u[r + 2] + w3 * u[r + 3] + bb);
        }
    }
    __builtin_amdgcn_s_waitcnt(0xC07F);
    __builtin_amdgcn_wave_barrier();
    const bf16_t* wr_ = F.wat() + ((size_t)(l * 2 + 0) * HLRU + h) * 4096;
    const bf16_t* wi_ = F.wat() + ((size_t)(l * 2 + 1) * HLRU + h) * 4096;
    unsigned* lrs = F.lrus();
    LAS unsigned* ost = (LAS unsigned*)(UC + 8 * 32 * CLD) + F.wave * (32 * 68);
    bf16x8 brn[2], bin[2];
#pragma unroll
    for (int kk = 0; kk < 2; ++kk) { brn[kk] = *(const bf16x8*)(wr_ + fr * 64 + kk * 32 + fq * 8); bin[kk] = *(const bf16x8*)(wi_ + fr * 64 + kk * 32 + fq * 8); }
#pragma unroll
    for (int j = 0; j < 4; ++j) {
        const int chn = 64 * h + 16 * j + fr;
        bf16x8 br[2], bi[2];
#pragma unroll
        for (int kk = 0; kk < 2; ++kk) { br[kk] = brn[kk]; bi[kk] = bin[kk]; }
        { const int jn = j < 3 ? j + 1 : 3;
#pragma unroll
          for (int kk = 0; kk < 2; ++kk) { brn[kk] = *(const bf16x8*)(wr_ + (16 * jn + fr) * 64 + kk * 32 + fq * 8); bin[kk] = *(const bf16x8*)(wi_ + (16 * jn + fr) * 64 + kk * 32 + fq * 8); } }
        const float w0 = kw0[j], w1 = kw1[j], w2 = kw2[j], w3 = kw3[j], bb = kbb[j];
        const float bra = kbra[j], bri = kbri[j], c1 = kc1[j];
        float Arun = 1.f, Hrun = 0.f;
        LAS unsigned* ap_ = ost + (4 * fq) * 68 + 16 * j + fr;
#pragma unroll
        for (int mt = 0; mt < 2; ++mt) {
            f32x4 ar = (f32x4){0.f, 0.f, 0.f, 0.f}, ai = (f32x4){0.f, 0.f, 0.f, 0.f};
#pragma unroll
            for (int kk = 0; kk < 2; ++kk) {
                const bf16x8 af = *(const LAS bf16x8*)(uc + (16 * mt + fr) * CLD + kk * 32 + fq * 8);
                ar = __builtin_amdgcn_mfma_f32_16x16x32_bf16(af, br[kk], ar, 0, 0, 0); ai = __builtin_amdgcn_mfma_f32_16x16x32_bf16(af, bi[kk], ai, 0, 0, 0);
            }
            float u[7];
#pragma unroll
            for (int q = 0; q < 7; ++q) u[q] = bf2f(U[(16 * mt + 4 * fq + q) * ULD + chn]);
            float apf[4], hpf[4];
            float a4 = 1.f, h4 = 0.f;
#pragma unroll
            for (int r = 0; r < 4; ++r) {
                const float ucv = w0 * u[r] + w1 * u[r + 1] + w2 * u[r + 2] + w3 * u[r + 3] + bb;
                const float rg = __builtin_amdgcn_rcpf(1.0f + __builtin_amdgcn_exp2f(__builtin_fmaf(ar[r], -1.4426950408889634f, bra)));
                const float ig = __builtin_amdgcn_rcpf(1.0f + __builtin_amdgcn_exp2f(__builtin_fmaf(ai[r], -1.4426950408889634f, bri)));
                const float e2 = c1 * rg;
                const float av = __builtin_amdgcn_exp2f(e2);
                const float x = e2 * 1.3862943611198906f;
                float pl = __builtin_fmaf(x, 1.0f / 6.0f, 1.0f); pl = __builtin_fmaf(x * (1.0f / 5.0f), pl, 1.0f);
                pl = __builtin_fmaf(x * 0.25f, pl, 1.0f); pl = __builtin_fmaf(x * (1.0f / 3.0f), pl, 1.0f); pl = __builtin_fmaf(x * 0.5f, pl, 1.0f);
                const float dr = sqrtf(-x * pl) * (ig * ucv);
                h4 = av * h4 + dr; a4 *= av;
                apf[r] = a4; hpf[r] = h4;
            }
            float Ea, Eh, Ta, Th;
            { const float pa = __shfl_xor(a4, 16), ph = __shfl_xor(h4, 16);
              const float pairA = a4 * pa, pairH = (fq & 1) ? (a4 * ph + h4) : (pa * h4 + ph);
              const float qa = __shfl_xor(pairA, 32), qh = __shfl_xor(pairH, 32);
              Ta = pairA * qa; Th = (fq & 2) ? (pairA * qh + pairH) : (qa * pairH + qh);
              const float e1a = (fq & 1) ? pa : 1.f, e1h = (fq & 1) ? ph : 0.f;
              const float e2a = (fq & 2) ? qa : 1.f, e2h = (fq & 2) ? qh : 0.f;
              Ea = e2a * e1a; Eh = e1a * e2h + e1h; }
            const float Ca = Arun * Ea, Ch = Ea * Hrun + Eh;
#pragma unroll
            for (int r = 0; r < 4; ++r) ap_[(16 * mt + r) * 68] = cvtpk_(Ca * apf[r], apf[r] * Ch + hpf[r]);
            Hrun = Ta * Hrun + Th; Arun *= Ta;
        }
        if (fq == 0) { float* ag = F.agg() + ((size_t)(b * 128 + ch) * DLRU + chn) * 2; *(float2*)ag = make_float2(Arun, Hrun); }
    }
    __builtin_amdgcn_s_waitcnt(0xC07F);
    __builtin_amdgcn_wave_barrier();
#pragma unroll
    for (int i = 0; i < 8; ++i) {
        const int id = i * 64 + F.lane, tk = id >> 4, c4 = (id & 15) * 4;
        if constexpr ((WT_MASK & 32) != 0) st16wt(F.p.ws, lrs + (tok0 + tk) * DLRU + 64 * h + c4, *(const LAS u32x4*)(ost + tk * 68 + c4)); else *(u32x4*)(lrs + (tok0 + tk) * DLRU + 64 * h + c4) = *(const LAS u32x4*)(ost + tk * 68 + c4);
    }
    __syncthreads();
}

__device__ __forceinline__ void p2_ropek_item(const Frame& F, int item) {
    for (int e = F.tid; e < 256 * 16; e += NTHR) {
        const int fg = e & 3, hh = (e >> 2) & 3, tl = e >> 4;
        const int tok = item * 256 + tl, t = tok & (S - 1);
        const bf16_t* zr = F.z() + (size_t)tok * ZLD + ((hh < 2 ? ZKS : ZKW) + (hh & 1) * 64) + fg * 8;
        const u32x4 a = *(const u32x4*)zr, bq = *(const u32x4*)(zr + 32);
        const float* cp = F.ropec() + t * 32 + fg * 8; const float* sp = F.ropes() + t * 32 + fg * 8;
        const f32x4 c0 = *(const f32x4*)cp, c1 = *(const f32x4*)(cp + 4), s0 = *(const f32x4*)sp, s1 = *(const f32x4*)(sp + 4);
        const float x1[8] = {bflo(a.x), bfhi(a.x), bflo(a.y), bfhi(a.y), bflo(a.z), bfhi(a.z), bflo(a.w), bfhi(a.w)};
        const float x2[8] = {bflo(bq.x), bfhi(bq.x), bflo(bq.y), bfhi(bq.y), bflo(bq.z), bfhi(bq.z), bflo(bq.w), bfhi(bq.w)};
        float o1[8], o2[8];
#pragma unroll
        for (int j = 0; j < 8; ++j) { const float c = j < 4 ? c0[j & 3] : c1[j & 3], s = j < 4 ? s0[j & 3] : s1[j & 3]; o1[j] = x1[j] * c - x2[j] * s; o2[j] = x2[j] * c + x1[j] * s; }
        bf16_t* d = F.kr() + (size_t)tok * 256 + hh * 64 + fg * 8;
        u32x4 w1, w2; w1.x = pack2(o1[0], o1[1]); w1.y = pack2(o1[2], o1[3]); w1.z = pack2(o1[4], o1[5]); w1.w = pack2(o1[6], o1[7]);
        w2.x = pack2(o2[0], o2[1]); w2.y = pack2(o2[2], o2[3]); w2.z = pack2(o2[4], o2[5]); w2.w = pack2(o2[6], o2[7]);
        if constexpr ((WT_MASK & 8) != 0) { st16wt(F.p.ws, d, w1); st16wt(F.p.ws, d + 32, w2); } else { *(u32x4*)d = w1; *(u32x4*)(d + 32) = w2; }
    }
}

__device__ __forceinline__ void dot4(const bf16_t* krow, const LAS float* qs, float& d0, float& d1, float& d2, float& d3) {
    d0 = 0.f; d1 = 0.f; d2 = 0.f; d3 = 0.f;
#pragma unroll
    for (int c = 0; c < 8; ++c) {
        const u32x4 kw = *(const u32x4*)(krow + c * 8);
        const float kf[8] = {bflo(kw.x), bfhi(kw.x), bflo(kw.y), bfhi(kw.y), bflo(kw.z), bfhi(kw.z), bflo(kw.w), bfhi(kw.w)};
#pragma unroll
        for (int e4 = 0; e4 < 2; ++e4) {
            const f32x4 q0 = *(const LAS f32x4*)(qs + c * 8 + e4 * 4), q1 = *(const LAS f32x4*)(qs + 64 + c * 8 + e4 * 4), q2 = *(const LAS f32x4*)(qs + 128 + c * 8 + e4 * 4), q3 = *(const LAS f32x4*)(qs + 192 + c * 8 + e4 * 4);
#pragma unroll
            for (int e = 0; e < 4; ++e) { const float kk = kf[e4 * 4 + e]; d0 += q0[e] * kk; d1 += q1[e] * kk; d2 += q2[e] * kk; d3 += q3[e] * kk; }
        }
    }
}

struct OS { float m[4], l[4], o[4]; };
__device__ __forceinline__ void os_init(OS& s) {
#pragma unroll
    for (int g = 0; g < 4; ++g) { s.m[g] = NEGF; s.l[g] = 0.f; s.o[g] = 0.f; } }
__device__ __forceinline__ void os_segment(OS& s, int st, const LAS float* qs_, LAS float* pb, const bf16_t* kbase, const bf16_t* vbase, int t, int lane) {
    const LAS float* qs = qs_; asm volatile("" : "+v"(qs));
    const int key = st + lane;
    const bool valid = key >= 0 && key <= t;
    float d[4] = {0.f, 0.f, 0.f, 0.f};
    if (valid) dot4(kbase + (size_t)key * 256, qs, d[0], d[1], d[2], d[3]);
    float pv[4];
#pragma unroll
    for (int g = 0; g < 4; ++g) {
        const float sc = valid ? d[g] * SCALE : NEGF;
        const float mn = fmaxf(s.m[g], wave_max(sc));
        const float alpha = __expf(s.m[g] - mn);
        pv[g] = valid ? __expf(sc - mn) : 0.f;
        s.l[g] = s.l[g] * alpha + wave_sum(pv[g]); s.o[g] *= alpha; s.m[g] = mn;
    }
    *(LAS f32x4*)(pb + lane * 4) = (f32x4){pv[0], pv[1], pv[2], pv[3]};
    __builtin_amdgcn_s_waitcnt(0xC07F);
    __builtin_amdgcn_wave_barrier();
    const int k0 = st < 0 ? -st : 0;
    const int k1 = (t - st + 1) < 64 ? (t - st + 1) : 64;
    for (int kx = k0; kx < k1; ++kx) {
        const f32x4 pq = *(const LAS f32x4*)(pb + kx * 4);
        const float vv = bf2f(vbase[(size_t)(st + kx) * ZLD + lane]);
        s.o[0] += pq[0] * vv; s.o[1] += pq[1] * vv; s.o[2] += pq[2] * vv; s.o[3] += pq[3] * vv;
    }
    __builtin_amdgcn_wave_barrier();
}

__device__ __forceinline__ void p3_nsa_task(const Frame& F, int l, int tok, int kvh, LAS float* wl  ) {
    const int lane = F.lane;
    const int b = tok >> 12, t = tok & (S - 1);
    LAS float* qs = wl; LAS float* qr = wl + 256; LAS float* pc = wl + 512; LAS float* pb = wl + 1536;
    const bf16_t* zr = F.z() + (size_t)tok * ZLD;
    if (lane < 32) {
        const bf16_t* qp = zr + ZQ + kvh * 256;
        const float c = F.ropec()[t * 32 + lane], s = F.ropes()[t * 32 + lane];
#pragma unroll
        for (int g = 0; g < 4; ++g) {
            const float x1 = bf2f(qp[g * 64 + lane]), x2 = bf2f(qp[g * 64 + lane + 32]);
            qs[g * 64 + lane] = x1; qs[g * 64 + lane + 32] = x2;
            qr[g * 64 + lane] = x1 * c - x2 * s; qr[g * 64 + lane + 32] = x2 * c + x1 * s;
        }
    }
    __builtin_amdgcn_s_waitcnt(0xC07F);
    __builtin_amdgcn_wave_barrier();
    const int nv = (t >= 31) ? (((t - 31) >> 4) + 1) : 0;
    const bf16_t* kc = F.kcmp() + (size_t)(b * 2 + kvh) * NCP * 64;
    const bf16_t* vc = F.vcmp() + (size_t)(b * 2 + kvh) * NCP * 64;
    float ocmp[4] = {0.f, 0.f, 0.f, 0.f};
#pragma unroll 1
    for (int ps = 0; ps < 4; ++ps) {
        const LAS float* qq = qs; asm volatile("" : "+v"(qq));
        const int c = lane + 64 * ps; const bool valid = c < nv;
        float d0 = 0.f, d1 = 0.f, d2 = 0.f, d3 = 0.f;
        if (valid) dot4(kc + (size_t)c * 64, qq, d0, d1, d2, d3);
        pc[c] = valid ? d0 * SCALE : NEGF; pc[256 + c] = valid ? d1 * SCALE : NEGF; pc[512 + c] = valid ? d2 * SCALE : NEGF; pc[768 + c] = valid ? d3 * SCALE : NEGF;
    }
    __builtin_amdgcn_s_waitcnt(0xC07F);
    __builtin_amdgcn_wave_barrier();
#pragma unroll
    for (int g = 0; g < 4; ++g) {
        float sc[4];
#pragma unroll
        for (int ps = 0; ps < 4; ++ps) sc[ps] = pc[g * 256 + lane + 64 * ps];
        const float mm = wave_max(fmaxf(fmaxf(sc[0], sc[1]), fmaxf(sc[2], sc[3])));
        float e[4], su = 0.f;
#pragma unroll
        for (int ps = 0; ps < 4; ++ps) { e[ps] = (sc[ps] > -1e29f) ? __expf(sc[ps] - mm) : 0.f; su += e[ps]; }
        su = wave_sum(su);
        const float inv = (nv > 0) ? 1.0f / su : 0.f;
#pragma unroll
        for (int ps = 0; ps < 4; ++ps) pc[g * 256 + lane + 64 * ps] = e[ps] * inv;
    }
    __builtin_amdgcn_s_waitcnt(0xC07F);
    __builtin_amdgcn_wave_barrier();
    for (int c = 0; c < nv; ++c) {
        const float vv = bf2f(vc[(size_t)c * 64 + lane]);
        ocmp[0] += pc[c] * vv; ocmp[1] += pc[256 + c] * vv; ocmp[2] += pc[512 + c] * vv; ocmp[3] += pc[768 + c] * vv;
    }
    unsigned long long selmask;
    {
        const int j = lane, cur = t >> 6;
        float pslc = 0.f;
#pragma unroll
        for (int q = -1; q <= 3; ++q) {
            const int c = 4 * j + q;
            if (c >= 0 && c < NC) { const float ps = (pc[c] + pc[256 + c]) + (pc[512 + c] + pc[768 + c]); pslc += (q == -1 || q == 3) ? 0.5f * ps : ps; }
        }
        const bool cand = j <= cur;
        const bool forced = (j == 0) || (j == cur) || (j == cur - 1);
        const float score = cand ? (forced ? pslc + 1e4f : pslc) : NEGF;
        int rank = 0;
        for (int i = 0; i < 64; ++i) { const float si = __shfl(score, i); rank += (si > score || (si == score && i < j)) ? 1 : 0; }
        selmask = __ballot(cand && rank < 16);
    }
    __builtin_amdgcn_wave_barrier();
    OS ss; os_init(ss);
    {
        const bf16_t* kb = F.kr() + (size_t)b * S * 256 + kvh * 64;
        const bf16_t* vb = F.z() + (size_t)b * S * ZLD + ZVS + kvh * 64;
        unsigned long long m = selmask;
        while (m) { const int j = (int)__builtin_ctzll(m); m &= (m - 1); os_segment(ss, j * 64, qr, pb, kb, vb, t, lane); }
    }
    OS sw; os_init(sw);
    {
        const bf16_t* kb = F.kr() + (size_t)b * S * 256 + 128 + kvh * 64;
        const bf16_t* vb = F.z() + (size_t)b * S * ZLD + ZVW + kvh * 64;
#pragma unroll 1
        for (int i = 0; i < 8; ++i) { const int st = t - 511 + 64 * i; if (st + 63 >= 0) os_segment(sw, st, qr, pb, kb, vb, t, lane); }
    }
    bf16_t* yb = F.ybuf();
#pragma unroll
    for (int g = 0; g < 4; ++g) {
        const int head = kvh * 4 + g;
        const float g0 = sigmoidf_(bf2f(zr[ZGATE + head * 3 + 0])), g1 = sigmoidf_(bf2f(zr[ZGATE + head * 3 + 1])), g2 = sigmoidf_(bf2f(zr[ZGATE + head * 3 + 2]));
        const float y = g0 * ocmp[g] + g1 * (ss.o[g] / ss.l[g]) + g2 * (sw.o[g] / sw.l[g]);
        const float gn = bf2f(zr[ZGN + head * 64 + lane]);
        yb[(size_t)tok * D + DLRU + head * 64 + lane] = f2bf(y * siluf_(gn));
    }
    __builtin_amdgcn_wave_barrier();
}

typedef float f32x16 __attribute__((ext_vector_type(16)));
typedef short v4i16_t __attribute__((ext_vector_type(4)));
#define MFMA32(a, b, c) __builtin_amdgcn_mfma_f32_32x32x16_bf16(a, b, c, 0, 0, 0)
constexpr float C2LOG = 0.125f * 1.4426950408889634f;
constexpr int SLP = 65;
constexpr int AT_KV = 0, AT_SLAB = 65536, AT_TOT = AT_SLAB + 8 * 32 * 68 * 4, AT_SEL = AT_TOT + 64 * SLP * 4;
__device__ __forceinline__ int crow(int r, int hi) { return (r & 3) + 8 * (r >> 2) + 4 * hi; }
__device__ __forceinline__ unsigned cvtpk(float lo, float hi) { unsigned r; asm("v_cvt_pk_bf16_f32 %0, %1, %2" : "=v"(r) : "v"(lo), "v"(hi)); return r; }
__device__ __forceinline__ float fexp2(float x) { return __builtin_amdgcn_exp2f(x); }
__device__ __forceinline__ u32x4 ldk(const bf16_t* kbase, int pitch, int row0, int wave, int lane) { return *(const u32x4*)(kbase + (size_t)(row0 + lane) * pitch + wave * 8); }
__device__ __forceinline__ u32x4 ldv(const bf16_t* vbase, int pitch, int row0, int wave, int lane) { return *(const u32x4*)(vbase + (size_t)(row0 + 16 * (wave & 3) + (lane >> 2)) * pitch + (wave >> 2) * 32 + (lane & 3) * 8); }
__device__ __forceinline__ void st_tile(LAS unsigned char* buf, int wave, int lane, u32x4 v) { *(LAS u32x4*)(buf + wave * 1024 + lane * 16) = v; }
__device__ __forceinline__ void kfrags(bf16x8 (&kf)[8], const LAS unsigned char* kbuf, int r32, int hi) {
#pragma unroll
    for (int d0 = 0; d0 < 4; ++d0) { kf[2 * d0] = *(const LAS bf16x8*)(kbuf + (2 * d0 + hi) * 1024 + r32 * 16); kf[2 * d0 + 1] = *(const LAS bf16x8*)(kbuf + (2 * d0 + hi) * 1024 + (32 + r32) * 16); }
}
__device__ __forceinline__ bf16x8 vfrag(const LAS unsigned char* vbuf, int ks, int dh, int lane) {
    const int hi = lane >> 5;
    const LAS unsigned char* p = vbuf + dh * 4096 + (16 * ks + 4 * hi + ((lane & 15) >> 2)) * 64 + ((lane >> 4) & 1) * 32 + (lane & 3) * 8;
    const v4i16_t lo = __builtin_amdgcn_ds_read_tr16_b64_v4i16((LAS v4i16_t*)p);
    const v4i16_t hh = __builtin_amdgcn_ds_read_tr16_b64_v4i16((LAS v4i16_t*)(p + 512));
    return (bf16x8){lo[0], lo[1], lo[2], lo[3], hh[0], hh[1], hh[2], hh[3]};
}
__device__ __forceinline__ void scores(f32x16& p0, f32x16& p1, const bf16x8 (&kf)[8], const bf16x8 (&qf)[4]) {
    p0 = (f32x16){0.f}; p1 = (f32x16){0.f};
#pragma unroll
    for (int d0 = 0; d0 < 4; ++d0) { p0 = MFMA32(kf[2 * d0], qf[d0], p0); p1 = MFMA32(kf[2 * d0 + 1], qf[d0], p1); }
}
__device__ __forceinline__ void band_mask(f32x16& p0, f32x16& p1, int mode, int tl, int hi) {
#pragma unroll
    for (int r = 0; r < 16; ++r) {
        const int k0 = crow(r, hi), k1 = k0 + 32;
        bool keep0, keep1;
        if (mode == 1) { keep0 = k0 <= tl; keep1 = k1 <= tl; } else if (mode == 2) { keep0 = k0 > tl; keep1 = k1 > tl; } else { keep0 = k0 < tl; keep1 = k1 < tl; }
        if (!keep0) p0[r] = -INFINITY; if (!keep1) p1[r] = -INFINITY;
    }
}
__device__ __forceinline__ float rowmax32(const f32x16& p0, const f32x16& p1) {
    float a = fmaxf(p0[0], p1[0]);
#pragma unroll
    for (int r = 1; r < 16; ++r) a = fmaxf(a, fmaxf(p0[r], p1[r]));
    return fmaxf(a, __shfl_xor(a, 32));
}
struct FlashState { f32x16 o0, o1; float m, l; };
__device__ __forceinline__ void fs_init(FlashState& s) { s.o0 = (f32x16){0.f}; s.o1 = (f32x16){0.f}; s.m = -1e30f; s.l = 0.f; }
__device__ __forceinline__ void pv_acc(f32x16& o0, f32x16& o1, const f32x16& p0, const f32x16& p1, const LAS unsigned char* vbuf, int lane) {
    bf16x8 pw[4];
#pragma unroll
    for (int s = 0; s < 2; ++s) {
        u32x4 a, b;
        a.x = cvtpk(p0[8 * s + 0], p0[8 * s + 1]); a.y = cvtpk(p0[8 * s + 2], p0[8 * s + 3]); a.z = cvtpk(p0[8 * s + 4], p0[8 * s + 5]); a.w = cvtpk(p0[8 * s + 6], p0[8 * s + 7]);
        b.x = cvtpk(p1[8 * s + 0], p1[8 * s + 1]); b.y = cvtpk(p1[8 * s + 2], p1[8 * s + 3]); b.z = cvtpk(p1[8 * s + 4], p1[8 * s + 5]); b.w = cvtpk(p1[8 * s + 6], p1[8 * s + 7]);
        pw[s] = __builtin_bit_cast(bf16x8, a); pw[2 + s] = __builtin_bit_cast(bf16x8, b);
    }
#pragma unroll
    for (int ks = 0; ks < 4; ++ks) { o0 = MFMA32(vfrag(vbuf, ks, 0, lane), pw[ks], o0); o1 = MFMA32(vfrag(vbuf, ks, 1, lane), pw[ks], o1); }
}
__device__ __forceinline__ void flash_tile(FlashState& st, const bf16x8 (&qf)[4], const LAS unsigned char* kbuf, const LAS unsigned char* vbuf, int lane, bool row_on, int mode, int tl) {
    const int r32 = lane & 31, hi = lane >> 5;
    bf16x8 kf[8]; kfrags(kf, kbuf, r32, hi);
    f32x16 p0, p1; scores(p0, p1, kf, qf);
    if (mode) band_mask(p0, p1, mode, tl, hi);
    float rm = rowmax32(p0, p1);
    if (!row_on) rm = -INFINITY;
    const float mn = fmaxf(st.m, rm);
    const float alpha = fexp2(st.m - mn);
    const float ms = row_on ? mn : INFINITY;
    float sum = 0.f;
#pragma unroll
    for (int r = 0; r < 16; ++r) { p0[r] = fexp2(p0[r] - ms); p1[r] = fexp2(p1[r] - ms); sum += p0[r] + p1[r]; }
    st.l = st.l * alpha + sum; st.m = mn;
    st.o0 *= alpha; st.o1 *= alpha;
    pv_acc(st.o0, st.o1, p0, p1, vbuf, lane);
}

namespace at64 {
typedef short s16x4 __attribute__((ext_vector_type(4)));
typedef LAS const char* lds_cptr;
constexpr int SLOTB = 8192, LDS_K = 0, LDS_V = 3 * SLOTB, STG = 68;
constexpr float C2 = 0.125f * 1.4426950408889634f;
#define A64_THR 8
#define SBAR() __builtin_amdgcn_sched_barrier(0)
#define PIN(x) asm volatile("" : "+v"(x))
#define WAIT_BAR(N) asm volatile("s_waitcnt vmcnt(" #N ") lgkmcnt(0)\n\ts_barrier" ::: "memory")
__device__ __forceinline__ void glds16(const void* g, unsigned lds_base) {
    unsigned sv; asm volatile("s_mov_b32 %0, m0\n\ts_mov_b32 m0, %2\n\ts_nop 0\n\tglobal_load_lds_dwordx4 %1, off\n\ts_mov_b32 m0, %0" : "=&s"(sv) : "v"(g), "s"(lds_base) : "memory"); }
__device__ __forceinline__ void kload2(bf16x8* kf, lds_cptr kp, int d0) { kf[2 * d0] = *(const LAS bf16x8*)(kp + d0 * 2048); kf[2 * d0 + 1] = *(const LAS bf16x8*)(kp + d0 * 2048 + 512); }
__device__ __forceinline__ s16x4 vtr(lds_cptr p) { return __builtin_bit_cast(s16x4, __builtin_amdgcn_ds_read_tr16_b64_v4i16((LAS v4i16_t*)p)); }
#define MX3(a, b, c) __builtin_fmaxf(__builtin_fmaxf((a), (b)), (c))
__device__ __forceinline__ float rowmax(const f32x16& p0, const f32x16& p1) {
    float a = MX3(p0[0], p0[1], p1[0]), b = MX3(p0[2], p0[3], p1[1]); a = MX3(a, p1[2], p1[3]);
#pragma unroll
    for (int r = 4; r < 16; r += 4) { a = MX3(a, p0[r], p0[r + 1]); b = MX3(b, p0[r + 2], p0[r + 3]); a = MX3(a, p1[r], p1[r + 1]); b = MX3(b, p1[r + 2], p1[r + 3]); }
    float m = __builtin_fmaxf(a, b); auto rr = __builtin_amdgcn_permlane32_swap(__float_as_uint(m), __float_as_uint(m), false, false);
    return __builtin_fmaxf(__uint_as_float(rr[0]), __uint_as_float(rr[1])); }
__device__ __forceinline__ void cmask_c(f32x16& p0, f32x16& p1, int qrel, int hi) {
#pragma unroll
    for (int r = 0; r < 16; ++r) { const int kv = 4 * hi + (r & 3) + 8 * (r >> 2); if (kv > qrel) p0[r] = -INFINITY; if (kv + 32 > qrel) p1[r] = -INFINITY; } }
__device__ __forceinline__ void cmask_f(f32x16& p0, f32x16& p1, int qrel, int hi) {
#pragma unroll
    for (int r = 0; r < 16; ++r) { const int kv = 4 * hi + (r & 3) + 8 * (r >> 2); if (kv <= qrel) p0[r] = -INFINITY; if (kv + 32 <= qrel) p1[r] = -INFINITY; } }

__device__ __forceinline__ void stream(LAS unsigned char* ring, LAS float* wsf  , LAS float* stage  , const bf16x8 (&qr)[4],
                                       const bf16_t* __restrict__ K, int KP, const bf16_t* __restrict__ V, int VP, int NT, bool far0, unsigned long long selw, int qrel, int tid) {
    const int lane = tid & 63, r32 = lane & 31, hi = lane >> 5; const int wid = __builtin_amdgcn_readfirstlane(tid >> 6);
    const unsigned lds0 = (unsigned)(uintptr_t)ring;
    const bf16_t* ksrc = K + (long)lane * KP + wid * 8;
    const bf16_t* vsrc = V + (long)(16 * (wid & 3) + (lane >> 2)) * VP + (wid >> 2) * 32 + (lane & 3) * 8;
    const unsigned kdst = lds0 + LDS_K + wid * 1024, vdst = lds0 + LDS_V + wid * 1024;
#define MFMA(a, b, c) __builtin_amdgcn_mfma_f32_32x32x16_bf16(a, b, c, 0, 0, 0)
#define DMA_K(t, slot) glds16(ksrc + (long)(t) * 64 * KP, (unsigned)__builtin_amdgcn_readfirstlane(kdst + (slot)))
#define DMA_V(t, slot) glds16(vsrc + (long)(t) * 64 * VP, (unsigned)__builtin_amdgcn_readfirstlane(vdst + (slot)))
    const lds_cptr vp0 = (lds_cptr)ring + LDS_V + ((lane >> 4) & 1) * 32 + (lane & 3) * 8 + (4 * hi + ((lane & 15) >> 2)) * 64;
    const lds_cptr kp0 = (lds_cptr)ring + LDS_K + hi * 1024 + r32 * 16;
    DMA_K(0, 0); DMA_V(0, 0); DMA_K(1, SLOTB);
    float mhat = 0.f, l_reg = 0.f; f32x16 o[2]; o[0] = f32x16{}; o[1] = f32x16{};
    const f32x16 zero16 = f32x16{};
    bool resc = false;
    f32x16 pA0, pA1, pB0, pB1; bf16x8 kf[8]; s16x4 vlo[8], vhi[8]; u32x4 pw0, pw1, pw2, pw3;
    int sl_prev = 0, sl_cur = 0, sl_next = SLOTB;
#define ROT() do { sl_prev = sl_cur; sl_cur = sl_next; sl_next = (sl_next == 2 * SLOTB) ? 0 : sl_next + SLOTB; } while (0)
#define EX(v) __builtin_amdgcn_exp2f(__builtin_fmaf((v), C2, nmh))
#define RESC() do { if (resc) { _Pragma("unroll") for (int d_ = 0; d_ < 2; ++d_) _Pragma("unroll") for (int r = 0; r < 16; ++r) o[d_][r] *= wsf[crow(r, hi)]; } } while (0)
    DMA_K(2, 2 * SLOTB);
    WAIT_BAR(3);
    _Pragma("unroll") for (int d0 = 0; d0 < 4; ++d0) kload2(kf, kp0, d0);
    pA0 = MFMA(kf[0], qr[0], zero16); pA1 = MFMA(kf[1], qr[0], zero16); pA0 = MFMA(kf[2], qr[1], pA0); pA1 = MFMA(kf[3], qr[1], pA1);
    pA0 = MFMA(kf[4], qr[2], pA0); pA1 = MFMA(kf[5], qr[2], pA1); pA0 = MFMA(kf[6], qr[3], pA0); pA1 = MFMA(kf[7], qr[3], pA1);
    if (NT == 1) cmask_c(pA0, pA1, qrel, hi);
    if (far0) cmask_f(pA0, pA1, qrel, hi);
    { const float rm = rowmax(pA0, pA1); mhat = __builtin_fmaxf(rm * C2, -1.0e4f); const float nmh = -mhat;
#pragma unroll
      for (int r = 0; r < 16; ++r) { pA0[r] = EX(pA0[r]); pA1[r] = EX(pA1[r]); } }
    WAIT_BAR(0);
    DMA_K(3, 0); DMA_V(1, SLOTB); ROT();
    _Pragma("unroll") for (int d0 = 0; d0 < 4; ++d0) kload2(kf, kp0 + sl_cur, d0);
    WAIT_BAR(2);
#define PKW(P, i) cvtpk(P[i], P[i + 1])
#define PAF(k) __builtin_bit_cast(bf16x8, pw##k)
#define VFR(i) (bf16x8){vlo[i][0], vlo[i][1], vlo[i][2], vlo[i][3], vhi[i][0], vhi[i][1], vhi[i][2], vhi[i][3]}
#define VRD(i) do { vlo[i] = vtr(vp_ + (((i) >> 2) * 4096 + ((i) & 3) * 1024)); vhi[i] = vtr(vp_ + (((i) >> 2) * 4096 + ((i) & 3) * 1024 + 512)); } while (0)
#define KRD(G, d0) do { if (G) { kload2(kf, kp0 + sl_next, d0); SBAR(); } } while (0)
#define GAPA(MF, a0, a1, a2, a3, W0, W1, PW) do { MF; sacc += a0; sacc += a1; sacc += a2; sacc += a3; W0; W1; PIN(PW); PIN(sacc); SBAR(); } while (0)
#define GAPB(MF, X, i) do { MF; X[i] = EX(X[i]); X[i + 1] = EX(X[i + 1]); X[i + 2] = EX(X[i + 2]); X[i + 3] = EX(X[i + 3]); PIN(X); SBAR(); } while (0)
#define STEP(C0, C1, P0, P1, t, MASK, GK, GV, GL) do { SBAR(); \
    const lds_cptr vp_ = vp0 + sl_prev; \
    VRD(0); SBAR(); float sacc = P0[0] + P0[1]; \
                    GAPA(C0 = MFMA(kf[0], qr[0], zero16), P0[2], P0[3], P0[4], P0[5],     pw0[0] = PKW(P0, 0),  pw0[1] = PKW(P0, 2),  pw0); \
    VRD(4); SBAR(); GAPA(C1 = MFMA(kf[1], qr[0], zero16), P0[6], P0[7], P0[8], P0[9],     pw0[2] = PKW(P0, 4),  pw0[3] = PKW(P0, 6),  pw0); \
    VRD(1); SBAR(); GAPA(C0 = MFMA(kf[2], qr[1], C0),    P0[10], P0[11], P0[12], P0[13], pw1[0] = PKW(P0, 8),  pw1[1] = PKW(P0, 10), pw1); \
    VRD(5); SBAR(); GAPA(C1 = MFMA(kf[3], qr[1], C1),    P0[14], P0[15], P1[0], P1[1],   pw1[2] = PKW(P0, 12), pw1[3] = PKW(P0, 14), pw1); \
    VRD(2); SBAR(); GAPA(C0 = MFMA(kf[4], qr[2], C0),    P1[2], P1[3], P1[4], P1[5],     pw2[0] = PKW(P1, 0),  pw2[1] = PKW(P1, 2),  pw2); \
    VRD(6); SBAR(); GAPA(C1 = MFMA(kf[5], qr[2], C1),    P1[6], P1[7], P1[8], P1[9],     pw2[2] = PKW(P1, 4),  pw2[3] = PKW(P1, 6),  pw2); \
    VRD(3); SBAR(); GAPA(C0 = MFMA(kf[6], qr[3], C0),    P1[10], P1[11], P1[12], P1[13], pw3[0] = PKW(P1, 8),  pw3[1] = PKW(P1, 10), pw3); \
    VRD(7); SBAR(); GAPA(C1 = MFMA(kf[7], qr[3], C1),    P1[14], P1[15], 0.f, 0.f,       pw3[2] = PKW(P1, 12), pw3[3] = PKW(P1, 14), pw3); \
    l_reg += sacc; \
    if (GK) DMA_K((t) + 3, sl_cur); if (GV) DMA_V((t) + 1, sl_next); \
    if (MASK) { if ((t) == NT - 1) cmask_c(C0, C1, qrel, hi); } \
    const bool ron_ = ((selw >> (t)) & 1ull) != 0ull; \
    { float rm = __builtin_fmaf(rowmax(C0, C1), C2, -mhat); if (!ron_) rm = -INFINITY; resc = false; \
      if (__builtin_expect(__any(rm > (float)A64_THR), 0)) { const float dl = __builtin_fmaxf(rm, 0.f); mhat += dl; \
          const float f = __builtin_amdgcn_exp2f(-dl); l_reg *= f; if (hi == 0) wsf[r32] = f; resc = true; } } \
    const float nmh = ron_ ? -mhat : -INFINITY; SBAR(); \
    GAPB(o[0] = MFMA(PAF(0), VFR(0), o[0]), C0, 0);              GAPB(o[1] = MFMA(PAF(0), VFR(4), o[1]), C0, 4); \
    KRD(GL, 0); GAPB(o[0] = MFMA(PAF(1), VFR(1), o[0]), C0, 8);  KRD(GL, 1); GAPB(o[1] = MFMA(PAF(1), VFR(5), o[1]), C0, 12); \
    KRD(GL, 2); GAPB(o[0] = MFMA(PAF(2), VFR(2), o[0]), C1, 0);  KRD(GL, 3); GAPB(o[1] = MFMA(PAF(2), VFR(6), o[1]), C1, 4); \
    GAPB(o[0] = MFMA(PAF(3), VFR(3), o[0]), C1, 8);              GAPB(o[1] = MFMA(PAF(3), VFR(7), o[1]), C1, 12); \
    } while (0)
    int t = 1;
    for (; t + 5 < NT; t += 2) {
        STEP(pB0, pB1, pA0, pA1, t, false, true, true, true);     WAIT_BAR(2); RESC(); ROT();
        STEP(pA0, pA1, pB0, pB1, t + 1, false, true, true, true); WAIT_BAR(2); RESC(); ROT();
    }
#define ENDW(tt) do { if ((tt) + 3 < NT) { WAIT_BAR(2); } else if ((tt) + 2 < NT) { WAIT_BAR(1); } else { WAIT_BAR(0); } } while (0)
    for (; t + 1 < NT; t += 2) {
        STEP(pB0, pB1, pA0, pA1, t, true, (t + 3 < NT), (t + 1 < NT), (t + 1 < NT));         ENDW(t);     RESC(); ROT();
        STEP(pA0, pA1, pB0, pB1, t + 1, true, (t + 4 < NT), (t + 2 < NT), (t + 2 < NT));     ENDW(t + 1); RESC(); ROT();
    }
    int sl_last;
    if (t < NT) { STEP(pB0, pB1, pA0, pA1, t, true, false, false, false); RESC(); sl_last = sl_cur; }
    else { pB0 = pA0; pB1 = pA1; sl_last = sl_prev; }
    { float sacc = pB0[0] + pB0[1];
#pragma unroll
      for (int r = 2; r < 16; ++r) sacc += pB0[r];
#pragma unroll
      for (int r = 0; r < 16; ++r) sacc += pB1[r];
      l_reg += sacc;
      pw0 = (u32x4){PKW(pB0, 0), PKW(pB0, 2), PKW(pB0, 4), PKW(pB0, 6)}; pw1 = (u32x4){PKW(pB0, 8), PKW(pB0, 10), PKW(pB0, 12), PKW(pB0, 14)};
      pw2 = (u32x4){PKW(pB1, 0), PKW(pB1, 2), PKW(pB1, 4), PKW(pB1, 6)}; pw3 = (u32x4){PKW(pB1, 8), PKW(pB1, 10), PKW(pB1, 12), PKW(pB1, 14)};
      const lds_cptr vp_ = vp0 + sl_last; _Pragma("unroll") for (int i = 0; i < 8; ++i) VRD(i);
      o[0] = MFMA(PAF(0), VFR(0), o[0]); o[1] = MFMA(PAF(0), VFR(4), o[1]); o[0] = MFMA(PAF(1), VFR(1), o[0]); o[1] = MFMA(PAF(1), VFR(5), o[1]);
      o[0] = MFMA(PAF(2), VFR(2), o[0]); o[1] = MFMA(PAF(2), VFR(6), o[1]); o[0] = MFMA(PAF(3), VFR(3), o[0]); o[1] = MFMA(PAF(3), VFR(7), o[1]); }
    { auto rr = __builtin_amdgcn_permlane32_swap(__float_as_uint(l_reg), __float_as_uint(l_reg), false, false); l_reg = __uint_as_float(rr[0]) + __uint_as_float(rr[1]); }
    if (hi == 0) wsf[32 + r32] *= __builtin_amdgcn_rcpf(l_reg);
    asm volatile("s_waitcnt lgkmcnt(0)" ::: "memory");
#pragma unroll
    for (int r = 0; r < 16; ++r) { const int orow = crow(r, hi); const float sc = wsf[32 + orow];
#pragma unroll
        for (int d0 = 0; d0 < 2; ++d0) stage[orow * STG + d0 * 32 + r32] += o[d0][r] * sc; }
    asm volatile("s_waitcnt vmcnt(0) lgkmcnt(0)\n\ts_barrier" ::: "memory");
#undef MFMA
#undef DMA_K
#undef DMA_V
#undef ROT
#undef EX
#undef RESC
#undef PKW
#undef PAF
#undef VFR
#undef VRD
#undef KRD
#undef ENDW
#undef GAPA
#undef GAPB
#undef STEP
}
#undef SBAR
#undef PIN
#undef WAIT_BAR
#undef MX3
}

__device__ __forceinline__ void p3_nsa_unit(const Frame& F, int l, int b, int kvh, int qb) {
    const int tid = F.tid, lane = F.lane, wave = F.wave, r32 = lane & 31, hi = lane >> 5;
    LAS unsigned char* base = F.lds + LDS_WORK;
    LAS unsigned char* kvr = base + AT_KV;
    LAS float* slab = (LAS float*)(base + AT_SLAB);
    LAS float* tot = (LAS float*)(base + AT_TOT);
    LAS unsigned long long* sel = (LAS unsigned long long*)(base + AT_SEL);
    LAS float* sinv = (LAS float*)(base + AT_SEL + 512);
    LAS float* stash = slab;
    const int g = wave >> 1, tl = 32 * (wave & 1) + r32, head = 4 * kvh + g;
    const int t0 = qb * 64, t = t0 + tl; const size_t tok = (size_t)b * S + t;
    const bf16_t* zr = F.z() + tok * ZLD;
    bf16x8 qc[4], qr[4]; float g0v, g1v, g2v; unsigned long long selw = 0ull; LAS float* stage = nullptr; LAS float* wsf = nullptr;
#pragma unroll 1
    for (int rpu_ = 0; rpu_ < (((REP_PH >> 12) & 1) ? 2 : 1); ++rpu_) {
    if (rpu_) __syncthreads();
    {
        const bf16_t* kc = F.kcmp() + (size_t)(b * 2 + kvh) * NCP * 64;
        const bf16_t* vc = F.vcmp() + (size_t)(b * 2 + kvh) * NCP * 64;
        const int ntc0 = (4 * qb + 3 + 63) >> 6;
#pragma unroll
        for (int tt = 0; tt < 4; ++tt) if (tt < ntc0) { st_tile(kvr + tt * 8192, wave, lane, ldk(kc, 64, tt * 64, wave, lane)); st_tile(kvr + 32768 + tt * 8192, wave, lane, ldv(vc, 64, tt * 64, wave, lane)); }
    }
    {
        float qv[4][8];
#pragma unroll
        for (int d0 = 0; d0 < 4; ++d0) {
            const u32x4 w = *(const u32x4*)(zr + ZQ + head * 64 + d0 * 16 + hi * 8);
            qv[d0][0] = bflo(w.x); qv[d0][1] = bfhi(w.x); qv[d0][2] = bflo(w.y); qv[d0][3] = bfhi(w.y); qv[d0][4] = bflo(w.z); qv[d0][5] = bfhi(w.z); qv[d0][6] = bflo(w.w); qv[d0][7] = bfhi(w.w);
            u32x4 o; o.x = cvtpk(qv[d0][0] * C2LOG, qv[d0][1] * C2LOG); o.y = cvtpk(qv[d0][2] * C2LOG, qv[d0][3] * C2LOG); o.z = cvtpk(qv[d0][4] * C2LOG, qv[d0][5] * C2LOG); o.w = cvtpk(qv[d0][6] * C2LOG, qv[d0][7] * C2LOG);
            qc[d0] = __builtin_bit_cast(bf16x8, o);
        }
#pragma unroll
        for (int d0 = 0; d0 < 2; ++d0) {
            const float* cp = F.ropec() + t * 32 + d0 * 16 + hi * 8; const float* sp = F.ropes() + t * 32 + d0 * 16 + hi * 8;
            const f32x4 c0 = *(const f32x4*)cp, c1 = *(const f32x4*)(cp + 4), s0 = *(const f32x4*)sp, s1 = *(const f32x4*)(sp + 4);
            float a[8], bb[8];
#pragma unroll
            for (int j = 0; j < 8; ++j) { const float c = j < 4 ? c0[j & 3] : c1[j & 3], s = j < 4 ? s0[j & 3] : s1[j & 3]; const float x1 = qv[d0][j], x2 = qv[d0 + 2][j];
                a[j] = x1 * c - x2 * s; bb[j] = x2 * c + x1 * s; }
            u32x4 o1, o2; o1.x = cvtpk(a[0], a[1]); o1.y = cvtpk(a[2], a[3]); o1.z = cvtpk(a[4], a[5]); o1.w = cvtpk(a[6], a[7]);
            o2.x = cvtpk(bb[0], bb[1]); o2.y = cvtpk(bb[2], bb[3]); o2.z = cvtpk(bb[4], bb[5]); o2.w = cvtpk(bb[6], bb[7]);
            qr[d0] = __builtin_bit_cast(bf16x8, o1); qr[d0 + 2] = __builtin_bit_cast(bf16x8, o2);
        }
        g0v = sigmoidf_(bf2f(zr[ZGATE + head * 3 + 0])); g1v = sigmoidf_(bf2f(zr[ZGATE + head * 3 + 1])); g2v = sigmoidf_(bf2f(zr[ZGATE + head * 3 + 2]));
    }
    __syncthreads();
    const int nv = (t >= 31) ? (((t - 31) >> 4) + 1) : 0;
    const int ntc = (4 * qb + 3 + 63) >> 6;
    float mrow = -1e30f;
#pragma unroll 1
    for (int tt = 0; tt < ntc; ++tt) {
        bf16x8 kf[8]; kfrags(kf, kvr + tt * 8192, r32, hi);
        f32x16 p0, p1; scores(p0, p1, kf, qc);
        band_mask(p0, p1, 3, nv - 64 * tt, hi);
        mrow = fmaxf(mrow, rowmax32(p0, p1));
    }
    f32x16 yacc0, yacc1;
    {
        f32x16 oc0 = (f32x16){0.f}, oc1 = (f32x16){0.f};
        float lsum = 0.f, carry = 0.f;
        LAS float* myslab = slab + (g * 64 + tl) * SLP;
#pragma unroll 1
        for (int tt = 0; tt < ntc; ++tt) {
            bf16x8 kf[8]; kfrags(kf, kvr + tt * 8192, r32, hi);
            f32x16 p0, p1; scores(p0, p1, kf, qc);
            band_mask(p0, p1, 3, nv - 64 * tt, hi);
#pragma unroll
            for (int r = 0; r < 16; ++r) { p0[r] = fexp2(p0[r] - mrow); p1[r] = fexp2(p1[r] - mrow); lsum += p0[r] + p1[r]; }
#pragma unroll
            for (int n = 0; n < 2; ++n)
#pragma unroll
                for (int q = 0; q < 4; ++q) {
                    const f32x16& pp = n ? p1 : p0;
                    const float tl_ = 0.5f * pp[4 * q + 3];
                    const float inner = (pp[4 * q] + pp[4 * q + 1]) + (pp[4 * q + 2] + tl_);
                    const float rcv = __shfl_xor(tl_, 32);
                    myslab[16 * tt + 8 * n + 2 * q + hi] = inner + (hi ? rcv : carry);
                    carry = rcv;
                }
            pv_acc(oc0, oc1, p0, p1, kvr + 32768 + tt * 8192, lane);
        }
        lsum += __shfl_xor(lsum, 32);
        const float inv = lsum > 0.f ? 1.0f / lsum : 0.f;
        if (hi == 0) sinv[g * 64 + tl] = inv;
        const float g0 = g0v * inv;
        yacc0 = oc0 * g0; yacc1 = oc1 * g0;
    }
    __syncthreads();
    {
        LAS unsigned* tkey = (LAS unsigned*)tot;
        const int tk = tid >> 3, part = tid & 7, cur = qb;
        unsigned my[8]; int rank[8];
#pragma unroll
        for (int jj = 0; jj < 8; ++jj) { const int j = part * 8 + jj;
            const float v = (j >= 16 * ntc) ? 0.f : (slab[(0 * 64 + tk) * SLP + j] * sinv[tk] + slab[(1 * 64 + tk) * SLP + j] * sinv[64 + tk]) + (slab[(2 * 64 + tk) * SLP + j] * sinv[128 + tk] + slab[(3 * 64 + tk) * SLP + j] * sinv[192 + tk]);
            const bool forced = (j == 0) || (j == cur) || (j == cur - 1);
            my[jj] = (forced ? 0x80000000u : 0u) | ((__float_as_uint(v) >> 6) << 6) | (unsigned)(63 - j); rank[jj] = 0;
            tkey[tk * SLP + j] = my[jj]; }
        __syncthreads();
        if (cur >= 16)
        for (int i = 0; i <= cur; ++i) {
            const unsigned ki = tkey[tk * SLP + i];
#pragma unroll
            for (int jj = 0; jj < 8; ++jj) rank[jj] += (ki > my[jj]) ? 1 : 0;
        }
        unsigned bits = 0;
#pragma unroll
        for (int jj = 0; jj < 8; ++jj) { const int j = part * 8 + jj; if (j <= cur && rank[jj] < 16) bits |= 1u << jj; }
        unsigned lo = (part < 4) ? (bits << (8 * part)) : 0u, hh = (part >= 4) ? (bits << (8 * (part - 4))) : 0u;
#pragma unroll
        for (int o = 1; o < 8; o <<= 1) { lo |= __shfl_xor(lo, o); hh |= __shfl_xor(hh, o); }
        if (part == 0) sel[tk] = ((unsigned long long)hh << 32) | lo;
        __syncthreads();
    }
    selw = sel[tl];
    stage = (LAS float*)(base + AT_SLAB) + wave * (32 * at64::STG);
    wsf = (LAS float*)(base + AT_SEL + 1536) + wave * 64;
#pragma unroll
    for (int dh = 0; dh < 2; ++dh)
#pragma unroll
        for (int q = 0; q < 4; ++q) { const f32x16& ya = dh ? yacc1 : yacc0; *(LAS f32x4*)(stage + r32 * at64::STG + 32 * dh + 8 * q + 4 * hi) = (f32x4){ya[4 * q], ya[4 * q + 1], ya[4 * q + 2], ya[4 * q + 3]}; }
    }
#pragma unroll 1
    for (int rp_ = 0; rp_ < (((REP_PH >> 10) & 1) ? 2 : 1); ++rp_) {
    if (hi == 0) wsf[32 + r32] = rp_ ? 0.f : g1v;
    at64::stream(kvr, wsf, stage, qr, F.kr() + (size_t)b * S * 256 + kvh * 64, 256, F.z() + (size_t)b * S * ZLD + ZVS + kvh * 64, ZLD, qb + 1, false, selw, tl, tid);
    }
    {
        const int tb = qb >= 8 ? qb - 8 : 0;
#pragma unroll 1
        for (int rp_ = 0; rp_ < (((REP_PH >> 11) & 1) ? 2 : 1); ++rp_) {
        if (hi == 0) wsf[32 + r32] = rp_ ? 0.f : g2v;
        at64::stream(kvr, wsf, stage, qr, F.kr() + ((size_t)b * S + tb * 64) * 256 + 128 + kvh * 64, 256, F.z() + ((size_t)b * S + tb * 64) * ZLD + ZVW + kvh * 64, ZLD, qb - tb + 1, qb >= 8, ~0ull, tl, tid);
        }
    }
    {
#pragma unroll
        for (int i = 0; i < 4; ++i) {
            const int row = i * 8 + (lane >> 3), ch = lane & 7;
            const size_t tk2 = (size_t)b * S + t0 + 32 * (wave & 1) + row;
            const f32x4 y0 = *(const LAS f32x4*)(stage + row * at64::STG + ch * 8), y1 = *(const LAS f32x4*)(stage + row * at64::STG + ch * 8 + 4);
            const u32x4 gw = *(const u32x4*)(F.z() + tk2 * ZLD + ZGN + head * 64 + ch * 8);
            u32x4 w;
            w.x = cvtpk(y0[0] * siluf_(bflo(gw.x)), y0[1] * siluf_(bfhi(gw.x))); w.y = cvtpk(y0[2] * siluf_(bflo(gw.y)), y0[3] * siluf_(bfhi(gw.y)));
            w.z = cvtpk(y1[0] * siluf_(bflo(gw.z)), y1[1] * siluf_(bfhi(gw.z))); w.w = cvtpk(y1[2] * siluf_(bflo(gw.w)), y1[3] * siluf_(bfhi(gw.w)));
            bf16_t* yo = F.ybuf() + tk2 * D + DLRU + head * 64 + ch * 8;
#if NSA_PROBE
            { const u32x4 ref = *(const u32x4*)yo;
              const unsigned rw[4] = {ref.x, ref.y, ref.z, ref.w}, nw[4] = {w.x, w.y, w.z, w.w};
              float dd = 0.f, rr = 0.f;
#pragma unroll
              for (int e = 0; e < 4; ++e) { const float r0 = bflo(rw[e]), r1 = bfhi(rw[e]), n0 = bflo(nw[e]), n1 = bfhi(nw[e]); dd += (n0 - r0) * (n0 - r0) + (n1 - r1) * (n1 - r1); rr += r0 * r0 + r1 * r1; }
              dd = wave_sum(dd); rr = wave_sum(rr);
              if (lane == 0) { atomicAdd((float*)(F.p.ws + WS_PROBE), dd); atomicAdd((float*)(F.p.ws + WS_PROBE) + 1, rr); } }
#else
            if constexpr ((WT_MASK & 16) != 0) st16wt(F.p.ws, yo, w); else *(u32x4*)yo = w;
#endif
        }
    }
    __syncthreads();
}

__device__ __forceinline__ void p3_lru_item(const Frame& F, int item) {
    const int b = item >> 6, ch = item & 63;
    LAS float* cs = (LAS float*)(F.lds + LDS_WORK);
    {
        const int chn = F.tid;
        float hh = 0.f;
        const float* agb = F.agg() + ((size_t)(b * 128) * DLRU + chn) * 2;
        for (int c0 = 0; c0 < 2 * ch; c0 += 32) {
            float2 ag[32];
#pragma unroll
            for (int i = 0; i < 32; ++i) ag[i] = (c0 + i < 2 * ch) ? *(const float2*)(agb + (size_t)(c0 + i) * DLRU * 2) : make_float2(1.f, 0.f);
#pragma unroll
            for (int i = 0; i < 32; ++i) hh = ag[i].x * hh + ag[i].y;
        }
        cs[chn] = hh;
        const float2 am = *(const float2*)(agb + (size_t)(2 * ch) * DLRU * 2);
        cs[512 + chn] = am.x * hh + am.y;
    }
    __syncthreads();
    const size_t tok0 = (size_t)b * S + ch * 64;
#pragma unroll 2
    for (int e = F.tid; e < 64 * 64; e += NTHR) {
        const int tl = e >> 6, cg = (e & 63) * 8;
        const u32x4 sw = __builtin_nontemporal_load((const u32x4*)(F.lrus() + (tok0 + tl) * DLRU + cg));
        const u32x4 sx = __builtin_nontemporal_load((const u32x4*)(F.lrus() + (tok0 + tl) * DLRU + cg + 4));
        const u32x4 gw = *(const u32x4*)(F.z() + (tok0 + tl) * ZLD + ZGL + cg);
        const f32x4 c0 = *(const LAS f32x4*)(cs + (tl >> 5) * 512 + cg), c1 = *(const LAS f32x4*)(cs + (tl >> 5) * 512 + cg + 4);
        const float h0 = bflo(sw.x) * c0[0] + bfhi(sw.x), h1 = bflo(sw.y) * c0[1] + bfhi(sw.y), h2 = bflo(sw.z) * c0[2] + bfhi(sw.z), h3 = bflo(sw.w) * c0[3] + bfhi(sw.w);
        const float h4 = bflo(sx.x) * c1[0] + bfhi(sx.x), h5 = bflo(sx.y) * c1[1] + bfhi(sx.y), h6 = bflo(sx.z) * c1[2] + bfhi(sx.z), h7 = bflo(sx.w) * c1[3] + bfhi(sx.w);
        u32x4 ow; ow.x = cvtpk_(h0 * siluf_(bflo(gw.x)), h1 * siluf_(bfhi(gw.x))); ow.y = cvtpk_(h2 * siluf_(bflo(gw.y)), h3 * siluf_(bfhi(gw.y)));
        ow.z = cvtpk_(h4 * siluf_(bflo(gw.z)), h5 * siluf_(bfhi(gw.z))); ow.w = cvtpk_(h6 * siluf_(bflo(gw.w)), h7 * siluf_(bfhi(gw.w)));
        if constexpr ((WT_MASK & 128) != 0) st16wt(F.p.ws, F.ybuf() + (tok0 + tl) * D + cg, ow); else *(u32x4*)(F.ybuf() + (tok0 + tl) * D + cg) = ow;
    }
    __syncthreads();
}

__device__ __forceinline__ void p4_outproj(const Frame& F, int l) {
    pg8::Gemm g{F.ybuf(), F.wt_out() + (size_t)l * D * D, T, D, D};
    pg8::StaticOrder So; So.init(T, D, (int)gridDim.x, F.bid);
    if (l == DEPTH - 1 && gridDim.x == 256) { pg8::EpiOutFinal E{F.xb(), F.p.out, F.in(17), (unsigned*)(F.p.ws + WS_SSQ), (unsigned*)(F.p.ws + WS_PANEL), (unsigned*)(F.p.ws + WS_BAR) + XB_TMO};
        pg8::gemm_phase<pg8::EpiOutFinal, pg8::StaticOrder, true, true>(F.lds + LDS_WORK, g, So, E, F.tid); }
    else if (l == 0) { pg8::EpiOutProj<true> E{F.in(0), F.xb(), F.ssq(), F.p.ws}; pg8::gemm_phase<pg8::EpiOutProj<true>, pg8::StaticOrder, true, true>(F.lds + LDS_WORK, g, So, E, F.tid); }
    else { pg8::EpiOutProj<false> E{nullptr, F.xb(), F.ssq(), F.p.ws}; pg8::gemm_phase<pg8::EpiOutProj<false>, pg8::StaticOrder, true, true>(F.lds + LDS_WORK, g, So, E, F.tid); }
}

__device__ __forceinline__ void p5_final(const Frame& F) {
    for (int row = F.bid * NWAVE + F.wave; row < T; row += gridDim.x * NWAVE) {
        const bf16_t* xr = F.xb() + (size_t)row * D;
        float* orow = F.p.out + (size_t)row * D;
        const f32x4* sp = (const f32x4*)(F.ssq() + (size_t)row * 16);
        const f32x4 s4 = (sp[0] + sp[1]) + (sp[2] + sp[3]);
        float rs = rsqrtf(((s4[0] + s4[1]) + (s4[2] + s4[3])) * (1.0f / D) + EPS);
#if NSA_PROBE
        { const float* pr = (const float*)(F.p.ws + WS_PROBE); rs *= 1.0f + sqrtf(pr[0] / fmaxf(pr[1], 1e-30f)); }
#endif
#pragma unroll
        for (int i = 0; i < 2; ++i) {
            const int c = (i * 64 + F.lane) * 8;
            const u32x4 xw = __builtin_nontemporal_load((const u32x4*)(xr + c));
            const f32x4 g0 = *(GAS const f32x4*)(F.in(17) + c), g1 = *(GAS const f32x4*)(F.in(17) + c + 4);
            const f32x4 o0 = (f32x4){bflo(xw.x), bfhi(xw.x), bflo(xw.y), bfhi(xw.y)} * rs * g0, o1 = (f32x4){bflo(xw.z), bfhi(xw.z), bflo(xw.w), bfhi(xw.w)} * rs * g1;
            if constexpr ((WT_MASK & 256) != 0) { st16wt_out(F.p.out, orow + c, __builtin_bit_cast(u32x4, o0)); st16wt_out(F.p.out, orow + c + 4, __builtin_bit_cast(u32x4, o1)); }
            else { *(f32x4*)(orow + c) = o0; *(f32x4*)(orow + c + 4) = o1; }
        }
    }
}

__global__ void __launch_bounds__(NTHR, 2) mk_fwd(Params p) {
    extern __shared__ __attribute__((aligned(16))) unsigned char lds[];
    Frame F0;
    F0.p = Params{}; F0.p.ws = p.ws; F0.p.out = p.out; F0.lds = (LAS unsigned char*)lds; F0.tid = threadIdx.x; F0.lane = F0.tid & 63; F0.wave = __builtin_amdgcn_readfirstlane(F0.tid >> 6); F0.bid = (int)blockIdx.x;
    unsigned char* ws = p.ws;
    volatile LAS unsigned* ctl = (volatile LAS unsigned*)F0.lds;
    if (F0.tid < 4) ctl[F0.tid] = 0u;
    if (F0.tid == 0) { LAS unsigned long long* it_ = (LAS unsigned long long*)(F0.lds + LDS_INP);
        it_[0] = (unsigned long long)p.x;
        it_[1] = (unsigned long long)p.norm_g;
        it_[2] = (unsigned long long)p.w_in;
        it_[3] = (unsigned long long)p.conv_w;
        it_[4] = (unsigned long long)p.conv_b;
        it_[5] = (unsigned long long)p.lru_wa;
        it_[6] = (unsigned long long)p.lru_ba;
        it_[7] = (unsigned long long)p.lru_wi;
        it_[8] = (unsigned long long)p.lru_bi;
        it_[9] = (unsigned long long)p.lru_lambda;
        it_[10] = (unsigned long long)p.pos_k;
        it_[11] = (unsigned long long)p.pos_v;
        it_[12] = (unsigned long long)p.k_w1;
        it_[13] = (unsigned long long)p.k_w2;
        it_[14] = (unsigned long long)p.v_w1;
        it_[15] = (unsigned long long)p.v_w2;
        it_[16] = (unsigned long long)p.w_out;
        it_[17] = (unsigned long long)p.final_g;
    }
    __syncthreads();
    const int lo = p.ph_lo, hi = p.ph_hi;
    XcdBarrier bar; bar.bar = (unsigned*)(ws + WS_BAR); bar.x = 0; bar.st = ctl;
    if (hi - lo > 1) bar = xcd_barrier_post((unsigned*)(ws + WS_BAR), ctl);

#if (REP_PH >> 13) & 1
    if (hi - lo > 1) for (int xb_ = 0; xb_ < 20; ++xb_) xcd_barrier(bar);
#endif
    for (int ph = lo; ph < hi; ++ph) {
      const int phs_ = (ph == 0) ? 4 : ((ph == NPHASE - 1) ? 5 : ((ph - 1) & 3));
      const int nrep_ = (phs_ < 5 && phs_ != 3 && ((REP_PH >> phs_) & 1)) ? 2 : 1;
      for (int rep_ = 0; rep_ < nrep_; ++rep_) {
        Frame G = F0;
        asm volatile("" : "+s"(G.lds), "+s"(G.bid));
        G.tid = (G.wave << 6) | (int)__builtin_amdgcn_mbcnt_hi(~0u, __builtin_amdgcn_mbcnt_lo(~0u, 0u));
        asm volatile("" : "+v"(G.tid));
        G.lane = G.tid & 63; G.wave = __builtin_amdgcn_readfirstlane(G.tid >> 6);
        const Frame& F = G;
        if (ph == 0) { if (PHSEL & 1) p0_prologue(F); }
        else if (ph == NPHASE - 1) { if ((PHSEL & 2) && gridDim.x != 256) p5_final(F); }
        else {
            const int l = (ph - 1) >> 2, s = (ph - 1) & 3;
            if (s == 0) { if (PHSEL & 4) p1_inproj(F, l); }
            else if (s == 1) {
                if (l + 1 < DEPTH) prep_layer(F, l + 1);
                const bool g256 = (gridDim.x == 256);
                for (int r3 = 0; r3 < (g256 ? 3 : (640 + (int)gridDim.x - 1) / (int)gridDim.x); ++r3) {
                    int kind, idx;
                    if (g256) { if (F.bid < 64) { if (r3) break; kind = 0; idx = F.bid; } else { const int k = (F.bid - 64) + 192 * r3; kind = k < 512 ? 1 : 2; idx = k < 512 ? k : k - 512; } }
                    else { const int k = F.bid + (int)gridDim.x * r3; if (k >= 640) break; kind = k < 64 ? 0 : (k < 576 ? 1 : 2); idx = k < 64 ? k : (k < 576 ? k - 64 : k - 576); }
                    asm volatile("" : "+s"(G.lds));
                    asm volatile("" : "+v"(G.tid));
                    G.lane = G.tid & 63; G.wave = __builtin_amdgcn_readfirstlane(G.tid >> 6);
                    if (kind == 0) { if (PHSEL & 8) p2_compress_item(F, l, idx);
#if (REP_PH >> 5) & 1
                        p2_compress_item(F, l, idx);
#endif
                    }
                    else if (kind == 1) { if (PHSEL & 16) p2_lru_item(F, l, idx);
#if (REP_PH >> 6) & 1
                        p2_lru_item(F, l, idx);
#endif
                    }
                    else { if (PHSEL & 1) p2_ropek_item(F, idx);
#if (REP_PH >> 7) & 1
                        p2_ropek_item(F, idx);
#endif
                    }
                }
            } else if (s == 2) {
                for (int it = F.bid; it < 256; it += gridDim.x) { if (PHSEL & 1) p3_lru_item(F, it);
#if (REP_PH >> 8) & 1
                    p3_lru_item(F, it);
#endif
                }
#if NSA_MODE == 0
                LAS float* wl = (LAS float*)(F.lds + LDS_WORK) + F.wave * 2048;
                for (int it = F.bid; it < 4096; it += gridDim.x) { const int task = it * NWAVE + F.wave; p3_nsa_task(F, l, task >> 1, task & 1, wl); }
#else
                for (int it = F.bid; it < 256; it += gridDim.x) {
                    const int bk = it & 7, qq = it >> 3;
#pragma unroll 1
                    for (int hf = 0; hf < (((REP_PH >> 9) & 1) ? 4 : 2); ++hf) {
                        const int qb = (hf & 1) ? 63 - qq : qq;
#if NSA_MODE == 2
                        { LAS float* wl = (LAS float*)(F.lds + LDS_WORK) + F.wave * 2048;
                          for (int k = 0; k < 8; ++k) { const int task = k * NWAVE + F.wave; p3_nsa_task(F, l, (bk >> 1) * S + qb * 64 + task, bk & 1, wl); }
                          __threadfence_block(); __syncthreads(); }
#endif
                        asm volatile("" : "+v"(G.tid)); G.lane = G.tid & 63; G.wave = __builtin_amdgcn_readfirstlane(G.tid >> 6);
                        if (PHSEL & 32) p3_nsa_unit(F, l, bk >> 1, bk & 1, qb);
                    }
                }
#endif
            } else { if (PHSEL & 64) p4_outproj(F, l); }
        }
        if (rep_ + 1 < nrep_) xcd_barrier(bar);
      }
        if (ph + 1 < hi && !(ph + 2 == NPHASE && gridDim.x == 256)) xcd_barrier(bar);
    }
}

extern "C" void kernel_launch(void* const* d_in, const int* in_sizes, int n_in, void* d_out, int out_size, void* d_ws, size_t ws_size, hipStream_t stream) {
    static int grid = 0;
    if (grid == 0) {
        if (n_in != 18 || out_size != T * D || ws_size < WS_END) { fprintf(stderr, "kernel_launch: unexpected shapes (n_in %d out %d ws %zu need %zu)\n", n_in, out_size, ws_size, (size_t)WS_END); grid = -1; return; }
        int dev = 0, cus = 0;
        if (hipGetDevice(&dev) != hipSuccess || hipDeviceGetAttribute(&cus, hipDeviceAttributeMultiprocessorCount, dev) != hipSuccess) { grid = -1; return; }
        if (hipFuncSetAttribute((const void*)mk_fwd, hipFuncAttributeMaxDynamicSharedMemorySize, LDS_BYTES) != hipSuccess) { fprintf(stderr, "kernel_launch: hipFuncSetAttribute failed\n"); grid = -1; return; }
        grid = cus;
    }
    if (grid < 0) return;
    (void)hipMemsetAsync((char*)d_ws + WS_BAR, 0, 16384, stream);
    Params p{};
    const float** pp = (const float**)&p;
    for (int i = 0; i < 18; ++i) pp[i] = (const float*)d_in[i];
    p.out = (float*)d_out; p.ws = (unsigned char*)d_ws;
#if MK_N_LAUNCHES == 1
    p.ph_lo = 0; p.ph_hi = NPHASE;
    hipLaunchKernelGGL(mk_fwd, dim3(grid), dim3(NTHR), LDS_BYTES, stream, p);
#else
    for (int ph = 0; ph < NPHASE; ++ph) { p.ph_lo = ph; p.ph_hi = ph + 1; hipLaunchKernelGGL(mk_fwd, dim3(grid), dim3(NTHR), LDS_BYTES, stream, p); }
#endif
}
```

```cpp
#include <hip/hip_runtime.h>
#include <stdint.h>
#include <cstdio>

#ifndef NSA_MODE
#define NSA_MODE 1
#endif
#define NSA_PROBE (NSA_MODE == 2)
#ifndef REP_PH
#define REP_PH 0
#endif
#ifndef PHSEL
#define PHSEL 0xFF
#endif
#ifndef MK_N_LAUNCHES
#define MK_N_LAUNCHES 1
#endif

typedef unsigned short bf16_t;
typedef short bf16x8 __attribute__((ext_vector_type(8)));
typedef float f32x4 __attribute__((ext_vector_type(4)));
typedef unsigned u32x4 __attribute__((ext_vector_type(4)));
typedef unsigned u32x2 __attribute__((ext_vector_type(2)));
#define LAS __attribute__((address_space(3)))
#define GAS __attribute__((address_space(1)))
typedef GAS const float* gcf;
template <class Tp> __device__ __forceinline__ Tp* asg(Tp* p) { return (Tp*)(GAS Tp*)p; }

constexpr int NB = 4, S = 4096, T = NB * S, D = 1024, DEPTH = 4;
constexpr int DLRU = 512, HLRU = 8, DIN = 2840, NPAD = 3072, ZLD = 2848;
constexpr int ZU = 0, ZGL = 512, ZQ = 1024, ZGN = 1536, ZKC = 2048, ZVC = 2176, ZKS = 2304, ZVS = 2432, ZKW = 2560, ZVW = 2688, ZGATE = 2816;
constexpr int NC = 255, NCP = 256, CMPH = 256, CMPK = 2048;
constexpr float EPS = 1e-6f, NEGF = -1e30f, SCALE = 0.125f;
constexpr int NTHR = 512, NWAVE = 8;
constexpr int NPHASE = 2 + 4 * DEPTH;

constexpr size_t al256(size_t x) { return (x + 255) & ~(size_t)255; }
constexpr size_t WS_PANEL = 14400;
constexpr size_t WS_PROBE = 15360;
constexpr size_t WS_BAR   = 0;
constexpr size_t WS_WTIN  = 16384;
constexpr size_t WS_WTOUT = WS_WTIN  + al256((size_t)DEPTH * NPAD * D * 2);
constexpr size_t WS_W1T   = WS_WTOUT + al256((size_t)DEPTH * D * D * 2);
constexpr size_t WS_W2T   = WS_W1T   + al256((size_t)DEPTH * 2 * CMPH * CMPK * 2);
constexpr size_t WS_WAT   = WS_W2T   + al256((size_t)DEPTH * 2 * 64 * CMPH * 2);
constexpr size_t WS_BIAS1 = WS_WAT   + al256((size_t)DEPTH * 2 * HLRU * 64 * 64 * 2);
constexpr size_t WS_LRUC  = WS_BIAS1 + al256((size_t)DEPTH * 2 * CMPH * 4);
constexpr size_t WS_ROPEC = WS_LRUC  + al256((size_t)DEPTH * DLRU * 4);
constexpr size_t WS_ROPES = WS_ROPEC + al256((size_t)S * 32 * 4);
constexpr size_t WS_XB    = WS_ROPES + al256((size_t)S * 32 * 4);
constexpr size_t WS_SSQ   = WS_XB    + al256((size_t)T * D * 2);
constexpr size_t WS_Z     = WS_SSQ   + al256((size_t)T * 16 * 4);
constexpr size_t WS_KR    = WS_Z     + al256((size_t)T * ZLD * 2);
constexpr size_t WS_KCMP  = WS_KR    + al256((size_t)T * 256 * 2);
constexpr size_t WS_VCMP  = WS_KCMP  + al256((size_t)NB * 2 * NCP * 64 * 2);
constexpr size_t WS_DBUF  = WS_VCMP  + al256((size_t)NB * 2 * NCP * 64 * 2);
constexpr size_t WS_AGG   = WS_DBUF  + al256((size_t)T * DLRU * 4);
constexpr size_t WS_YBUF  = WS_AGG   + al256((size_t)NB * 128 * DLRU * 2 * 4);
constexpr size_t WS_END   = WS_YBUF  + al256((size_t)T * D * 2);
static_assert(WS_END <= (size_t)256 * 1024 * 1024, "workspace map exceeds 256 MiB");
#ifndef WT_MASK
#define WT_MASK 255
#endif
typedef unsigned wt_u32x4 __attribute__((ext_vector_type(4)));
__device__ __forceinline__ void st16wt(const unsigned char* ws, const void* ptr, wt_u32x4 v) {
    const __amdgpu_buffer_rsrc_t r = __builtin_amdgcn_make_buffer_rsrc((void*)ws, (short)0, (int)WS_END, 0x00020000);
    __builtin_amdgcn_raw_buffer_store_b128(v, r, (unsigned)((const unsigned char*)ptr - ws), 0,   16);
}
__device__ __forceinline__ void st16wt_out(const float* out, const void* ptr, wt_u32x4 v) {
    const __amdgpu_buffer_rsrc_t r = __builtin_amdgcn_make_buffer_rsrc((void*)out, (short)0, (int)((size_t)T * D * 4), 0x00020000);
    __builtin_amdgcn_raw_buffer_store_b128(v, r, (unsigned)((const unsigned char*)ptr - (const unsigned char*)out), 0,   16);
}

constexpr int LDS_BYTES = 156 * 1024;
constexpr int LDS_CTL = 0;
constexpr int LDS_INP = 16;
constexpr int LDS_WORK = 256;

struct Params {
    const float *x, *norm_g, *w_in, *conv_w, *conv_b, *lru_wa, *lru_ba, *lru_wi, *lru_bi, *lru_lambda, *pos_k, *pos_v, *k_w1, *k_w2, *v_w1, *v_w2, *w_out, *final_g;
    float* out; unsigned char* ws;
    int ph_lo, ph_hi;
};

__device__ __forceinline__ bf16_t f2bf(float f) { unsigned u = __float_as_uint(f); u += 0x7fffu + ((u >> 16) & 1u); return (bf16_t)(u >> 16); }
__device__ __forceinline__ float bf2f(bf16_t h) { return __uint_as_float(((unsigned)h) << 16); }
__device__ __forceinline__ unsigned pack2(float lo, float hi) { return (unsigned)f2bf(lo) | ((unsigned)f2bf(hi) << 16); }
__device__ __forceinline__ unsigned cvtpk_(float lo, float hi) { unsigned r; asm("v_cvt_pk_bf16_f32 %0, %1, %2" : "=v"(r) : "v"(lo), "v"(hi)); return r; }
__device__ __forceinline__ float bflo(unsigned w) { return __uint_as_float(w << 16); }
__device__ __forceinline__ float bfhi(unsigned w) { return __uint_as_float(w & 0xffff0000u); }
__device__ __forceinline__ float sigmoidf_(float x) { return 1.0f / (1.0f + __expf(-x)); }
__device__ __forceinline__ float siluf_(float x) { return x / (1.0f + __expf(-x)); }
__device__ __forceinline__ float wave_max(float v) {
#pragma unroll
    for (int o = 32; o > 0; o >>= 1) v = fmaxf(v, __shfl_xor(v, o));
    return v; }
__device__ __forceinline__ float wave_sum(float v) {
#pragma unroll
    for (int o = 32; o > 0; o >>= 1) v += __shfl_xor(v, o);
    return v; }

#define XB_TMO      128
#define XB_XCNT(j)  (256  + 64 * (j))
#define XB_XSUB(j)  (1280 + 64 * (j))
#define XB_XGEN(j)  (2304 + 64 * (j))
#define XB_TOP      3328
#define XB_TOPGEN   3392
#define XCD_BAR_WORDS 3456
#define XB_SPIN_CAP (1u << 22)
__device__ __forceinline__ unsigned xb_ld(unsigned* p)              { return __hip_atomic_load(p, __ATOMIC_RELAXED, __HIP_MEMORY_SCOPE_AGENT); }
__device__ __forceinline__ unsigned xb_add(unsigned* p, unsigned v) { return __hip_atomic_fetch_add(p, v, __ATOMIC_RELAXED, __HIP_MEMORY_SCOPE_AGENT); }
__device__ __forceinline__ unsigned xb_xcc_id() { return (unsigned)__builtin_amdgcn_s_getreg((3 << 11) | 20) & 0xFu; }
#define XB_SPIN(cond, bar) do { unsigned _sp = 0; while (cond) { __builtin_amdgcn_s_sleep(1); \
    if ((++_sp & 255u) == 0u) { if (xb_ld(&(bar)[XB_TMO])) break; if (_sp > XB_SPIN_CAP) { atomicAdd(&(bar)[XB_TMO], 1u); break; } } } } while (0)
struct XcdBarrier { unsigned* bar; unsigned x; volatile LAS unsigned* st; };
__device__ __forceinline__ XcdBarrier xcd_barrier_post(unsigned* bar, volatile LAS unsigned* st) {
    XcdBarrier b; b.bar = bar; b.x = xb_xcc_id(); b.st = st;
    if (threadIdx.x == 0) (void)xb_add(&bar[XB_XCNT(b.x)], 1u);
    return b;
}
__device__ __forceinline__ void xcd_barrier_complete(unsigned* bar, unsigned x, unsigned& nloc, unsigned& nx) {
    const unsigned G = gridDim.x * gridDim.y * gridDim.z;
    unsigned sum, cnt, mine, sp = 0u;
    for (;;) {
        sum = 0u; cnt = 0u; mine = 0u;
#pragma unroll
        for (unsigned j = 0; j < 16; ++j) { const unsigned c = xb_ld(&bar[XB_XCNT(j)]); sum += c; cnt += (c > 0u) ? 1u : 0u; mine = (j == x) ? c : mine; }
        if (sum == G) break;
        __builtin_amdgcn_s_sleep(1);
        if ((++sp & 255u) == 0u) { if (xb_ld(&bar[XB_TMO])) break; if (sp > XB_SPIN_CAP) { atomicAdd(&bar[XB_TMO], 1u); break; } }
    }
    nloc = mine > 0u ? mine : 1u; nx = cnt > 0u ? cnt : 1u;
}
__device__ __forceinline__ void xcd_barrier(const XcdBarrier& b) {
    asm volatile("s_waitcnt vmcnt(0)" ::: "memory");
    __syncthreads();
    if (threadIdx.x == 0) {
        unsigned* bar = b.bar;
        __builtin_amdgcn_s_waitcnt(0);
        unsigned nloc = b.st[0], nx = b.st[1];
        if (nloc == 0u) { xcd_barrier_complete(bar, b.x, nloc, nx); b.st[0] = nloc; b.st[1] = nx; }
        const unsigned old = xb_add(&bar[XB_XSUB(b.x)], 1u);
        const unsigned gen = old / nloc;
        if (old + 1u == (gen + 1u) * nloc) {
            __builtin_amdgcn_fence(__ATOMIC_RELEASE, "agent");
            asm volatile("s_waitcnt vmcnt(0)" ::: "memory");
            const unsigned og = xb_add(&bar[XB_TOP], 1u);
            const unsigned tg = og / nx;
            if (og + 1u == (tg + 1u) * nx) xb_add(&bar[XB_TOPGEN], 1u);
            else XB_SPIN(xb_ld(&bar[XB_TOPGEN]) == tg, bar);
            __builtin_amdgcn_fence(__ATOMIC_ACQUIRE, "agent");
            xb_add(&bar[XB_XGEN(b.x)], 1u);
            asm volatile("s_waitcnt vmcnt(0)" ::: "memory");
        } else {
            XB_SPIN(xb_ld(&bar[XB_XGEN(b.x)]) == gen, bar);
            __builtin_amdgcn_fence(__ATOMIC_ACQUIRE, "agent");
            asm volatile("s_waitcnt vmcnt(0)" ::: "memory");
        }
    }
    __syncthreads();
}

struct Frame {
    Params p;
    LAS unsigned char* lds;
    int tid, lane, wave, bid;
    __device__ __forceinline__ gcf in(int i) const { const unsigned long long v = *(const LAS unsigned long long*)(lds + LDS_INP + 8 * i);
        const unsigned lo = __builtin_amdgcn_readfirstlane((unsigned)v), hi = __builtin_amdgcn_readfirstlane((unsigned)(v >> 32)); return (gcf)(((unsigned long long)hi << 32) | lo); }
    __device__ __forceinline__ bf16_t* wt_in()  const { return (bf16_t*)(p.ws + WS_WTIN); }
    __device__ __forceinline__ bf16_t* wt_out() const { return (bf16_t*)(p.ws + WS_WTOUT); }
    __device__ __forceinline__ bf16_t* w1t()    const { return (bf16_t*)(p.ws + WS_W1T); }
    __device__ __forceinline__ bf16_t* w2t()    const { return (bf16_t*)(p.ws + WS_W2T); }
    __device__ __forceinline__ bf16_t* wat()    const { return (bf16_t*)(p.ws + WS_WAT); }
    __device__ __forceinline__ float*  bias1()  const { return (float*)(p.ws + WS_BIAS1); }
    __device__ __forceinline__ float*  lruc()   const { return (float*)(p.ws + WS_LRUC); }
    __device__ __forceinline__ float*  ropec()  const { return (float*)(p.ws + WS_ROPEC); }
    __device__ __forceinline__ float*  ropes()  const { return (float*)(p.ws + WS_ROPES); }
    __device__ __forceinline__ bf16_t* xb()     const { return (bf16_t*)(p.ws + WS_XB); }
    __device__ __forceinline__ unsigned* lrus()  const { return (unsigned*)(p.ws + WS_DBUF); }
    __device__ __forceinline__ float*  abuf()   const { return (float*)(p.ws + WS_XB); }
    __device__ __forceinline__ float*  ssq()    const { return (float*)(p.ws + WS_SSQ); }
    __device__ __forceinline__ bf16_t* z()      const { return (bf16_t*)(p.ws + WS_Z); }
    __device__ __forceinline__ bf16_t* kr()     const { return (bf16_t*)(p.ws + WS_KR); }
    __device__ __forceinline__ bf16_t* kcmp()   const { return (bf16_t*)(p.ws + WS_KCMP); }
    __device__ __forceinline__ bf16_t* vcmp()   const { return (bf16_t*)(p.ws + WS_VCMP); }
    __device__ __forceinline__ float*  dbuf()   const { return (float*)(p.ws + WS_DBUF); }
    __device__ __forceinline__ float*  agg()    const { return (float*)(p.ws + WS_AGG); }
    __device__ __forceinline__ bf16_t* ybuf()   const { return (bf16_t*)(p.ws + WS_YBUF); }
};

template <int BM, int BN, int WM, int WN, int PF, class APtr>
__device__ __forceinline__ void gemm_mainloop(const APtr& aptr, const bf16_t* __restrict__ Bt, int ldb, int K, int n0, LAS unsigned char* smem,
                                              f32x4 (&acc)[BM / WM / 16][BN / WN / 16], int tid) {
    constexpr int MT = BM / WM / 16, NT = BN / WN / 16;
    constexpr int ACH = BM * 8 / NTHR, BCH = BN * 8 / NTHR;
    static_assert(ACH >= 1 && BCH >= 1, "tile too small for 512 threads");
    constexpr int ABYTES = BM * 128, BBYTES = BN * 128;
    const int lane = tid & 63, wave = tid >> 6, wm = wave / WN, wn = wave % WN;
    const int fr = lane & 15, fq = lane >> 4;
#pragma unroll
    for (int i = 0; i < MT; ++i)
#pragma unroll
        for (int j = 0; j < NT; ++j) acc[i][j] = (f32x4){0.f, 0.f, 0.f, 0.f};
    u32x4 ra[PF][ACH], rb[PF][BCH];
    const int nk = K / 64;
#define GM_LOAD(slot, kt_) do { const int k1_ = (kt_) * 64; \
        _Pragma("unroll") for (int i = 0; i < ACH; ++i) { const int idx = tid + NTHR * i, r = idx >> 3, c = idx & 7; ra[slot][i] = *(const u32x4*)(aptr(r, k1_) + c * 8); } \
        _Pragma("unroll") for (int i = 0; i < BCH; ++i) { const int idx = tid + NTHR * i, r = idx >> 3, c = idx & 7; rb[slot][i] = *(const u32x4*)(Bt + (size_t)(n0 + r) * ldb + k1_ + c * 8); } } while (0)
#define GM_WRITE(slot, buf_) do { LAS unsigned char* An = smem + (buf_) * ABYTES; LAS unsigned char* Bn = smem + 2 * ABYTES + (buf_) * BBYTES; \
        _Pragma("unroll") for (int i = 0; i < ACH; ++i) { const int idx = tid + NTHR * i, r = idx >> 3, c = idx & 7; *(LAS u32x4*)(An + r * 128 + ((c ^ (r & 7)) << 4)) = ra[slot][i]; } \
        _Pragma("unroll") for (int i = 0; i < BCH; ++i) { const int idx = tid + NTHR * i, r = idx >> 3, c = idx & 7; *(LAS u32x4*)(Bn + r * 128 + ((c ^ (r & 7)) << 4)) = rb[slot][i]; } } while (0)
#pragma unroll
    for (int s = 0; s < PF; ++s) if (s < nk) GM_LOAD(s, s);
    GM_WRITE(0, 0);
    __syncthreads();
    for (int kt0 = 0; kt0 < nk; kt0 += PF) {
#pragma unroll
        for (int u = 0; u < PF; ++u) {
            const int kt = kt0 + u;
            if (kt < nk) {
                const int cur = kt & 1;
                if (kt + PF < nk) GM_LOAD(u, kt + PF);
                const LAS unsigned char* As = smem + cur * ABYTES;
                const LAS unsigned char* Bs = smem + 2 * ABYTES + cur * BBYTES;
#pragma unroll
                for (int kk = 0; kk < 2; ++kk) {
                    bf16x8 af[MT], bfr[NT];
#pragma unroll
                    for (int i = 0; i < MT; ++i) { const int r = wm * MT * 16 + i * 16 + fr, c = kk * 4 + fq; af[i] = *(const LAS bf16x8*)(As + r * 128 + ((c ^ (r & 7)) << 4)); }
#pragma unroll
                    for (int j = 0; j < NT; ++j) { const int r = wn * NT * 16 + j * 16 + fr, c = kk * 4 + fq; bfr[j] = *(const LAS bf16x8*)(Bs + r * 128 + ((c ^ (r & 7)) << 4)); }
#pragma unroll
                    for (int i = 0; i < MT; ++i)
#pragma unroll
                        for (int j = 0; j < NT; ++j) acc[i][j] = __builtin_amdgcn_mfma_f32_16x16x32_bf16(bfr[j], af[i], acc[i][j], 0, 0, 0);
                }
                if (kt + 1 < nk) GM_WRITE((u + 1) % PF, cur ^ 1);
                __syncthreads();
            }
        }
    }
#undef GM_LOAD
#undef GM_WRITE
}

struct APlain { const bf16_t* A; int lda; int m0; __device__ __forceinline__ const bf16_t* operator()(int r, int k0) const { return A + (size_t)(m0 + r) * lda + k0; } };

namespace pg8 {
#define PG8_LAS __attribute__((address_space(3)))
typedef unsigned short bf16_t;
typedef short bf16x8 __attribute__((ext_vector_type(8)));
typedef float f32x4 __attribute__((ext_vector_type(4)));
typedef unsigned u32x4 __attribute__((ext_vector_type(4)));
constexpr int BM = 256, BK = 64, HALF = 128, HTB = HALF * BK * 2  , STAGE_BYTES = 8 * HTB, NXCD = 8, WGM = 8;

__host__ __device__ __forceinline__ int lds_byte(int r, int c) { const int st = (r >> 4) * 2 + (c >> 5), rr = r & 15, cc = c & 31, ob = rr * 64 + cc * 2; return st * 1024 + (ob ^ (((ob >> 9) & 1) << 5)); }
__host__ __device__ __forceinline__ void stage_rc(int b, int& R, int& C) { const int st = b / 1024, sb = b % 1024, swz = sb ^ (((sb >> 9) & 1) << 5); R = (st >> 1) * 16 + swz / 64; C = (st & 1) * 32 + (swz % 64) / 2; }
__host__ __device__ __forceinline__ int perm32(int rho) { const int n = rho >> 4, i = rho & 15; return 8 * (i >> 2) + 4 * n + (i & 3); }

struct Unit { int pm, pn; };
struct Gemm { const bf16_t* A; const bf16_t* Bt; int M, N, K; };

struct StaticOrder {
    int nM, nN, nwg, G, c;
    __host__ __device__ void init(int M, int N, int G_, int c_) { nM = M / BM; nN = N / BM; nwg = nM * nN; G = G_; c = c_; }
    __host__ __device__ bool next(int i, Unit& u) const {
        const long L = (long)i * G + c; if (L >= nwg) return false;
        int wgid = (int)L; { const int q = nwg / NXCD, r = nwg % NXCD, xcd = wgid % NXCD, off = wgid / NXCD; wgid = (xcd < r ? xcd * (q + 1) : r * (q + 1) + (xcd - r) * q) + off; }
        const int nig = WGM * nN, gid = wgid / nig, fm = gid * WGM, gsz = (nM - fm) < WGM ? (nM - fm) : WGM;
        u.pm = fm + ((wgid % nig) % gsz); u.pn = (wgid % nig) / gsz; return true;
    }
    __device__ __forceinline__ void a_ready(const Unit&) const {}
    __device__ __forceinline__ void done(const Unit&) const {}
};

__device__ __forceinline__ unsigned cvt_pk_bf16(float lo, float hi) { unsigned r; asm volatile("v_cvt_pk_bf16_f32 %0, %1, %2" : "=v"(r) : "v"(lo), "v"(hi)); return r; }
struct EpiInProj {
    static constexpr bool PERM = true, AFTER_DRAIN = false;
    bf16_t* Z; const float* ssq; int ldz, ncol; const unsigned char* ws;
    __device__ __forceinline__ void operator()(const f32x4 (&acc)[2][2][4][2], const Unit& u, int wr, int wc, int fr, int fq) const {
        const int row0 = u.pm * BM + wr * 64 + fr, col0 = u.pn * BM + wc * 32 + 8 * fq;
#pragma unroll
        for (int ai = 0; ai < 2; ++ai)
#pragma unroll
            for (int m = 0; m < 4; ++m) {
                const int row = row0 + ai * HALF + m * 16;
                const f32x4* sp = (const f32x4*)(ssq + (size_t)row * 16);
                const f32x4 s4 = (sp[0] + sp[1]) + (sp[2] + sp[3]);
                const float rs = __builtin_amdgcn_rsqf(((s4[0] + s4[1]) + (s4[2] + s4[3])) * (1.0f / 1024.0f) + 1e-6f);
                bf16_t* rowp = Z + (size_t)row * ldz;
#pragma unroll
                for (int bj = 0; bj < 2; ++bj) {
                    const int col = col0 + bj * HALF;
                    if (col < ncol) { const f32x4 v0 = acc[ai][bj][m][0] * rs, v1 = acc[ai][bj][m][1] * rs;
                        u32x4 w; w.x = cvt_pk_bf16(v0[0], v0[1]); w.y = cvt_pk_bf16(v0[2], v0[3]); w.z = cvt_pk_bf16(v1[0], v1[1]); w.w = cvt_pk_bf16(v1[2], v1[3]);
                        if constexpr ((WT_MASK & 1) != 0) st16wt(ws, rowp + col, w); else *(u32x4*)(rowp + col) = w; }
                }
            }
    }
};
template <bool FIRST> struct EpiOutProj {
    static constexpr bool PERM = true, AFTER_DRAIN = false;
    GAS const float* xin; bf16_t* xb; float* ssq; const unsigned char* ws;
    __device__ __forceinline__ void operator()(const f32x4 (&acc)[2][2][4][2], const Unit& u, int wr, int wc, int fr, int fq) const {
        const int row0 = u.pm * BM + wr * 64 + fr, col0 = u.pn * BM + wc * 32 + 8 * fq;
#pragma unroll
        for (int ai = 0; ai < 2; ++ai)
#pragma unroll
            for (int m = 0; m < 4; ++m) {
                const int row = row0 + ai * HALF + m * 16;
                float ss = 0.f;
#pragma unroll
                for (int bj = 0; bj < 2; ++bj) {
                    const size_t o = (size_t)row * 1024 + col0 + bj * HALF;
                    f32x4 v0, v1;
                    if constexpr (FIRST) { v0 = __builtin_nontemporal_load((GAS const f32x4*)(xin + o)) + acc[ai][bj][m][0]; v1 = __builtin_nontemporal_load((GAS const f32x4*)(xin + o + 4)) + acc[ai][bj][m][1]; }
                    else { const u32x4 xw = *(const u32x4*)(xb + o);
                        v0 = (f32x4){__uint_as_float(xw.x << 16), __uint_as_float(xw.x & 0xffff0000u), __uint_as_float(xw.y << 16), __uint_as_float(xw.y & 0xffff0000u)} + acc[ai][bj][m][0];
                        v1 = (f32x4){__uint_as_float(xw.z << 16), __uint_as_float(xw.z & 0xffff0000u), __uint_as_float(xw.w << 16), __uint_as_float(xw.w & 0xffff0000u)} + acc[ai][bj][m][1]; }
                    u32x4 w; w.x = cvt_pk_bf16(v0[0], v0[1]); w.y = cvt_pk_bf16(v0[2], v0[3]); w.z = cvt_pk_bf16(v1[0], v1[1]); w.w = cvt_pk_bf16(v1[2], v1[3]);
                    if constexpr ((WT_MASK & 2) != 0) st16wt(ws, xb + o, w); else *(u32x4*)(xb + o) = w;
                    ss += ((v0[0] * v0[0] + v0[1] * v0[1]) + (v0[2] * v0[2] + v0[3] * v0[3])) + ((v1[0] * v1[0] + v1[1] * v1[1]) + (v1[2] * v1[2] + v1[3] * v1[3]));
                }
                ss += __shfl_xor(ss, 16); ss += __shfl_xor(ss, 32);
                if (fq == 0) ssq[(size_t)row * 16 + u.pn * 4 + wc] = ss;
            }
    }
};

struct EpiOutFinal {
    static constexpr bool PERM = true, AFTER_DRAIN = true;
    const bf16_t* xb; float* out; GAS const float* gain; unsigned* slot; unsigned* cnt; unsigned* tmo;
    __device__ __forceinline__ void operator()(const f32x4 (&)[2][2][4][2], const Unit&, int, int, int, int) const {}
    __device__ __forceinline__ void fused(f32x4 (&acc)[2][2][4][2], const Unit& u, int wr, int wc, int fr, int fq, PG8_LAS unsigned char* lds, int wid, int lane) const {
        PG8_LAS float* P = (PG8_LAS float*)lds;
        PG8_LAS float* Sr = (PG8_LAS float*)(lds + 4096);
        const int row0 = u.pm * BM + wr * 64 + fr, col0 = u.pn * BM + wc * 32 + 8 * fq;
#pragma unroll
        for (int ai = 0; ai < 2; ++ai)
#pragma unroll
            for (int m = 0; m < 4; ++m) {
                const int row = row0 + ai * HALF + m * 16;
                float ss = 0.f;
#pragma unroll
                for (int bj = 0; bj < 2; ++bj) {
                    const u32x4 xw = *(const u32x4*)(xb + (size_t)row * 1024 + col0 + bj * HALF);
                    const f32x4 v0 = (f32x4){__uint_as_float(xw.x << 16), __uint_as_float(xw.x & 0xffff0000u), __uint_as_float(xw.y << 16), __uint_as_float(xw.y & 0xffff0000u)} + acc[ai][bj][m][0];
                    const f32x4 v1 = (f32x4){__uint_as_float(xw.z << 16), __uint_as_float(xw.z & 0xffff0000u), __uint_as_float(xw.w << 16), __uint_as_float(xw.w & 0xffff0000u)} + acc[ai][bj][m][1];
                    acc[ai][bj][m][0] = v0; acc[ai][bj][m][1] = v1;
                    ss += ((v0[0] * v0[0] + v0[1] * v0[1]) + (v0[2] * v0[2] + v0[3] * v0[3])) + ((v1[0] * v1[0] + v1[1] * v1[1]) + (v1[2] * v1[2] + v1[3] * v1[3]));
                }
                ss += __shfl_xor(ss, 16); ss += __shfl_xor(ss, 32);
                if (fq == 0) P[(ai * HALF + wr * 64 + m * 16 + fr) * 4 + wc] = ss;
            }
        asm volatile("s_waitcnt lgkmcnt(0)" ::: "memory"); __builtin_amdgcn_s_barrier(); asm volatile("" ::: "memory");
        const int rowl = wid * 32 + (lane & 31);
        if (lane < 32) { const f32x4 p4 = *(const PG8_LAS f32x4*)(P + rowl * 4);
            __hip_atomic_store(slot + (size_t)(u.pm * BM + rowl) * 4 + u.pn, __float_as_uint((p4[0] + p4[1]) + (p4[2] + p4[3])), __ATOMIC_RELAXED, __HIP_MEMORY_SCOPE_AGENT); }
        asm volatile("s_waitcnt vmcnt(0)" ::: "memory");
        if (lane == 0) __hip_atomic_fetch_add(cnt + 2 * u.pm, 1u, __ATOMIC_RELAXED, __HIP_MEMORY_SCOPE_AGENT);
        if (wid == 0) {
            unsigned sp = 0u;
            for (;;) {
                if ((unsigned)__builtin_amdgcn_readfirstlane(__hip_atomic_load(cnt + 2 * u.pm, __ATOMIC_RELAXED, __HIP_MEMORY_SCOPE_AGENT)) >= 32u) break;
                __builtin_amdgcn_s_sleep(2);
                if ((++sp & 255u) == 0u) { if (__hip_atomic_load(tmo, __ATOMIC_RELAXED, __HIP_MEMORY_SCOPE_AGENT)) break; if (sp > (1u << 22)) { if (lane == 0) __hip_atomic_fetch_add(tmo, 1u, __ATOMIC_RELAXED, __HIP_MEMORY_SCOPE_AGENT); break; } }
            }
            __builtin_amdgcn_fence(__ATOMIC_ACQUIRE, "agent");
        }
        asm volatile("s_waitcnt vmcnt(0) lgkmcnt(0)" ::: "memory"); __builtin_amdgcn_s_barrier(); asm volatile("" ::: "memory");
        if (lane < 32) { const unsigned* sl = slot + (size_t)(u.pm * BM + rowl) * 4; float t = 0.f;
#pragma unroll
            for (int k = 0; k < 4; ++k) t += __uint_as_float(__hip_atomic_load(sl + k, __ATOMIC_RELAXED, __HIP_MEMORY_SCOPE_AGENT));
            Sr[rowl] = 1.0f / sqrtf(t * (1.0f / 1024.0f) + 1e-6f); }
        asm volatile("s_waitcnt lgkmcnt(0)" ::: "memory"); __builtin_amdgcn_s_barrier(); asm volatile("" ::: "memory");
        f32x4 g[2][2];
#pragma unroll
        for (int bj = 0; bj < 2; ++bj)
#pragma unroll
            for (int n = 0; n < 2; ++n) g[bj][n] = *(GAS const f32x4*)(gain + col0 + bj * HALF + 4 * n);
        PG8_LAS float* Tl = (PG8_LAS float*)(lds + 8192);
#pragma unroll
        for (int ai = 0; ai < 2; ++ai) {
            float rsv[4];
#pragma unroll
            for (int m = 0; m < 4; ++m) rsv[m] = Sr[ai * HALF + wr * 64 + m * 16 + fr];
            if (ai == 1) { asm volatile("s_waitcnt lgkmcnt(0)" ::: "memory"); __builtin_amdgcn_s_barrier(); asm volatile("" ::: "memory"); }
#pragma unroll
            for (int m = 0; m < 4; ++m)
#pragma unroll
                for (int bj = 0; bj < 2; ++bj)
#pragma unroll
                    for (int n = 0; n < 2; ++n) *(PG8_LAS f32x4*)(Tl + (wr * 64 + m * 16 + fr) * 260 + bj * HALF + wc * 32 + 8 * fq + 4 * n) = acc[ai][bj][m][n] * rsv[m] * g[bj][n];
            asm volatile("s_waitcnt lgkmcnt(0)" ::: "memory"); __builtin_amdgcn_s_barrier(); asm volatile("" ::: "memory");
#pragma unroll 4
            for (int r = wid; r < HALF; r += 8) {
                const f32x4 v = *(const PG8_LAS f32x4*)(Tl + r * 260 + lane * 4);
                *(f32x4*)(out + (size_t)(u.pm * BM + ai * HALF + r) * 1024 + u.pn * BM + lane * 4) = v;
            }
        }
    }
};

template <class Epi, class Sched, bool ALIGN_EPI = false, bool SP2 = false>
__device__ __forceinline__ void gemm_phase(PG8_LAS unsigned char* lds, const Gemm g, const Sched& S, const Epi& E, const int tid_in) {
    const int tid = tid_in, wid = __builtin_amdgcn_readfirstlane(tid >> 6), lane = tid & 63, wr = wid >> 2, wc = wid & 3, fr = lane & 15, fq = lane >> 4;
    const int K = g.K, nt = K / BK;
    unsigned voffA[2], voffB[2];
#pragma unroll
    for (int i = 0; i < 2; ++i) { int R, C; stage_rc(tid * 16 + i * 8192, R, C); const int Rb = Epi::PERM ? ((R & ~31) + perm32(R & 31)) : R;
        voffA[i] = (unsigned)(R * K + C) * 2u; voffB[i] = (unsigned)(Rb * K + C) * 2u; }
    const size_t kstep = (size_t)(BK * 2);
    const size_t hstep = (size_t)HALF * K * 2;
    const size_t tstep = 2 * hstep;
    const unsigned ldsw = (unsigned)wid * 1024u;
    const int aoff = lds_byte(wr * 64 + fr, fq * 8), boff = lds_byte(wc * 32 + fr, fq * 8);
#define PG8_SA(b, h) (((b) * 2 + (h)) * HTB)
#define PG8_SB(b, h) ((4 + (b) * 2 + (h)) * HTB)
#define PG8_STAGE(bufoff, gbase, voff) do { _Pragma("unroll") for (int _i = 0; _i < 2; ++_i) \
        __builtin_amdgcn_global_load_lds((const unsigned*)((const char*)(gbase) + (voff)[_i]), (PG8_LAS unsigned*)(lds + (bufoff) + ldsw + _i * 8192), 16, 0, 0); } while (0)
#define PG8_LDA(dst, b, h) do { _Pragma("unroll") for (int m = 0; m < 4; ++m) _Pragma("unroll") for (int k = 0; k < 2; ++k) dst[m][k] = *(const PG8_LAS bf16x8*)(lds + PG8_SA(b, h) + aoff + m * 2048 + k * 1024); } while (0)
#define PG8_LDB(dst, b, h) do { _Pragma("unroll") for (int n = 0; n < 2; ++n) _Pragma("unroll") for (int k = 0; k < 2; ++k) dst[n][k] = *(const PG8_LAS bf16x8*)(lds + PG8_SB(b, h) + boff + n * 2048 + k * 1024); } while (0)
#define PG8_MMA(ai, bj, At, Bt) do { __builtin_amdgcn_s_setprio(1); _Pragma("unroll") for (int m = 0; m < 4; ++m) _Pragma("unroll") for (int n = 0; n < 2; ++n) _Pragma("unroll") for (int k = 0; k < 2; ++k) \
        acc[ai][bj][m][n] = __builtin_amdgcn_mfma_f32_16x16x32_bf16(Bt[n][k], At[m][k], acc[ai][bj][m][n], 0, 0, 0); __builtin_amdgcn_s_setprio(0); } while (0)
#define PG8_WAIT_V(n) asm volatile("s_waitcnt vmcnt(" #n ")" ::: "memory")
#define PG8_WAIT_L(n) asm volatile("s_waitcnt lgkmcnt(" #n ")" ::: "memory")
#define PG8_BAR __builtin_amdgcn_s_barrier()
#define PG8_SCHED __builtin_amdgcn_sched_barrier(0)
    Unit cur, nxt; int ui = 0;
    if (!S.next(0, cur)) return;
    f32x4 acc[2][2][4][2];
#pragma unroll
    for (int a = 0; a < 2; ++a)
#pragma unroll
        for (int b = 0; b < 2; ++b)
#pragma unroll
            for (int m = 0; m < 4; ++m)
#pragma unroll
                for (int n = 0; n < 2; ++n) acc[a][b][m][n] = (f32x4){0.f, 0.f, 0.f, 0.f};
    bf16x8 At[4][2], B0[2][2], B1[2][2];
    const char* cA = (const char*)g.A + (size_t)cur.pm * tstep; const char* cB = (const char*)g.Bt + (size_t)cur.pn * tstep;
    S.a_ready(cur);
    if constexpr (SP2) {
        PG8_STAGE(PG8_SB(0, 0), cB, voffB); PG8_STAGE(PG8_SB(0, 1), cB + hstep, voffB); PG8_STAGE(PG8_SA(0, 0), cA, voffA); PG8_STAGE(PG8_SA(0, 1), cA + hstep, voffA);
        if (wr == 1) PG8_BAR;
        PG8_WAIT_V(2); PG8_BAR;
        PG8_STAGE(PG8_SB(1, 0), cB + kstep, voffB); PG8_STAGE(PG8_SA(1, 0), cA + kstep, voffA); PG8_STAGE(PG8_SB(1, 1), cB + hstep + kstep, voffB);
        PG8_WAIT_V(6); PG8_BAR;
    } else {
        PG8_STAGE(PG8_SB(0, 0), cB, voffB); PG8_STAGE(PG8_SA(0, 0), cA, voffA); PG8_STAGE(PG8_SB(0, 1), cB + hstep, voffB); PG8_STAGE(PG8_SA(0, 1), cA + hstep, voffA);
        if (wr == 1) PG8_BAR;
        PG8_WAIT_V(4); PG8_BAR;
        PG8_STAGE(PG8_SB(1, 0), cB + kstep, voffB); PG8_STAGE(PG8_SA(1, 0), cA + kstep, voffA); PG8_STAGE(PG8_SB(1, 1), cB + hstep + kstep, voffB);
        PG8_WAIT_V(6); PG8_BAR;
    }
    for (;;) {
        const bool has_next = S.next(ui + 1, nxt);
        const char* nA = has_next ? (const char*)g.A + (size_t)nxt.pm * tstep : cA; const char* nB = has_next ? (const char*)g.Bt + (size_t)nxt.pn * tstep : cB;
        for (int t = 0; t < nt; t += 2) {
            const bool last = (t == nt - 2);
            const char* a1 = cA + (size_t)(t + 1) * kstep;
            const char* a2 = last ? nA : cA + (size_t)(t + 2) * kstep; const char* b2 = last ? nB : cB + (size_t)(t + 2) * kstep;
            const char* a3 = a2 + kstep; const char* b3 = b2 + kstep;
            if (last && has_next) S.a_ready(nxt);
            if constexpr (SP2) {
            PG8_LDB(B0, 0, 0); PG8_LDB(B1, 0, 1); PG8_SCHED; PG8_LDA(At, 0, 0); PG8_STAGE(PG8_SA(1, 1), a1 + hstep, voffA);
            PG8_WAIT_V(8); PG8_WAIT_L(0); PG8_BAR; PG8_MMA(0, 0, At, B0); PG8_MMA(0, 1, At, B1); PG8_BAR; PG8_SCHED;
            PG8_LDA(At, 0, 1); PG8_STAGE(PG8_SB(0, 0), b2, voffB); PG8_STAGE(PG8_SB(0, 1), b2 + hstep, voffB); PG8_STAGE(PG8_SA(0, 0), a2, voffA);
            PG8_WAIT_V(8); PG8_WAIT_L(0); PG8_BAR; PG8_MMA(1, 0, At, B0); PG8_MMA(1, 1, At, B1); PG8_BAR; PG8_SCHED;
            PG8_LDB(B0, 1, 0); PG8_LDB(B1, 1, 1); PG8_SCHED; PG8_LDA(At, 1, 0); PG8_STAGE(PG8_SA(0, 1), a2 + hstep, voffA);
            PG8_WAIT_V(8); PG8_WAIT_L(0); PG8_BAR; PG8_MMA(0, 0, At, B0); PG8_MMA(0, 1, At, B1); PG8_BAR; PG8_SCHED;
            PG8_LDA(At, 1, 1); PG8_STAGE(PG8_SB(1, 0), b3, voffB); PG8_STAGE(PG8_SB(1, 1), b3 + hstep, voffB); PG8_STAGE(PG8_SA(1, 0), a3, voffA);
            PG8_WAIT_V(8); PG8_WAIT_L(0); PG8_BAR; PG8_MMA(1, 0, At, B0); PG8_MMA(1, 1, At, B1); PG8_BAR; PG8_SCHED;
            } else {
            PG8_LDB(B0, 0, 0); PG8_SCHED; PG8_LDA(At, 0, 0); PG8_STAGE(PG8_SA(1, 1), a1 + hstep, voffA);
            PG8_WAIT_L(8); PG8_BAR; PG8_WAIT_L(0); PG8_MMA(0, 0, At, B0); PG8_BAR; PG8_SCHED;
            PG8_LDB(B1, 0, 1); PG8_STAGE(PG8_SB(0, 0), b2, voffB);
            PG8_BAR; PG8_WAIT_L(0); PG8_MMA(0, 1, At, B1); PG8_BAR;
            PG8_LDA(At, 0, 1); PG8_STAGE(PG8_SA(0, 0), a2, voffA);
            PG8_BAR; PG8_WAIT_L(0); PG8_MMA(1, 0, At, B0); PG8_BAR; PG8_SCHED;
            PG8_STAGE(PG8_SB(0, 1), b2 + hstep, voffB);
            PG8_WAIT_V(6); PG8_BAR; PG8_MMA(1, 1, At, B1); PG8_BAR;
            PG8_LDB(B0, 1, 0); PG8_SCHED; PG8_LDA(At, 1, 0); PG8_STAGE(PG8_SA(0, 1), a2 + hstep, voffA);
            PG8_WAIT_L(8); PG8_BAR; PG8_WAIT_L(0); PG8_MMA(0, 0, At, B0); PG8_BAR; PG8_SCHED;
            PG8_LDB(B1, 1, 1); PG8_STAGE(PG8_SB(1, 0), b3, voffB);
            PG8_BAR; PG8_WAIT_L(0); PG8_MMA(0, 1, At, B1); PG8_BAR;
            PG8_LDA(At, 1, 1); PG8_STAGE(PG8_SA(1, 0), a3, voffA);
            PG8_BAR; PG8_WAIT_L(0); PG8_MMA(1, 0, At, B0); PG8_BAR; PG8_SCHED;
            PG8_STAGE(PG8_SB(1, 1), b3 + hstep, voffB);
            PG8_WAIT_V(6); PG8_BAR; PG8_MMA(1, 1, At, B1); PG8_BAR;
            }
        }
        if constexpr (ALIGN_EPI) { if (wr == 0) PG8_BAR; }
        if constexpr (!Epi::AFTER_DRAIN) { E(acc, cur, wr, wc, fr, fq); S.done(cur); }
        if (!has_next) break;
#pragma unroll
        for (int a = 0; a < 2; ++a)
#pragma unroll
            for (int b = 0; b < 2; ++b)
#pragma unroll
                for (int m = 0; m < 4; ++m)
#pragma unroll
                    for (int n = 0; n < 2; ++n) acc[a][b][m][n] = (f32x4){0.f, 0.f, 0.f, 0.f};
        cur = nxt; cA = nA; cB = nB; ++ui;
        if constexpr (ALIGN_EPI) { if (wr == 1) PG8_BAR; }
    }
    PG8_WAIT_V(0);
    if constexpr (!ALIGN_EPI) { if (wr == 0) PG8_BAR; }
    PG8_BAR;
    if constexpr (Epi::AFTER_DRAIN) { E.fused(acc, cur, wr, wc, fr, fq, lds, wid, lane); S.done(cur); }
#undef PG8_SA
#undef PG8_SB
#undef PG8_STAGE
#undef PG8_LDA
#undef PG8_LDB
#undef PG8_MMA
#undef PG8_WAIT_V
#undef PG8_WAIT_L
#undef PG8_BAR
#undef PG8_SCHED
}
}

__device__ __forceinline__ void tr_tile(const Frame& F, gcf src, int R, int C, int ld_src, bf16_t* __restrict__ dst, int ld_dst, int Cpad, gcf rowscale, int r0, int c0) {
    LAS float* tile = (LAS float*)(F.lds + LDS_WORK);
#pragma unroll
    for (int i = 0; i < 2; ++i) {
        const int idx = F.tid + NTHR * i, rl = idx >> 4, c4 = (idx & 15) * 4;
        const int r = r0 + rl, c = c0 + c4;
        f32x4 v = (f32x4){0.f, 0.f, 0.f, 0.f};
        if (c < C) { v = __builtin_nontemporal_load((GAS const f32x4*)(src + (size_t)r * ld_src + c)); if (rowscale) v = v * rowscale[r]; }
        tile[rl * 65 + c4] = v[0]; tile[rl * 65 + c4 + 1] = v[1]; tile[rl * 65 + c4 + 2] = v[2]; tile[rl * 65 + c4 + 3] = v[3];
    }
    __syncthreads();
    {
        const int cl = F.tid >> 3, rg = (F.tid & 7) * 8;
        const int c = c0 + cl;
        if (c < Cpad) {
            u32x4 w;
            w.x = pack2(tile[(rg + 0) * 65 + cl], tile[(rg + 1) * 65 + cl]); w.y = pack2(tile[(rg + 2) * 65 + cl], tile[(rg + 3) * 65 + cl]);
            w.z = pack2(tile[(rg + 4) * 65 + cl], tile[(rg + 5) * 65 + cl]); w.w = pack2(tile[(rg + 6) * 65 + cl], tile[(rg + 7) * 65 + cl]);
            if constexpr ((WT_MASK & 4) != 0) st16wt(F.p.ws, dst + (size_t)c * ld_dst + r0 + rg, w); else *(u32x4*)(dst + (size_t)c * ld_dst + r0 + rg) = w;
        }
    }
    __syncthreads();
}

__device__ __forceinline__ void prep_layer(const Frame& F, int l) {
    const int G = gridDim.x, bid = F.bid;
    constexpr int T_IN = 16 * 48, T_OUT = 16 * 16, T_W1 = 32 * 4, T_W2 = 4, T_G = 8;
    constexpr int PER_L = T_IN + T_OUT + 2 * T_W1 + 2 * T_W2 + 2 * T_G;
    for (int it = bid; it < PER_L; it += G) {
        int j = it;
        if (j < T_IN) { tr_tile(F, F.in(2) + (size_t)l * D * DIN, D, DIN, DIN, F.wt_in() + (size_t)l * NPAD * D, D, NPAD, F.in(1) + l * D, (j % 16) * 64, (j / 16) * 64); continue; }
        j -= T_IN;
        if (j < T_OUT) { tr_tile(F, F.in(16) + (size_t)l * D * D, D, D, D, F.wt_out() + (size_t)l * D * D, D, D, nullptr, (j % 16) * 64, (j / 16) * 64); continue; }
        j -= T_OUT;
        if (j < 2 * T_W1) { const int kv = j / T_W1, jj = j % T_W1; gcf src = (kv ? F.in(14) : F.in(12)) + (size_t)l * CMPK * CMPH;
            tr_tile(F, src, CMPK, CMPH, CMPH, F.w1t() + (size_t)(l * 2 + kv) * CMPH * CMPK, CMPK, CMPH, nullptr, (jj % 32) * 64, (jj / 32) * 64); continue; }
        j -= 2 * T_W1;
        if (j < 2 * T_W2) { const int kv = j / T_W2, jj = j % T_W2; gcf src = (kv ? F.in(15) : F.in(13)) + (size_t)l * CMPH * 64;
            tr_tile(F, src, CMPH, 64, 64, F.w2t() + (size_t)(l * 2 + kv) * 64 * CMPH, CMPH, 64, nullptr, jj * 64, 0); continue; }
        j -= 2 * T_W2;
        { const int gsel = j / T_G, h = j % T_G; gcf src = (gsel ? F.in(7) : F.in(5)) + ((size_t)l * HLRU + h) * 64 * 64;
            tr_tile(F, src, 64, 64, 64, F.wat() + ((size_t)(l * 2 + gsel) * HLRU + h) * 64 * 64, 64, 64, nullptr, 0, 0); }
    }
    {
        LAS float* red = (LAS float*)(F.lds + LDS_WORK);
        for (int it = G - 1 - bid; it < 2 * 8; it += G) {
            const int kv = (it >> 3) & 1, jb = it & 7;
            gcf w1 = (kv ? F.in(14) : F.in(12)) + (size_t)l * CMPK * CMPH;
            gcf pos = (kv ? F.in(11) : F.in(10)) + (size_t)l * CMPK;
            const int j = jb * 32 + (F.tid & 31), ks = F.tid >> 5;
            float s = 0.f;
#pragma unroll 1
            for (int k0 = ks * 128; k0 < ks * 128 + 128; k0 += 16) {
                float wv[16], pv[16];
#pragma unroll
                for (int i = 0; i < 16; ++i) { wv[i] = w1[(size_t)(k0 + i) * CMPH + j]; pv[i] = pos[k0 + i]; }
#pragma unroll
                for (int i = 0; i < 16; ++i) s += pv[i] * wv[i];
            }
            red[ks * 32 + (F.tid & 31)] = s;
            __syncthreads();
            if (F.tid < 32) { float t = 0.f;
#pragma unroll
                for (int q = 0; q < 16; ++q) t += red[q * 32 + F.tid];
                F.bias1()[(l * 2 + kv) * CMPH + j] = t; }
            __syncthreads();
        }
    }
    for (int i = bid * NTHR + F.tid; i < DLRU; i += G * NTHR) {
        const float lm = F.in(9)[l * DLRU + i];
        const float sp = (lm > 20.f) ? expf(-lm) : log1pf(expf(-lm));
        F.lruc()[l * DLRU + i] = -8.0f * sp * 1.4426950408889634f;
    }
}

__device__ __forceinline__ void p0_prologue(const Frame& F) {
    const int G = gridDim.x, bid = F.bid;
    prep_layer(F, 0);
    for (int i = bid * NTHR + F.tid; i < S * 32; i += G * NTHR) {
        const int t = i >> 5, f = i & 31;
        const float inv = 1.0f / powf(10000.0f, (float)(2 * f) / 64.0f);
        const float ang = (float)t * inv;
        F.ropec()[i] = cosf(ang); F.ropes()[i] = sinf(ang);
    }
    for (int row = bid * NWAVE + F.wave; row < T; row += G * NWAVE) {
        gcf xr = F.in(0) + (size_t)row * D;
        float ss = 0.f;
#pragma unroll
        for (int i = 0; i < 2; ++i) {
            const f32x4 v = __builtin_nontemporal_load((GAS const f32x4*)(xr + (i * 64 + F.lane) * 8)), v2 = __builtin_nontemporal_load((GAS const f32x4*)(xr + (i * 64 + F.lane) * 8 + 4));
            ss += (v[0] * v[0] + v[1] * v[1] + v[2] * v[2] + v[3] * v[3]) + (v2[0] * v2[0] + v2[1] * v2[1] + v2[2] * v2[2] + v2[3] * v2[3]);
            u32x4 w; w.x = pack2(v[0], v[1]); w.y = pack2(v[2], v[3]); w.z = pack2(v2[0], v2[1]); w.w = pack2(v2[2], v2[3]);
            if constexpr ((WT_MASK & 64) != 0) st16wt(F.p.ws, F.xb() + (size_t)row * D + (i * 64 + F.lane) * 8, w); else *(u32x4*)(F.xb() + (size_t)row * D + (i * 64 + F.lane) * 8) = w;
        }
        ss = wave_sum(ss);
        if (F.lane < 16) F.ssq()[(size_t)row * 16 + F.lane] = (F.lane == 0) ? ss : 0.f;
    }
}

__device__ __forceinline__ void p1_inproj(const Frame& F, int l) {
    pg8::Gemm g{F.xb(), F.wt_in() + (size_t)l * NPAD * D, T, NPAD, D};
    pg8::StaticOrder So; So.init(T, NPAD, (int)gridDim.x, F.bid);
    pg8::EpiInProj E{F.z(), F.ssq(), ZLD, DIN, F.p.ws};
    pg8::gemm_phase<pg8::EpiInProj, pg8::StaticOrder, true, true>(F.lds + LDS_WORK, g, So, E, F.tid);
}

struct ACmp { const bf16_t* z; int zoff; int m0; __device__ __forceinline__ const bf16_t* operator()(int r, int k0) const {
    int m = m0 + r; if (m > NB * NC * 2 - 1) m = NB * NC * 2 - 1;
    const int h = m & 1, bc = m >> 1, b = bc / NC, c = bc % NC;
    return z + (size_t)(b * S + 16 * c + (k0 >> 6)) * ZLD + zoff + h * 64; } };

__device__ __forceinline__ void p2_compress_item(const Frame& F, int l, int item) {
    constexpr int BM = 64, BN = 256;
    const int kv = item & 1, mt0 = item >> 1;
    LAS unsigned char* smem = F.lds + LDS_WORK;
    LAS bf16_t* hid = (LAS bf16_t*)(smem + 2 * BM * 128 + 2 * BN * 128);
    constexpr int HLD = 264;
    f32x4 acc[4][2];
    ACmp ap{F.z(), kv ? ZVC : ZKC, mt0 * BM};
    gemm_mainloop<BM, BN, 1, 8, 3>(ap, F.w1t() + (size_t)(l * 2 + kv) * CMPH * CMPK, CMPK, CMPK, 0, smem, acc, F.tid);
    const int fr = F.lane & 15, fq = F.lane >> 4;
    const float* b1 = F.bias1() + (l * 2 + kv) * CMPH;
#pragma unroll
    for (int i = 0; i < 4; ++i)
#pragma unroll
        for (int j = 0; j < 2; ++j) {
            const int col = F.wave * 32 + j * 16 + 4 * fq, row = i * 16 + fr;
            const f32x4 bb = *(const f32x4*)(b1 + col);
            u32x2 w; w.x = pack2(siluf_(acc[i][j][0] + bb[0]), siluf_(acc[i][j][1] + bb[1])); w.y = pack2(siluf_(acc[i][j][2] + bb[2]), siluf_(acc[i][j][3] + bb[3]));
            *(LAS u32x2*)(hid + row * HLD + col) = w;
        }
    __syncthreads();
    const bf16_t* w2 = F.w2t() + (size_t)(l * 2 + kv) * 64 * CMPH;
    const int mt = F.wave >> 1;
    f32x4 o[2] = {(f32x4){0.f, 0.f, 0.f, 0.f}, (f32x4){0.f, 0.f, 0.f, 0.f}};
#pragma unroll
    for (int kk = 0; kk < 8; ++kk) {
        const bf16x8 a = *(const LAS bf16x8*)(hid + (mt * 16 + fr) * HLD + kk * 32 + fq * 8);
#pragma unroll
        for (int j = 0; j < 2; ++j) {
            const int n = ((F.wave & 1) * 2 + j) * 16 + fr;
            const bf16x8 b = *(const bf16x8*)(w2 + (size_t)n * CMPH + kk * 32 + fq * 8);
            o[j] = __builtin_amdgcn_mfma_f32_16x16x32_bf16(b, a, o[j], 0, 0, 0);
        }
    }
    const int m = mt0 * BM + mt * 16 + fr;
    if (m < NB * NC * 2) {
        const int h = m & 1, bc = m >> 1, b = bc / NC, c = bc % NC;
        bf16_t* dst = (kv ? F.vcmp() : F.kcmp()) + ((size_t)(b * 2 + h) * NCP + c) * 64;
#pragma unroll
        for (int j = 0; j < 2; ++j) { const int col = ((F.wave & 1) * 2 + j) * 16 + 4 * fq; u32x2 w; w.x = pack2(o[j][0], o[j][1]); w.y = pack2(o[j][2], o[j][3]); *(u32x2*)(dst + col) = w; }
    }
    __syncthreads();
}

__device__ __forceinline__ void p2_lru_item(const Frame& F, int l, int item) {
    const Params& p = F.p;
    const int b = item >> 7, ch = item & 127, t0 = ch * 32;
    const size_t tok0 = (size_t)b * S + t0;
    constexpr int ULD = 520;
    LAS bf16_t* U = (LAS bf16_t*)(F.lds + LDS_WORK);
    LAS bf16_t* UC = U + 35 * ULD + 8;
    constexpr int CLD = 72;
    float kw0[4], kw1[4], kw2[4], kw3[4], kbb[4], kbra[4], kbri[4], kc1[4];
    {
        gcf cw_ = F.in(3) + (size_t)l * 4 * DLRU; gcf cb_ = F.in(4) + (size_t)l * DLRU; gcf ba_ = F.in(6) + (size_t)l * DLRU; gcf bi2_ = F.in(8) + (size_t)l * DLRU; const float* lc_ = F.lruc() + (size_t)l * DLRU;
#pragma unroll
        for (int j = 0; j < 4; ++j) { const int chn = 64 * F.wave + 16 * j + (F.lane & 15);
            kw0[j] = cw_[chn]; kw1[j] = cw_[DLRU + chn]; kw2[j] = cw_[2 * DLRU + chn]; kw3[j] = cw_[3 * DLRU + chn]; kbb[j] = cb_[chn];
            kbra[j] = ba_[chn] * -1.4426950408889634f; kbri[j] = bi2_[chn] * -1.4426950408889634f; kc1[j] = lc_[chn]; }
    }
    for (int idx = F.tid; idx < 35 * 64; idx += NTHR) {
        const int r = idx >> 6, c = idx & 63; const int t = t0 - 3 + r;
        u32x4 v = (u32x4){0u, 0u, 0u, 0u};
        if (t >= 0) v = *(const u32x4*)(F.z() + ((size_t)b * S + t) * ZLD + ZU + c * 8);
        *(LAS u32x4*)(U + r * ULD + c * 8) = v;
    }
    __syncthreads();
    const int h = F.wave, fr = F.lane & 15, fq = F.lane >> 4;
    LAS bf16_t* uc = UC + F.wave * 32 * CLD;
#pragma unroll
    for (int nt = 0; nt < 4; ++nt) {
        const int chn = 64 * h + 16 * nt + fr;
        const float w0 = kw0[nt], w1 = kw1[nt], w2 = kw2[nt], w3 = kw3[nt], bb = kbb[nt];
#pragma unroll
        for (int mt = 0; mt < 2; ++mt) {
            float u[7];
#pragma unroll
            for (int q = 0; q < 7; ++q) u[q] = bf2f(U[(16 * mt + 4 * fq + q) * ULD + chn]);
#pragma unroll
            for (int r = 0; r < 4; ++r) uc[(16 * mt + 4 * fq + r) * CLD + 16 * nt + fr] = f2bf(w0 * u[r] + w1 * u[r + 1] + w2 * u[r + 2] + w3 * u[r + 3] + bb);
        }
    }
    __builtin_amdgcn_s_waitcnt(0xC07F);
    __builtin_amdgcn_wave_barrier();
    const bf16_t* wr_ = F.wat() + ((size_t)(l * 2 + 0) * HLRU + h) * 4096;
    const bf16_t* wi_ = F.wat() + ((size_t)(l * 2 + 1) * HLRU + h) * 4096;
    unsigned* lrs = F.lrus();
    LAS unsigned* ost = (LAS unsigned*)(UC + 8 * 32 * CLD) + F.wave * (32 * 68);
    bf16x8 brn[2], bin[2];
#pragma unroll
    for (int kk = 0; kk < 2; ++kk) { brn[kk] = *(const bf16x8*)(wr_ + fr * 64 + kk * 32 + fq * 8); bin[kk] = *(const bf16x8*)(wi_ + fr * 64 + kk * 32 + fq * 8); }
#pragma unroll
    for (int j = 0; j < 4; ++j) {
        const int chn = 64 * h + 16 * j + fr;
        bf16x8 br[2], bi[2];
#pragma unroll
        for (int kk = 0; kk < 2; ++kk) { br[kk] = brn[kk]; bi[kk] = bin[kk]; }
        { const int jn = j < 3 ? j + 1 : 3;
#pragma unroll
          for (int kk = 0; kk < 2; ++kk) { brn[kk] = *(const bf16x8*)(wr_ + (16 * jn + fr) * 64 + kk * 32 + fq * 8); bin[kk] = *(const bf16x8*)(wi_ + (16 * jn + fr) * 64 + kk * 32 + fq * 8); } }
        const float w0 = kw0[j], w1 = kw1[j], w2 = kw2[j], w3 = kw3[j], bb = kbb[j];
        const float bra = kbra[j], bri = kbri[j], c1 = kc1[j];
        float Arun = 1.f, Hrun = 0.f;
        LAS unsigned* ap_ = ost + (4 * fq) * 68 + 16 * j + fr;
#pragma unroll
        for (int mt = 0; mt < 2; ++mt) {
            f32x4 ar = (f32x4){0.f, 0.f, 0.f, 0.f}, ai = (f32x4){0.f, 0.f, 0.f, 0.f};
#pragma unroll
            for (int kk = 0; kk < 2; ++kk) {
                const bf16x8 af = *(const LAS bf16x8*)(uc + (16 * mt + fr) * CLD + kk * 32 + fq * 8);
                ar = __builtin_amdgcn_mfma_f32_16x16x32_bf16(af, br[kk], ar, 0, 0, 0); ai = __builtin_amdgcn_mfma_f32_16x16x32_bf16(af, bi[kk], ai, 0, 0, 0);
            }
            float u[7];
#pragma unroll
            for (int q = 0; q < 7; ++q) u[q] = bf2f(U[(16 * mt + 4 * fq + q) * ULD + chn]);
            float apf[4], hpf[4];
            float a4 = 1.f, h4 = 0.f;
#pragma unroll
            for (int r = 0; r < 4; ++r) {
                const float ucv = w0 * u[r] + w1 * u[r + 1] + w2 * u[r + 2] + w3 * u[r + 3] + bb;
                const float rg = __builtin_amdgcn_rcpf(1.0f + __builtin_amdgcn_exp2f(__builtin_fmaf(ar[r], -1.4426950408889634f, bra)));
                const float ig = __builtin_amdgcn_rcpf(1.0f + __builtin_amdgcn_exp2f(__builtin_fmaf(ai[r], -1.4426950408889634f, bri)));
                const float e2 = c1 * rg;
                const float av = __builtin_amdgcn_exp2f(e2);
                const float x = e2 * 1.3862943611198906f;
                float pl = __builtin_fmaf(x, 1.0f / 6.0f, 1.0f); pl = __builtin_fmaf(x * (1.0f / 5.0f), pl, 1.0f);
                pl = __builtin_fmaf(x * 0.25f, pl, 1.0f); pl = __builtin_fmaf(x * (1.0f / 3.0f), pl, 1.0f); pl = __builtin_fmaf(x * 0.5f, pl, 1.0f);
                const float dr = sqrtf(-x * pl) * (ig * ucv);
                h4 = av * h4 + dr; a4 *= av;
                apf[r] = a4; hpf[r] = h4;
            }
            float Ea, Eh, Ta, Th;
            { const float pa = __shfl_xor(a4, 16), ph = __shfl_xor(h4, 16);
              const float pairA = a4 * pa, pairH = (fq & 1) ? (a4 * ph + h4) : (pa * h4 + ph);
              const float qa = __shfl_xor(pairA, 32), qh = __shfl_xor(pairH, 32);
              Ta = pairA * qa; Th = (fq & 2) ? (pairA * qh + pairH) : (qa * pairH + qh);
              const float e1a = (fq & 1) ? pa : 1.f, e1h = (fq & 1) ? ph : 0.f;
              const float e2a = (fq & 2) ? qa : 1.f, e2h = (fq & 2) ? qh : 0.f;
              Ea = e2a * e1a; Eh = e1a * e2h + e1h; }
            const float Ca = Arun * Ea, Ch = Ea * Hrun + Eh;
#pragma unroll
            for (int r = 0; r < 4; ++r) ap_[(16 * mt + r) * 68] = cvtpk_(Ca * apf[r], apf[r] * Ch + hpf[r]);
            Hrun = Ta * Hrun + Th; Arun *= Ta;
        }
        if (fq == 0) { float* ag = F.agg() + ((size_t)(b * 128 + ch) * DLRU + chn) * 2; *(float2*)ag = make_float2(Arun, Hrun); }
    }
    __builtin_amdgcn_s_waitcnt(0xC07F);
    __builtin_amdgcn_wave_barrier();
#pragma unroll
    for (int i = 0; i < 8; ++i) {
        const int id = i * 64 + F.lane, tk = id >> 4, c4 = (id & 15) * 4;
        if constexpr ((WT_MASK & 32) != 0) st16wt(F.p.ws, lrs + (tok0 + tk) * DLRU + 64 * h + c4, *(const LAS u32x4*)(ost + tk * 68 + c4)); else *(u32x4*)(lrs + (tok0 + tk) * DLRU + 64 * h + c4) = *(const LAS u32x4*)(ost + tk * 68 + c4);
    }
    __syncthreads();
}

__device__ __forceinline__ void p2_ropek_item(const Frame& F, int item) {
    for (int e = F.tid; e < 256 * 16; e += NTHR) {
        const int fg = e & 3, hh = (e >> 2) & 3, tl = e >> 4;
        const int tok = item * 256 + tl, t = tok & (S - 1);
        const bf16_t* zr = F.z() + (size_t)tok * ZLD + ((hh < 2 ? ZKS : ZKW) + (hh & 1) * 64) + fg * 8;
        const u32x4 a = *(const u32x4*)zr, bq = *(const u32x4*)(zr + 32);
        const float* cp = F.ropec() + t * 32 + fg * 8; const float* sp = F.ropes() + t * 32 + fg * 8;
        const f32x4 c0 = *(const f32x4*)cp, c1 = *(const f32x4*)(cp + 4), s0 = *(const f32x4*)sp, s1 = *(const f32x4*)(sp + 4);
        const float x1[8] = {bflo(a.x), bfhi(a.x), bflo(a.y), bfhi(a.y), bflo(a.z), bfhi(a.z), bflo(a.w), bfhi(a.w)};
        const float x2[8] = {bflo(bq.x), bfhi(bq.x), bflo(bq.y), bfhi(bq.y), bflo(bq.z), bfhi(bq.z), bflo(bq.w), bfhi(bq.w)};
        float o1[8], o2[8];
#pragma unroll
        for (int j = 0; j < 8; ++j) { const float c = j < 4 ? c0[j & 3] : c1[j & 3], s = j < 4 ? s0[j & 3] : s1[j & 3]; o1[j] = x1[j] * c - x2[j] * s; o2[j] = x2[j] * c + x1[j] * s; }
        bf16_t* d = F.kr() + (size_t)tok * 256 + hh * 64 + fg * 8;
        u32x4 w1, w2; w1.x = pack2(o1[0], o1[1]); w1.y = pack2(o1[2], o1[3]); w1.z = pack2(o1[4], o1[5]); w1.w = pack2(o1[6], o1[7]);
        w2.x = pack2(o2[0], o2[1]); w2.y = pack2(o2[2], o2[3]); w2.z = pack2(o2[4], o2[5]); w2.w = pack2(o2[6], o2[7]);
        if constexpr ((WT_MASK & 8) != 0) { st16wt(F.p.ws, d, w1); st16wt(F.p.ws, d + 32, w2); } else { *(u32x4*)d = w1; *(u32x4*)(d + 32) = w2; }
    }
}

__device__ __forceinline__ void dot4(const bf16_t* krow, const LAS float* qs, float& d0, float& d1, float& d2, float& d3) {
    d0 = 0.f; d1 = 0.f; d2 = 0.f; d3 = 0.f;
#pragma unroll
    for (int c = 0; c < 8; ++c) {
        const u32x4 kw = *(const u32x4*)(krow + c * 8);
        const float kf[8] = {bflo(kw.x), bfhi(kw.x), bflo(kw.y), bfhi(kw.y), bflo(kw.z), bfhi(kw.z), bflo(kw.w), bfhi(kw.w)};
#pragma unroll
        for (int e4 = 0; e4 < 2; ++e4) {
            const f32x4 q0 = *(const LAS f32x4*)(qs + c * 8 + e4 * 4), q1 = *(const LAS f32x4*)(qs + 64 + c * 8 + e4 * 4), q2 = *(const LAS f32x4*)(qs + 128 + c * 8 + e4 * 4), q3 = *(const LAS f32x4*)(qs + 192 + c * 8 + e4 * 4);
#pragma unroll
            for (int e = 0; e < 4; ++e) { const float kk = kf[e4 * 4 + e]; d0 += q0[e] * kk; d1 += q1[e] * kk; d2 += q2[e] * kk; d3 += q3[e] * kk; }
        }
    }
}

struct OS { float m[4], l[4], o[4]; };
__device__ __forceinline__ void os_init(OS& s) {
#pragma unroll
    for (int g = 0; g < 4; ++g) { s.m[g] = NEGF; s.l[g] = 0.f; s.o[g] = 0.f; } }
__device__ __forceinline__ void os_segment(OS& s, int st, const LAS float* qs_, LAS float* pb, const bf16_t* kbase, const bf16_t* vbase, int t, int lane) {
    const LAS float* qs = qs_; asm volatile("" : "+v"(qs));
    const int key = st + lane;
    const bool valid = key >= 0 && key <= t;
    float d[4] = {0.f, 0.f, 0.f, 0.f};
    if (valid) dot4(kbase + (size_t)key * 256, qs, d[0], d[1], d[2], d[3]);
    float pv[4];
#pragma unroll
    for (int g = 0; g < 4; ++g) {
        const float sc = valid ? d[g] * SCALE : NEGF;
        const float mn = fmaxf(s.m[g], wave_max(sc));
        const float alpha = __expf(s.m[g] - mn);
        pv[g] = valid ? __expf(sc - mn) : 0.f;
        s.l[g] = s.l[g] * alpha + wave_sum(pv[g]); s.o[g] *= alpha; s.m[g] = mn;
    }
    *(LAS f32x4*)(pb + lane * 4) = (f32x4){pv[0], pv[1], pv[2], pv[3]};
    __builtin_amdgcn_s_waitcnt(0xC07F);
    __builtin_amdgcn_wave_barrier();
    const int k0 = st < 0 ? -st : 0;
    const int k1 = (t - st + 1) < 64 ? (t - st + 1) : 64;
    for (int kx = k0; kx < k1; ++kx) {
        const f32x4 pq = *(const LAS f32x4*)(pb + kx * 4);
        const float vv = bf2f(vbase[(size_t)(st + kx) * ZLD + lane]);
        s.o[0] += pq[0] * vv; s.o[1] += pq[1] * vv; s.o[2] += pq[2] * vv; s.o[3] += pq[3] * vv;
    }
    __builtin_amdgcn_wave_barrier();
}

__device__ __forceinline__ void p3_nsa_task(const Frame& F, int l, int tok, int kvh, LAS float* wl  ) {
    const int lane = F.lane;
    const int b = tok >> 12, t = tok & (S - 1);
    LAS float* qs = wl; LAS float* qr = wl + 256; LAS float* pc = wl + 512; LAS float* pb = wl + 1536;
    const bf16_t* zr = F.z() + (size_t)tok * ZLD;
    if (lane < 32) {
        const bf16_t* qp = zr + ZQ + kvh * 256;
        const float c = F.ropec()[t * 32 + lane], s = F.ropes()[t * 32 + lane];
#pragma unroll
        for (int g = 0; g < 4; ++g) {
            const float x1 = bf2f(qp[g * 64 + lane]), x2 = bf2f(qp[g * 64 + lane + 32]);
            qs[g * 64 + lane] = x1; qs[g * 64 + lane + 32] = x2;
            qr[g * 64 + lane] = x1 * c - x2 * s; qr[g * 64 + lane + 32] = x2 * c + x1 * s;
        }
    }
    __builtin_amdgcn_s_waitcnt(0xC07F);
    __builtin_amdgcn_wave_barrier();
    const int nv = (t >= 31) ? (((t - 31) >> 4) + 1) : 0;
    const bf16_t* kc = F.kcmp() + (size_t)(b * 2 + kvh) * NCP * 64;
    const bf16_t* vc = F.vcmp() + (size_t)(b * 2 + kvh) * NCP * 64;
    float ocmp[4] = {0.f, 0.f, 0.f, 0.f};
#pragma unroll 1
    for (int ps = 0; ps < 4; ++ps) {
        const LAS float* qq = qs; asm volatile("" : "+v"(qq));
        const int c = lane + 64 * ps; const bool valid = c < nv;
        float d0 = 0.f, d1 = 0.f, d2 = 0.f, d3 = 0.f;
        if (valid) dot4(kc + (size_t)c * 64, qq, d0, d1, d2, d3);
        pc[c] = valid ? d0 * SCALE : NEGF; pc[256 + c] = valid ? d1 * SCALE : NEGF; pc[512 + c] = valid ? d2 * SCALE : NEGF; pc[768 + c] = valid ? d3 * SCALE : NEGF;
    }
    __builtin_amdgcn_s_waitcnt(0xC07F);
    __builtin_amdgcn_wave_barrier();
#pragma unroll
    for (int g = 0; g < 4; ++g) {
        float sc[4];
#pragma unroll
        for (int ps = 0; ps < 4; ++ps) sc[ps] = pc[g * 256 + lane + 64 * ps];
        const float mm = wave_max(fmaxf(fmaxf(sc[0], sc[1]), fmaxf(sc[2], sc[3])));
        float e[4], su = 0.f;
#pragma unroll
        for (int ps = 0; ps < 4; ++ps) { e[ps] = (sc[ps] > -1e29f) ? __expf(sc[ps] - mm) : 0.f; su += e[ps]; }
        su = wave_sum(su);
        const float inv = (nv > 0) ? 1.0f / su : 0.f;
#pragma unroll
        for (int ps = 0; ps < 4; ++ps) pc[g * 256 + lane + 64 * ps] = e[ps] * inv;
    }
    __builtin_amdgcn_s_waitcnt(0xC07F);
    __builtin_amdgcn_wave_barrier();
    for (int c = 0; c < nv; ++c) {
        const float vv = bf2f(vc[(size_t)c * 64 + lane]);
        ocmp[0] += pc[c] * vv; ocmp[1] += pc[256 + c] * vv; ocmp[2] += pc[512 + c] * vv; ocmp[3] += pc[768 + c] * vv;
    }
    unsigned long long selmask;
    {
        const int j = lane, cur = t >> 6;
        float pslc = 0.f;
#pragma unroll
        for (int q = -1; q <= 3; ++q) {
            const int c = 4 * j + q;
            if (c >= 0 && c < NC) { const float ps = (pc[c] + pc[256 + c]) + (pc[512 + c] + pc[768 + c]); pslc += (q == -1 || q == 3) ? 0.5f * ps : ps; }
        }
        const bool cand = j <= cur;
        const bool forced = (j == 0) || (j == cur) || (j == cur - 1);
        const float score = cand ? (forced ? pslc + 1e4f : pslc) : NEGF;
        int rank = 0;
        for (int i = 0; i < 64; ++i) { const float si = __shfl(score, i); rank += (si > score || (si == score && i < j)) ? 1 : 0; }
        selmask = __ballot(cand && rank < 16);
    }
    __builtin_amdgcn_wave_barrier();
    OS ss; os_init(ss);
    {
        const bf16_t* kb = F.kr() + (size_t)b * S * 256 + kvh * 64;
        const bf16_t* vb = F.z() + (size_t)b * S * ZLD + ZVS + kvh * 64;
        unsigned long long m = selmask;
        while (m) { const int j = (int)__builtin_ctzll(m); m &= (m - 1); os_segment(ss, j * 64, qr, pb, kb, vb, t, lane); }
    }
    OS sw; os_init(sw);
    {
        const bf16_t* kb = F.kr() + (size_t)b * S * 256 + 128 + kvh * 64;
        const bf16_t* vb = F.z() + (size_t)b * S * ZLD + ZVW + kvh * 64;
#pragma unroll 1
        for (int i = 0; i < 8; ++i) { const int st = t - 511 + 64 * i; if (st + 63 >= 0) os_segment(sw, st, qr, pb, kb, vb, t, lane); }
    }
    bf16_t* yb = F.ybuf();
#pragma unroll
    for (int g = 0; g < 4; ++g) {
        const int head = kvh * 4 + g;
        const float g0 = sigmoidf_(bf2f(zr[ZGATE + head * 3 + 0])), g1 = sigmoidf_(bf2f(zr[ZGATE + head * 3 + 1])), g2 = sigmoidf_(bf2f(zr[ZGATE + head * 3 + 2]));
        const float y = g0 * ocmp[g] + g1 * (ss.o[g] / ss.l[g]) + g2 * (sw.o[g] / sw.l[g]);
        const float gn = bf2f(zr[ZGN + head * 64 + lane]);
        yb[(size_t)tok * D + DLRU + head * 64 + lane] = f2bf(y * siluf_(gn));
    }
    __builtin_amdgcn_wave_barrier();
}

typedef float f32x16 __attribute__((ext_vector_type(16)));
typedef short v4i16_t __attribute__((ext_vector_type(4)));
#define MFMA32(a, b, c) __builtin_amdgcn_mfma_f32_32x32x16_bf16(a, b, c, 0, 0, 0)
constexpr float C2LOG = 0.125f * 1.4426950408889634f;
constexpr int SLP = 65;
constexpr int AT_KV = 0, AT_SLAB = 65536, AT_TOT = AT_SLAB + 8 * 32 * 68 * 4, AT_SEL = AT_TOT + 64 * SLP * 4;
__device__ __forceinline__ int crow(int r, int hi) { return (r & 3) + 8 * (r >> 2) + 4 * hi; }
__device__ __forceinline__ unsigned cvtpk(float lo, float hi) { unsigned r; asm("v_cvt_pk_bf16_f32 %0, %1, %2" : "=v"(r) : "v"(lo), "v"(hi)); return r; }
__device__ __forceinline__ float fexp2(float x) { return __builtin_amdgcn_exp2f(x); }
__device__ __forceinline__ u32x4 ldk(const bf16_t* kbase, int pitch, int row0, int wave, int lane) { return *(const u32x4*)(kbase + (size_t)(row0 + lane) * pitch + wave * 8); }
__device__ __forceinline__ u32x4 ldv(const bf16_t* vbase, int pitch, int row0, int wave, int lane) { return *(const u32x4*)(vbase + (size_t)(row0 + 16 * (wave & 3) + (lane >> 2)) * pitch + (wave >> 2) * 32 + (lane & 3) * 8); }
__device__ __forceinline__ void st_tile(LAS unsigned char* buf, int wave, int lane, u32x4 v) { *(LAS u32x4*)(buf + wave * 1024 + lane * 16) = v; }
__device__ __forceinline__ void kfrags(bf16x8 (&kf)[8], const LAS unsigned char* kbuf, int r32, int hi) {
#pragma unroll
    for (int d0 = 0; d0 < 4; ++d0) { kf[2 * d0] = *(const LAS bf16x8*)(kbuf + (2 * d0 + hi) * 1024 + r32 * 16); kf[2 * d0 + 1] = *(const LAS bf16x8*)(kbuf + (2 * d0 + hi) * 1024 + (32 + r32) * 16); }
}
__device__ __forceinline__ bf16x8 vfrag(const LAS unsigned char* vbuf, int ks, int dh, int lane) {
    const int hi = lane >> 5;
    const LAS unsigned char* p = vbuf + dh * 4096 + (16 * ks + 4 * hi + ((lane & 15) >> 2)) * 64 + ((lane >> 4) & 1) * 32 + (lane & 3) * 8;
    const v4i16_t lo = __builtin_amdgcn_ds_read_tr16_b64_v4i16((LAS v4i16_t*)p);
    const v4i16_t hh = __builtin_amdgcn_ds_read_tr16_b64_v4i16((LAS v4i16_t*)(p + 512));
    return (bf16x8){lo[0], lo[1], lo[2], lo[3], hh[0], hh[1], hh[2], hh[3]};
}
__device__ __forceinline__ void scores(f32x16& p0, f32x16& p1, const bf16x8 (&kf)[8], const bf16x8 (&qf)[4]) {
    p0 = (f32x16){0.f}; p1 = (f32x16){0.f};
#pragma unroll
    for (int d0 = 0; d0 < 4; ++d0) { p0 = MFMA32(kf[2 * d0], qf[d0], p0); p1 = MFMA32(kf[2 * d0 + 1], qf[d0], p1); }
}
__device__ __forceinline__ void band_mask(f32x16& p0, f32x16& p1, int mode, int tl, int hi) {
#pragma unroll
    for (int r = 0; r < 16; ++r) {
        const int k0 = crow(r, hi), k1 = k0 + 32;
        bool keep0, keep1;
        if (mode == 1) { keep0 = k0 <= tl; keep1 = k1 <= tl; } else if (mode == 2) { keep0 = k0 > tl; keep1 = k1 > tl; } else { keep0 = k0 < tl; keep1 = k1 < tl; }
        if (!keep0) p0[r] = -INFINITY; if (!keep1) p1[r] = -INFINITY;
    }
}
__device__ __forceinline__ float rowmax32(const f32x16& p0, const f32x16& p1) {
    float a = fmaxf(p0[0], p1[0]);
#pragma unroll
    for (int r = 1; r < 16; ++r) a = fmaxf(a, fmaxf(p0[r], p1[r]));
    return fmaxf(a, __shfl_xor(a, 32));
}
struct FlashState { f32x16 o0, o1; float m, l; };
__device__ __forceinline__ void fs_init(FlashState& s) { s.o0 = (f32x16){0.f}; s.o1 = (f32x16){0.f}; s.m = -1e30f; s.l = 0.f; }
__device__ __forceinline__ void pv_acc(f32x16& o0, f32x16& o1, const f32x16& p0, const f32x16& p1, const LAS unsigned char* vbuf, int lane) {
    bf16x8 pw[4];
#pragma unroll
    for (int s = 0; s < 2; ++s) {
        u32x4 a, b;
        a.x = cvtpk(p0[8 * s + 0], p0[8 * s + 1]); a.y = cvtpk(p0[8 * s + 2], p0[8 * s + 3]); a.z = cvtpk(p0[8 * s + 4], p0[8 * s + 5]); a.w = cvtpk(p0[8 * s + 6], p0[8 * s + 7]);
        b.x = cvtpk(p1[8 * s + 0], p1[8 * s + 1]); b.y = cvtpk(p1[8 * s + 2], p1[8 * s + 3]); b.z = cvtpk(p1[8 * s + 4], p1[8 * s + 5]); b.w = cvtpk(p1[8 * s + 6], p1[8 * s + 7]);
        pw[s] = __builtin_bit_cast(bf16x8, a); pw[2 + s] = __builtin_bit_cast(bf16x8, b);
    }
#pragma unroll
    for (int ks = 0; ks < 4; ++ks) { o0 = MFMA32(vfrag(vbuf, ks, 0, lane), pw[ks], o0); o1 = MFMA32(vfrag(vbuf, ks, 1, lane), pw[ks], o1); }
}
__device__ __forceinline__ void flash_tile(FlashState& st, const bf16x8 (&qf)[4], const LAS unsigned char* kbuf, const LAS unsigned char* vbuf, int lane, bool row_on, int mode, int tl) {
    const int r32 = lane & 31, hi = lane >> 5;
    bf16x8 kf[8]; kfrags(kf, kbuf, r32, hi);
    f32x16 p0, p1; scores(p0, p1, kf, qf);
    if (mode) band_mask(p0, p1, mode, tl, hi);
    float rm = rowmax32(p0, p1);
    if (!row_on) rm = -INFINITY;
    const float mn = fmaxf(st.m, rm);
    const float alpha = fexp2(st.m - mn);
    const float ms = row_on ? mn : INFINITY;
    float sum = 0.f;
#pragma unroll
    for (int r = 0; r < 16; ++r) { p0[r] = fexp2(p0[r] - ms); p1[r] = fexp2(p1[r] - ms); sum += p0[r] + p1[r]; }
    st.l = st.l * alpha + sum; st.m = mn;
    st.o0 *= alpha; st.o1 *= alpha;
    pv_acc(st.o0, st.o1, p0, p1, vbuf, lane);
}

namespace at64 {
typedef short s16x4 __attribute__((ext_vector_type(4)));
typedef LAS const char* lds_cptr;
constexpr int SLOTB = 8192, LDS_K = 0, LDS_V = 3 * SLOTB, STG = 68;
constexpr float C2 = 0.125f * 1.4426950408889634f;
#define A64_THR 8
#define SBAR() __builtin_amdgcn_sched_barrier(0)
#define PIN(x) asm volatile("" : "+v"(x))
#define WAIT_BAR(N) asm volatile("s_waitcnt vmcnt(" #N ") lgkmcnt(0)\n\ts_barrier" ::: "memory")
__device__ __forceinline__ void glds16(const void* g, unsigned lds_base) {
    unsigned sv; asm volatile("s_mov_b32 %0, m0\n\ts_mov_b32 m0, %2\n\ts_nop 0\n\tglobal_load_lds_dwordx4 %1, off\n\ts_mov_b32 m0, %0" : "=&s"(sv) : "v"(g), "s"(lds_base) : "memory"); }
__device__ __forceinline__ void kload2(bf16x8* kf, lds_cptr kp, int d0) { kf[2 * d0] = *(const LAS bf16x8*)(kp + d0 * 2048); kf[2 * d0 + 1] = *(const LAS bf16x8*)(kp + d0 * 2048 + 512); }
__device__ __forceinline__ s16x4 vtr(lds_cptr p) { return __builtin_bit_cast(s16x4, __builtin_amdgcn_ds_read_tr16_b64_v4i16((LAS v4i16_t*)p)); }
#define MX3(a, b, c) __builtin_fmaxf(__builtin_fmaxf((a), (b)), (c))
__device__ __forceinline__ float rowmax(const f32x16& p0, const f32x16& p1) {
    float a = MX3(p0[0], p0[1], p1[0]), b = MX3(p0[2], p0[3], p1[1]); a = MX3(a, p1[2], p1[3]);
#pragma unroll
    for (int r = 4; r < 16; r += 4) { a = MX3(a, p0[r], p0[r + 1]); b = MX3(b, p0[r + 2], p0[r + 3]); a = MX3(a, p1[r], p1[r + 1]); b = MX3(b, p1[r + 2], p1[r + 3]); }
    float m = __builtin_fmaxf(a, b); auto rr = __builtin_amdgcn_permlane32_swap(__float_as_uint(m), __float_as_uint(m), false, false);
    return __builtin_fmaxf(__uint_as_float(rr[0]), __uint_as_float(rr[1])); }
__device__ __forceinline__ void cmask_c(f32x16& p0, f32x16& p1, int qrel, int hi) {
#pragma unroll
    for (int r = 0; r < 16; ++r) { const int kv = 4 * hi + (r & 3) + 8 * (r >> 2); if (kv > qrel) p0[r] = -INFINITY; if (kv + 32 > qrel) p1[r] = -INFINITY; } }
__device__ __forceinline__ void cmask_f(f32x16& p0, f32x16& p1, int qrel, int hi) {
#pragma unroll
    for (int r = 0; r < 16; ++r) { const int kv = 4 * hi + (r & 3) + 8 * (r >> 2); if (kv <= qrel) p0[r] = -INFINITY; if (kv + 32 <= qrel) p1[r] = -INFINITY; } }

__device__ __forceinline__ void stream(LAS unsigned char* ring, LAS float* wsf  , LAS float* stage  , const bf16x8 (&qr)[4],
                                       const bf16_t* __restrict__ K, int KP, const bf16_t* __restrict__ V, int VP, int NT, bool far0, unsigned long long selw, int qrel, int tid) {
    const int lane = tid & 63, r32 = lane & 31, hi = lane >> 5; const int wid = __builtin_amdgcn_readfirstlane(tid >> 6);
    const unsigned lds0 = (unsigned)(uintptr_t)ring;
    const bf16_t* ksrc = K + (long)lane * KP + wid * 8;
    const bf16_t* vsrc = V + (long)(16 * (wid & 3) + (lane >> 2)) * VP + (wid >> 2) * 32 + (lane & 3) * 8;
    const unsigned kdst = lds0 + LDS_K + wid * 1024, vdst = lds0 + LDS_V + wid * 1024;
#define MFMA(a, b, c) __builtin_amdgcn_mfma_f32_32x32x16_bf16(a, b, c, 0, 0, 0)
#define DMA_K(t, slot) glds16(ksrc + (long)(t) * 64 * KP, (unsigned)__builtin_amdgcn_readfirstlane(kdst + (slot)))
#define DMA_V(t, slot) glds16(vsrc + (long)(t) * 64 * VP, (unsigned)__builtin_amdgcn_readfirstlane(vdst + (slot)))
    const lds_cptr vp0 = (lds_cptr)ring + LDS_V + ((lane >> 4) & 1) * 32 + (lane & 3) * 8 + (4 * hi + ((lane & 15) >> 2)) * 64;
    const lds_cptr kp0 = (lds_cptr)ring + LDS_K + hi * 1024 + r32 * 16;
    DMA_K(0, 0); DMA_V(0, 0); DMA_K(1, SLOTB);
    float mhat = 0.f, l_reg = 0.f; f32x16 o[2]; o[0] = f32x16{}; o[1] = f32x16{};
    const f32x16 zero16 = f32x16{};
    bool resc = false;
    f32x16 pA0, pA1, pB0, pB1; bf16x8 kf[8]; s16x4 vlo[8], vhi[8]; u32x4 pw0, pw1, pw2, pw3;
    int sl_prev = 0, sl_cur = 0, sl_next = SLOTB;
#define ROT() do { sl_prev = sl_cur; sl_cur = sl_next; sl_next = (sl_next == 2 * SLOTB) ? 0 : sl_next + SLOTB; } while (0)
#define EX(v) __builtin_amdgcn_exp2f(__builtin_fmaf((v), C2, nmh))
#define RESC() do { if (resc) { _Pragma("unroll") for (int d_ = 0; d_ < 2; ++d_) _Pragma("unroll") for (int r = 0; r < 16; ++r) o[d_][r] *= wsf[crow(r, hi)]; } } while (0)
    DMA_K(2, 2 * SLOTB);
    WAIT_BAR(3);
    _Pragma("unroll") for (int d0 = 0; d0 < 4; ++d0) kload2(kf, kp0, d0);
    pA0 = MFMA(kf[0], qr[0], zero16); pA1 = MFMA(kf[1], qr[0], zero16); pA0 = MFMA(kf[2], qr[1], pA0); pA1 = MFMA(kf[3], qr[1], pA1);
    pA0 = MFMA(kf[4], qr[2], pA0); pA1 = MFMA(kf[5], qr[2], pA1); pA0 = MFMA(kf[6], qr[3], pA0); pA1 = MFMA(kf[7], qr[3], pA1);
    if (NT == 1) cmask_c(pA0, pA1, qrel, hi);
    if (far0) cmask_f(pA0, pA1, qrel, hi);
    { const float rm = rowmax(pA0, pA1); mhat = __builtin_fmaxf(rm * C2, -1.0e4f); const float nmh = -mhat;
#pragma unroll
      for (int r = 0; r < 16; ++r) { pA0[r] = EX(pA0[r]); pA1[r] = EX(pA1[r]); } }
    WAIT_BAR(0);
    DMA_K(3, 0); DMA_V(1, SLOTB); ROT();
    _Pragma("unroll") for (int d0 = 0; d0 < 4; ++d0) kload2(kf, kp0 + sl_cur, d0);
    WAIT_BAR(2);
#define PKW(P, i) cvtpk(P[i], P[i + 1])
#define PAF(k) __builtin_bit_cast(bf16x8, pw##k)
#define VFR(i) (bf16x8){vlo[i][0], vlo[i][1], vlo[i][2], vlo[i][3], vhi[i][0], vhi[i][1], vhi[i][2], vhi[i][3]}
#define VRD(i) do { vlo[i] = vtr(vp_ + (((i) >> 2) * 4096 + ((i) & 3) * 1024)); vhi[i] = vtr(vp_ + (((i) >> 2) * 4096 + ((i) & 3) * 1024 + 512)); } while (0)
#define KRD(G, d0) do { if (G) { kload2(kf, kp0 + sl_next, d0); SBAR(); } } while (0)
#define GAPA(MF, a0, a1, a2, a3, W0, W1, PW) do { MF; sacc += a0; sacc += a1; sacc += a2; sacc += a3; W0; W1; PIN(PW); PIN(sacc); SBAR(); } while (0)
#define GAPB(MF, X, i) do { MF; X[i] = EX(X[i]); X[i + 1] = EX(X[i + 1]); X[i + 2] = EX(X[i + 2]); X[i + 3] = EX(X[i + 3]); PIN(X); SBAR(); } while (0)
#define STEP(C0, C1, P0, P1, t, MASK, GK, GV, GL) do { SBAR(); \
    const lds_cptr vp_ = vp0 + sl_prev; \
    VRD(0); SBAR(); float sacc = P0[0] + P0[1]; \
                    GAPA(C0 = MFMA(kf[0], qr[0], zero16), P0[2], P0[3], P0[4], P0[5],     pw0[0] = PKW(P0, 0),  pw0[1] = PKW(P0, 2),  pw0); \
    VRD(4); SBAR(); GAPA(C1 = MFMA(kf[1], qr[0], zero16), P0[6], P0[7], P0[8], P0[9],     pw0[2] = PKW(P0, 4),  pw0[3] = PKW(P0, 6),  pw0); \
    VRD(1); SBAR(); GAPA(C0 = MFMA(kf[2], qr[1], C0),    P0[10], P0[11], P0[12], P0[13], pw1[0] = PKW(P0, 8),  pw1[1] = PKW(P0, 10), pw1); \
    VRD(5); SBAR(); GAPA(C1 = MFMA(kf[3], qr[1], C1),    P0[14], P0[15], P1[0], P1[1],   pw1[2] = PKW(P0, 12), pw1[3] = PKW(P0, 14), pw1); \
    VRD(2); SBAR(); GAPA(C0 = MFMA(kf[4], qr[2], C0),    P1[2], P1[3], P1[4], P1[5],     pw2[0] = PKW(P1, 0),  pw2[1] = PKW(P1, 2),  pw2); \
    VRD(6); SBAR(); GAPA(C1 = MFMA(kf[5], qr[2], C1),    P1[6], P1[7], P1[8], P1[9],     pw2[2] = PKW(P1, 4),  pw2[3] = PKW(P1, 6),  pw2); \
    VRD(3); SBAR(); GAPA(C0 = MFMA(kf[6], qr[3], C0),    P1[10], P1[11], P1[12], P1[13], pw3[0] = PKW(P1, 8),  pw3[1] = PKW(P1, 10), pw3); \
    VRD(7); SBAR(); GAPA(C1 = MFMA(kf[7], qr[3], C1),    P1[14], P1[15], 0.f, 0.f,       pw3[2] = PKW(P1, 12), pw3[3] = PKW(P1, 14), pw3); \
    l_reg += sacc; \
    if (GK) DMA_K((t) + 3, sl_cur); if (GV) DMA_V((t) + 1, sl_next); \
    if (MASK) { if ((t) == NT - 1) cmask_c(C0, C1, qrel, hi); } \
    const bool ron_ = ((selw >> (t)) & 1ull) != 0ull; \
    { float rm = __builtin_fmaf(rowmax(C0, C1), C2, -mhat); if (!ron_) rm = -INFINITY; resc = false; \
      if (__builtin_expect(__any(rm > (float)A64_THR), 0)) { const float dl = __builtin_fmaxf(rm, 0.f); mhat += dl; \
          const float f = __builtin_amdgcn_exp2f(-dl); l_reg *= f; if (hi == 0) wsf[r32] = f; resc = true; } } \
    const float nmh = ron_ ? -mhat : -INFINITY; SBAR(); \
    GAPB(o[0] = MFMA(PAF(0), VFR(0), o[0]), C0, 0);              GAPB(o[1] = MFMA(PAF(0), VFR(4), o[1]), C0, 4); \
    KRD(GL, 0); GAPB(o[0] = MFMA(PAF(1), VFR(1), o[0]), C0, 8);  KRD(GL, 1); GAPB(o[1] = MFMA(PAF(1), VFR(5), o[1]), C0, 12); \
    KRD(GL, 2); GAPB(o[0] = MFMA(PAF(2), VFR(2), o[0]), C1, 0);  KRD(GL, 3); GAPB(o[1] = MFMA(PAF(2), VFR(6), o[1]), C1, 4); \
    GAPB(o[0] = MFMA(PAF(3), VFR(3), o[0]), C1, 8);              GAPB(o[1] = MFMA(PAF(3), VFR(7), o[1]), C1, 12); \
    } while (0)
    int t = 1;
    for (; t + 5 < NT; t += 2) {
        STEP(pB0, pB1, pA0, pA1, t, false, true, true, true);     WAIT_BAR(2); RESC(); ROT();
        STEP(pA0, pA1, pB0, pB1, t + 1, false, true, true, true); WAIT_BAR(2); RESC(); ROT();
    }
#define ENDW(tt) do { if ((tt) + 3 < NT) { WAIT_BAR(2); } else if ((tt) + 2 < NT) { WAIT_BAR(1); } else { WAIT_BAR(0); } } while (0)
    for (; t + 1 < NT; t += 2) {
        STEP(pB0, pB1, pA0, pA1, t, true, (t + 3 < NT), (t + 1 < NT), (t + 1 < NT));         ENDW(t);     RESC(); ROT();
        STEP(pA0, pA1, pB0, pB1, t + 1, true, (t + 4 < NT), (t + 2 < NT), (t + 2 < NT));     ENDW(t + 1); RESC(); ROT();
    }
    int sl_last;
    if (t < NT) { STEP(pB0, pB1, pA0, pA1, t, true, false, false, false); RESC(); sl_last = sl_cur; }
    else { pB0 = pA0; pB1 = pA1; sl_last = sl_prev; }
    { float sacc = pB0[0] + pB0[1];
#pragma unroll
      for (int r = 2; r < 16; ++r) sacc += pB0[r];
#pragma unroll
      for (int r = 0; r < 16; ++r) sacc += pB1[r];
      l_reg += sacc;
      pw0 = (u32x4){PKW(pB0, 0), PKW(pB0, 2), PKW(pB0, 4), PKW(pB0, 6)}; pw1 = (u32x4){PKW(pB0, 8), PKW(pB0, 10), PKW(pB0, 12), PKW(pB0, 14)};
      pw2 = (u32x4){PKW(pB1, 0), PKW(pB1, 2), PKW(pB1, 4), PKW(pB1, 6)}; pw3 = (u32x4){PKW(pB1, 8), PKW(pB1, 10), PKW(pB1, 12), PKW(pB1, 14)};
      const lds_cptr vp_ = vp0 + sl_last; _Pragma("unroll") for (int i = 0; i < 8; ++i) VRD(i);
      o[0] = MFMA(PAF(0), VFR(0), o[0]); o[1] = MFMA(PAF(0), VFR(4), o[1]); o[0] = MFMA(PAF(1), VFR(1), o[0]); o[1] = MFMA(PAF(1), VFR(5), o[1]);
      o[0] = MFMA(PAF(2), VFR(2), o[0]); o[1] = MFMA(PAF(2), VFR(6), o[1]); o[0] = MFMA(PAF(3), VFR(3), o[0]); o[1] = MFMA(PAF(3), VFR(7), o[1]); }
    { auto rr = __builtin_amdgcn_permlane32_swap(__float_as_uint(l_reg), __float_as_uint(l_reg), false, false); l_reg = __uint_as_float(rr[0]) + __uint_as_float(rr[1]); }
    if (hi == 0) wsf[32 + r32] *= __builtin_amdgcn_rcpf(l_reg);
    asm volatile("s_waitcnt lgkmcnt(0)" ::: "memory");
#pragma unroll
    for (int r = 0; r < 16; ++r) { const int orow = crow(r, hi); const float sc = wsf[32 + orow];
#pragma unroll
        for (int d0 = 0; d0 < 2; ++d0) stage[orow * STG + d0 * 32 + r32] += o[d0][r] * sc; }
    asm volatile("s_waitcnt vmcnt(0) lgkmcnt(0)\n\ts_barrier" ::: "memory");
#undef MFMA
#undef DMA_K
#undef DMA_V
#undef ROT
#undef EX
#undef RESC
#undef PKW
#undef PAF
#undef VFR
#undef VRD
#undef KRD
#undef ENDW
#undef GAPA
#undef GAPB
#undef STEP
}
#undef SBAR
#undef PIN
#undef WAIT_BAR
#undef MX3
}

__device__ __forceinline__ void p3_nsa_unit(const Frame& F, int l, int b, int kvh, int qb) {
    const int tid = F.tid, lane = F.lane, wave = F.wave, r32 = lane & 31, hi = lane >> 5;
    LAS unsigned char* base = F.lds + LDS_WORK;
    LAS unsigned char* kvr = base + AT_KV;
    LAS float* slab = (LAS float*)(base + AT_SLAB);
    LAS float* tot = (LAS float*)(base + AT_TOT);
    LAS unsigned long long* sel = (LAS unsigned long long*)(base + AT_SEL);
    LAS float* sinv = (LAS float*)(base + AT_SEL + 512);
    LAS float* stash = slab;
    const int g = wave >> 1, tl = 32 * (wave & 1) + r32, head = 4 * kvh + g;
    const int t0 = qb * 64, t = t0 + tl; const size_t tok = (size_t)b * S + t;
    const bf16_t* zr = F.z() + tok * ZLD;
    bf16x8 qc[4], qr[4]; float g0v, g1v, g2v; unsigned long long selw = 0ull; LAS float* stage = nullptr; LAS float* wsf = nullptr;
#pragma unroll 1
    for (int rpu_ = 0; rpu_ < (((REP_PH >> 12) & 1) ? 2 : 1); ++rpu_) {
    if (rpu_) __syncthreads();
    {
        const bf16_t* kc = F.kcmp() + (size_t)(b * 2 + kvh) * NCP * 64;
        const bf16_t* vc = F.vcmp() + (size_t)(b * 2 + kvh) * NCP * 64;
        const int ntc0 = (4 * qb + 3 + 63) >> 6;
#pragma unroll
        for (int tt = 0; tt < 4; ++tt) if (tt < ntc0) { st_tile(kvr + tt * 8192, wave, lane, ldk(kc, 64, tt * 64, wave, lane)); st_tile(kvr + 32768 + tt * 8192, wave, lane, ldv(vc, 64, tt * 64, wave, lane)); }
    }
    {
        float qv[4][8];
#pragma unroll
        for (int d0 = 0; d0 < 4; ++d0) {
            const u32x4 w = *(const u32x4*)(zr + ZQ + head * 64 + d0 * 16 + hi * 8);
            qv[d0][0] = bflo(w.x); qv[d0][1] = bfhi(w.x); qv[d0][2] = bflo(w.y); qv[d0][3] = bfhi(w.y); qv[d0][4] = bflo(w.z); qv[d0][5] = bfhi(w.z); qv[d0][6] = bflo(w.w); qv[d0][7] = bfhi(w.w);
            u32x4 o; o.x = cvtpk(qv[d0][0] * C2LOG, qv[d0][1] * C2LOG); o.y = cvtpk(qv[d0][2] * C2LOG, qv[d0][3] * C2LOG); o.z = cvtpk(qv[d0][4] * C2LOG, qv[d0][5] * C2LOG); o.w = cvtpk(qv[d0][6] * C2LOG, qv[d0][7] * C2LOG);
            qc[d0] = __builtin_bit_cast(bf16x8, o);
        }
#pragma unroll
        for (int d0 = 0; d0 < 2; ++d0) {
            const float* cp = F.ropec() + t * 32 + d0 * 16 + hi * 8; const float* sp = F.ropes() + t * 32 + d0 * 16 + hi * 8;
            const f32x4 c0 = *(const f32x4*)cp, c1 = *(const f32x4*)(cp + 4), s0 = *(const f32x4*)sp, s1 = *(const f32x4*)(sp + 4);
            float a[8], bb[8];
#pragma unroll
            for (int j = 0; j < 8; ++j) { const float c = j < 4 ? c0[j & 3] : c1[j & 3], s = j < 4 ? s0[j & 3] : s1[j & 3]; const float x1 = qv[d0][j], x2 = qv[d0 + 2][j];
                a[j] = x1 * c - x2 * s; bb[j] = x2 * c + x1 * s; }
            u32x4 o1, o2; o1.x = cvtpk(a[0], a[1]); o1.y = cvtpk(a[2], a[3]); o1.z = cvtpk(a[4], a[5]); o1.w = cvtpk(a[6], a[7]);
            o2.x = cvtpk(bb[0], bb[1]); o2.y = cvtpk(bb[2], bb[3]); o2.z = cvtpk(bb[4], bb[5]); o2.w = cvtpk(bb[6], bb[7]);
            qr[d0] = __builtin_bit_cast(bf16x8, o1); qr[d0 + 2] = __builtin_bit_cast(bf16x8, o2);
        }
        g0v = sigmoidf_(bf2f(zr[ZGATE + head * 3 + 0])); g1v = sigmoidf_(bf2f(zr[ZGATE + head * 3 + 1])); g2v = sigmoidf_(bf2f(zr[ZGATE + head * 3 + 2]));
    }
    __syncthreads();
    const int nv = (t >= 31) ? (((t - 31) >> 4) + 1) : 0;
    const int ntc = (4 * qb + 3 + 63) >> 6;
    float mrow = -1e30f;
#pragma unroll 1
    for (int tt = 0; tt < ntc; ++tt) {
        bf16x8 kf[8]; kfrags(kf, kvr + tt * 8192, r32, hi);
        f32x16 p0, p1; scores(p0, p1, kf, qc);
        band_mask(p0, p1, 3, nv - 64 * tt, hi);
        mrow = fmaxf(mrow, rowmax32(p0, p1));
    }
    f32x16 yacc0, yacc1;
    {
        f32x16 oc0 = (f32x16){0.f}, oc1 = (f32x16){0.f};
        float lsum = 0.f, carry = 0.f;
        LAS float* myslab = slab + (g * 64 + tl) * SLP;
#pragma unroll 1
        for (int tt = 0; tt < ntc; ++tt) {
            bf16x8 kf[8]; kfrags(kf, kvr + tt * 8192, r32, hi);
            f32x16 p0, p1; scores(p0, p1, kf, qc);
            band_mask(p0, p1, 3, nv - 64 * tt, hi);
#pragma unroll
            for (int r = 0; r < 16; ++r) { p0[r] = fexp2(p0[r] - mrow); p1[r] = fexp2(p1[r] - mrow); lsum += p0[r] + p1[r]; }
#pragma unroll
            for (int n = 0; n < 2; ++n)
#pragma unroll
                for (int q = 0; q < 4; ++q) {
                    const f32x16& pp = n ? p1 : p0;
                    const float tl_ = 0.5f * pp[4 * q + 3];
                    const float inner = (pp[4 * q] + pp[4 * q + 1]) + (pp[4 * q + 2] + tl_);
                    const float rcv = __shfl_xor(tl_, 32);
                    myslab[16 * tt + 8 * n + 2 * q + hi] = inner + (hi ? rcv : carry);
                    carry = rcv;
                }
            pv_acc(oc0, oc1, p0, p1, kvr + 32768 + tt * 8192, lane);
        }
        lsum += __shfl_xor(lsum, 32);
        const float inv = lsum > 0.f ? 1.0f / lsum : 0.f;
        if (hi == 0) sinv[g * 64 + tl] = inv;
        const float g0 = g0v * inv;
        yacc0 = oc0 * g0; yacc1 = oc1 * g0;
    }
    __syncthreads();
    {
        LAS unsigned* tkey = (LAS unsigned*)tot;
        const int tk = tid >> 3, part = tid & 7, cur = qb;
        unsigned my[8]; int rank[8];
#pragma unroll
        for (int jj = 0; jj < 8; ++jj) { const int j = part * 8 + jj;
            const float v = (j >= 16 * ntc) ? 0.f : (slab[(0 * 64 + tk) * SLP + j] * sinv[tk] + slab[(1 * 64 + tk) * SLP + j] * sinv[64 + tk]) + (slab[(2 * 64 + tk) * SLP + j] * sinv[128 + tk] + slab[(3 * 64 + tk) * SLP + j] * sinv[192 + tk]);
            const bool forced = (j == 0) || (j == cur) || (j == cur - 1);
            my[jj] = (forced ? 0x80000000u : 0u) | ((__float_as_uint(v) >> 6) << 6) | (unsigned)(63 - j); rank[jj] = 0;
            tkey[tk * SLP + j] = my[jj]; }
        __syncthreads();
        if (cur >= 16)
        for (int i = 0; i <= cur; ++i) {
            const unsigned ki = tkey[tk * SLP + i];
#pragma unroll
            for (int jj = 0; jj < 8; ++jj) rank[jj] += (ki > my[jj]) ? 1 : 0;
        }
        unsigned bits = 0;
#pragma unroll
        for (int jj = 0; jj < 8; ++jj) { const int j = part * 8 + jj; if (j <= cur && rank[jj] < 16) bits |= 1u << jj; }
        unsigned lo = (part < 4) ? (bits << (8 * part)) : 0u, hh = (part >= 4) ? (bits << (8 * (part - 4))) : 0u;
#pragma unroll
        for (int o = 1; o < 8; o <<= 1) { lo |= __shfl_xor(lo, o); hh |= __shfl_xor(hh, o); }
        if (part == 0) sel[tk] = ((unsigned long long)hh << 32) | lo;
        __syncthreads();
    }
    selw = sel[tl];
    stage = (LAS float*)(base + AT_SLAB) + wave * (32 * at64::STG);
    wsf = (LAS float*)(base + AT_SEL + 1536) + wave * 64;
#pragma unroll
    for (int dh = 0; dh < 2; ++dh)
#pragma unroll
        for (int q = 0; q < 4; ++q) { const f32x16& ya = dh ? yacc1 : yacc0; *(LAS f32x4*)(stage + r32 * at64::STG + 32 * dh + 8 * q + 4 * hi) = (f32x4){ya[4 * q], ya[4 * q + 1], ya[4 * q + 2], ya[4 * q + 3]}; }
    }
#pragma unroll 1
    for (int rp_ = 0; rp_ < (((REP_PH >> 10) & 1) ? 2 : 1); ++rp_) {
    if (hi == 0) wsf[32 + r32] = rp_ ? 0.f : g1v;
    at64::stream(kvr, wsf, stage, qr, F.kr() + (size_t)b * S * 256 + kvh * 64, 256, F.z() + (size_t)b * S * ZLD + ZVS + kvh * 64, ZLD, qb + 1, false, selw, tl, tid);
    }
    {
        const int tb = qb >= 8 ? qb - 8 : 0;
#pragma unroll 1
        for (int rp_ = 0; rp_ < (((REP_PH >> 11) & 1) ? 2 : 1); ++rp_) {
        if (hi == 0) wsf[32 + r32] = rp_ ? 0.f : g2v;
        at64::stream(kvr, wsf, stage, qr, F.kr() + ((size_t)b * S + tb * 64) * 256 + 128 + kvh * 64, 256, F.z() + ((size_t)b * S + tb * 64) * ZLD + ZVW + kvh * 64, ZLD, qb - tb + 1, qb >= 8, ~0ull, tl, tid);
        }
    }
    {
#pragma unroll
        for (int i = 0; i < 4; ++i) {
            const int row = i * 8 + (lane >> 3), ch = lane & 7;
            const size_t tk2 = (size_t)b * S + t0 + 32 * (wave & 1) + row;
            const f32x4 y0 = *(const LAS f32x4*)(stage + row * at64::STG + ch * 8), y1 = *(const LAS f32x4*)(stage + row * at64::STG + ch * 8 + 4);
            const u32x4 gw = *(const u32x4*)(F.z() + tk2 * ZLD + ZGN + head * 64 + ch * 8);
            u32x4 w;
            w.x = cvtpk(y0[0] * siluf_(bflo(gw.x)), y0[1] * siluf_(bfhi(gw.x))); w.y = cvtpk(y0[2] * siluf_(bflo(gw.y)), y0[3] * siluf_(bfhi(gw.y)));
            w.z = cvtpk(y1[0] * siluf_(bflo(gw.z)), y1[1] * siluf_(bfhi(gw.z))); w.w = cvtpk(y1[2] * siluf_(bflo(gw.w)), y1[3] * siluf_(bfhi(gw.w)));
            bf16_t* yo = F.ybuf() + tk2 * D + DLRU + head * 64 + ch * 8;
#if NSA_PROBE
            { const u32x4 ref = *(const u32x4*)yo;
              const unsigned rw[4] = {ref.x, ref.y, ref.z, ref.w}, nw[4] = {w.x, w.y, w.z, w.w};
              float dd = 0.f, rr = 0.f;
#pragma unroll
              for (int e = 0; e < 4; ++e) { const float r0 = bflo(rw[e]), r1 = bfhi(rw[e]), n0 = bflo(nw[e]), n1 = bfhi(nw[e]); dd += (n0 - r0) * (n0 - r0) + (n1 - r1) * (n1 - r1); rr += r0 * r0 + r1 * r1; }
              dd = wave_sum(dd); rr = wave_sum(rr);
              if (lane == 0) { atomicAdd((float*)(F.p.ws + WS_PROBE), dd); atomicAdd((float*)(F.p.ws + WS_PROBE) + 1, rr); } }
#else
            if constexpr ((WT_MASK & 16) != 0) st16wt(F.p.ws, yo, w); else *(u32x4*)yo = w;
#endif
        }
    }
    __syncthreads();
}

__device__ __forceinline__ void p3_lru_item(const Frame& F, int item) {
    const int b = item >> 6, ch = item & 63;
    LAS float* cs = (LAS float*)(F.lds + LDS_WORK);
    {
        const int chn = F.tid;
        float hh = 0.f;
        const float* agb = F.agg() + ((size_t)(b * 128) * DLRU + chn) * 2;
        for (int c0 = 0; c0 < 2 * ch; c0 += 32) {
            float2 ag[32];
#pragma unroll
            for (int i = 0; i < 32; ++i) ag[i] = (c0 + i < 2 * ch) ? *(const float2*)(agb + (size_t)(c0 + i) * DLRU * 2) : make_float2(1.f, 0.f);
#pragma unroll
            for (int i = 0; i < 32; ++i) hh = ag[i].x * hh + ag[i].y;
        }
        cs[chn] = hh;
        const float2 am = *(const float2*)(agb + (size_t)(2 * ch) * DLRU * 2);
        cs[512 + chn] = am.x * hh + am.y;
    }
    __syncthreads();
    const size_t tok0 = (size_t)b * S + ch * 64;
#pragma unroll 2
    for (int e = F.tid; e < 64 * 64; e += NTHR) {
        const int tl = e >> 6, cg = (e & 63) * 8;
        const u32x4 sw = __builtin_nontemporal_load((const u32x4*)(F.lrus() + (tok0 + tl) * DLRU + cg));
        const u32x4 sx = __builtin_nontemporal_load((const u32x4*)(F.lrus() + (tok0 + tl) * DLRU + cg + 4));
        const u32x4 gw = *(const u32x4*)(F.z() + (tok0 + tl) * ZLD + ZGL + cg);
        const f32x4 c0 = *(const LAS f32x4*)(cs + (tl >> 5) * 512 + cg), c1 = *(const LAS f32x4*)(cs + (tl >> 5) * 512 + cg + 4);
        const float h0 = bflo(sw.x) * c0[0] + bfhi(sw.x), h1 = bflo(sw.y) * c0[1] + bfhi(sw.y), h2 = bflo(sw.z) * c0[2] + bfhi(sw.z), h3 = bflo(sw.w) * c0[3] + bfhi(sw.w);
        const float h4 = bflo(sx.x) * c1[0] + bfhi(sx.x), h5 = bflo(sx.y) * c1[1] + bfhi(sx.y), h6 = bflo(sx.z) * c1[2] + bfhi(sx.z), h7 = bflo(sx.w) * c1[3] + bfhi(sx.w);
        u32x4 ow; ow.x = cvtpk_(h0 * siluf_(bflo(gw.x)), h1 * siluf_(bfhi(gw.x))); ow.y = cvtpk_(h2 * siluf_(bflo(gw.y)), h3 * siluf_(bfhi(gw.y)));
        ow.z = cvtpk_(h4 * siluf_(bflo(gw.z)), h5 * siluf_(bfhi(gw.z))); ow.w = cvtpk_(h6 * siluf_(bflo(gw.w)), h7 * siluf_(bfhi(gw.w)));
        if constexpr ((WT_MASK & 128) != 0) st16wt(F.p.ws, F.ybuf() + (tok0 + tl) * D + cg, ow); else *(u32x4*)(F.ybuf() + (tok0 + tl) * D + cg) = ow;
    }
    __syncthreads();
}

__device__ __forceinline__ void p4_outproj(const Frame& F, int l) {
    pg8::Gemm g{F.ybuf(), F.wt_out() + (size_t)l * D * D, T, D, D};
    pg8::StaticOrder So; So.init(T, D, (int)gridDim.x, F.bid);
    if (l == DEPTH - 1 && gridDim.x == 256) { pg8::EpiOutFinal E{F.xb(), F.p.out, F.in(17), (unsigned*)(F.p.ws + WS_SSQ), (unsigned*)(F.p.ws + WS_PANEL), (unsigned*)(F.p.ws + WS_BAR) + XB_TMO};
        pg8::gemm_phase<pg8::EpiOutFinal, pg8::StaticOrder, true, true>(F.lds + LDS_WORK, g, So, E, F.tid); }
    else if (l == 0) { pg8::EpiOutProj<true> E{F.in(0), F.xb(), F.ssq(), F.p.ws}; pg8::gemm_phase<pg8::EpiOutProj<true>, pg8::StaticOrder, true, true>(F.lds + LDS_WORK, g, So, E, F.tid); }
    else { pg8::EpiOutProj<false> E{nullptr, F.xb(), F.ssq(), F.p.ws}; pg8::gemm_phase<pg8::EpiOutProj<false>, pg8::StaticOrder, true, true>(F.lds + LDS_WORK, g, So, E, F.tid); }
}

__device__ __forceinline__ void p5_final(const Frame& F) {
    for (int row = F.bid * NWAVE + F.wave; row < T; row += gridDim.x * NWAVE) {
        const bf16_t* xr = F.xb() + (size_t)row * D;
        float* orow = F.p.out + (size_t)row * D;
        const f32x4* sp = (const f32x4*)(F.ssq() + (size_t)row * 16);
        const f32x4 s4 = (sp[0] + sp[1]) + (sp[2] + sp[3]);
        float rs = rsqrtf(((s4[0] + s4[1]) + (s4[2] + s4[3])) * (1.0f / D) + EPS);
#if NSA_PROBE
        { const float* pr = (const float*)(F.p.ws + WS_PROBE); rs *= 1.0f + sqrtf(pr[0] / fmaxf(pr[1], 1e-30f)); }
#endif
#pragma unroll
        for (int i = 0; i < 2; ++i) {
            const int c = (i * 64 + F.lane) * 8;
            const u32x4 xw = __builtin_nontemporal_load((const u32x4*)(xr + c));
            const f32x4 g0 = *(GAS const f32x4*)(F.in(17) + c), g1 = *(GAS const f32x4*)(F.in(17) + c + 4);
            const f32x4 o0 = (f32x4){bflo(xw.x), bfhi(xw.x), bflo(xw.y), bfhi(xw.y)} * rs * g0, o1 = (f32x4){bflo(xw.z), bfhi(xw.z), bflo(xw.w), bfhi(xw.w)} * rs * g1;
            if constexpr ((WT_MASK & 256) != 0) { st16wt_out(F.p.out, orow + c, __builtin_bit_cast(u32x4, o0)); st16wt_out(F.p.out, orow + c + 4, __builtin_bit_cast(u32x4, o1)); }
            else { *(f32x4*)(orow + c) = o0; *(f32x4*)(orow + c + 4) = o1; }
        }
    }
}

__global__ void __launch_bounds__(NTHR, 2) mk_fwd(Params p) {
    extern __shared__ __attribute__((aligned(16))) unsigned char lds[];
    Frame F0;
    F0.p = Params{}; F0.p.ws = p.ws; F0.p.out = p.out; F0.lds = (LAS unsigned char*)lds; F0.tid = threadIdx.x; F0.lane = F0.tid & 63; F0.wave = __builtin_amdgcn_readfirstlane(F0.tid >> 6); F0.bid = (int)blockIdx.x;
    unsigned char* ws = p.ws;
    volatile LAS unsigned* ctl = (volatile LAS unsigned*)F0.lds;
    if (F0.tid < 4) ctl[F0.tid] = 0u;
    if (F0.tid == 0) { LAS unsigned long long* it_ = (LAS unsigned long long*)(F0.lds + LDS_INP);
        it_[0] = (unsigned long long)p.x;
        it_[1] = (unsigned long long)p.norm_g;
        it_[2] = (unsigned long long)p.w_in;
        it_[3] = (unsigned long long)p.conv_w;
        it_[4] = (unsigned long long)p.conv_b;
        it_[5] = (unsigned long long)p.lru_wa;
        it_[6] = (unsigned long long)p.lru_ba;
        it_[7] = (unsigned long long)p.lru_wi;
        it_[8] = (unsigned long long)p.lru_bi;
        it_[9] = (unsigned long long)p.lru_lambda;
        it_[10] = (unsigned long long)p.pos_k;
        it_[11] = (unsigned long long)p.pos_v;
        it_[12] = (unsigned long long)p.k_w1;
        it_[13] = (unsigned long long)p.k_w2;
        it_[14] = (unsigned long long)p.v_w1;
        it_[15] = (unsigned long long)p.v_w2;
        it_[16] = (unsigned long long)p.w_out;
        it_[17] = (unsigned long long)p.final_g;
    }
    __syncthreads();
    const int lo = p.ph_lo, hi = p.ph_hi;
    XcdBarrier bar; bar.bar = (unsigned*)(ws + WS_BAR); bar.x = 0; bar.st = ctl;
    if (hi - lo > 1) bar = xcd_barrier_post((unsigned*)(ws + WS_BAR), ctl);

#if (REP_PH >> 13) & 1
    if (hi - lo > 1) for (int xb_ = 0; xb_ < 20; ++xb_) xcd_barrier(bar);
#endif
    for (int ph = lo; ph < hi; ++ph) {
      const int phs_ = (ph == 0) ? 4 : ((ph == NPHASE - 1) ? 5 : ((ph - 1) & 3));
      const int nrep_ = (phs_ < 5 && phs_ != 3 && ((REP_PH >> phs_) & 1)) ? 2 : 1;
      for (int rep_ = 0; rep_ < nrep_; ++rep_) {
        Frame G = F0;
        asm volatile("" : "+s"(G.lds), "+s"(G.bid));
        G.tid = (G.wave << 6) | (int)__builtin_amdgcn_mbcnt_hi(~0u, __builtin_amdgcn_mbcnt_lo(~0u, 0u));
        asm volatile("" : "+v"(G.tid));
        G.lane = G.tid & 63; G.wave = __builtin_amdgcn_readfirstlane(G.tid >> 6);
        const Frame& F = G;
        if (ph == 0) { if (PHSEL & 1) p0_prologue(F); }
        else if (ph == NPHASE - 1) { if ((PHSEL & 2) && gridDim.x != 256) p5_final(F); }
        else {
            const int l = (ph - 1) >> 2, s = (ph - 1) & 3;
            if (s == 0) { if (PHSEL & 4) p1_inproj(F, l); }
            else if (s == 1) {
                if (l + 1 < DEPTH) prep_layer(F, l + 1);
                const bool g256 = (gridDim.x == 256);
                for (int r3 = 0; r3 < (g256 ? 3 : (640 + (int)gridDim.x - 1) / (int)gridDim.x); ++r3) {
                    int kind, idx;
                    if (g256) { if (F.bid < 64) { if (r3) break; kind = 0; idx = F.bid; } else { const int k = (F.bid - 64) + 192 * r3; kind = k < 512 ? 1 : 2; idx = k < 512 ? k : k - 512; } }
                    else { const int k = F.bid + (int)gridDim.x * r3; if (k >= 640) break; kind = k < 64 ? 0 : (k < 576 ? 1 : 2); idx = k < 64 ? k : (k < 576 ? k - 64 : k - 576); }
                    asm volatile("" : "+s"(G.lds));
                    asm volatile("" : "+v"(G.tid));
                    G.lane = G.tid & 63; G.wave = __builtin_amdgcn_readfirstlane(G.tid >> 6);
                    if (kind == 0) { if (PHSEL & 8) p2_compress_item(F, l, idx);
#if (REP_PH >> 5) & 1
                        p2_compress_item(F, l, idx);
#endif
                    }
                    else if (kind == 1) { if (PHSEL & 16) p2_lru_item(F, l, idx);
#if (REP_PH >> 6) & 1
                        p2_lru_item(F, l, idx);
#endif
                    }
                    else { if (PHSEL & 1) p2_ropek_item(F, idx);
#if (REP_PH >> 7) & 1
                        p2_ropek_item(F, idx);
#endif
                    }
                }
            } else if (s == 2) {
                for (int it = F.bid; it < 256; it += gridDim.x) { if (PHSEL & 1) p3_lru_item(F, it);
#if (REP_PH >> 8) & 1
                    p3_lru_item(F, it);
#endif
                }
#if NSA_MODE == 0
                LAS float* wl = (LAS float*)(F.lds + LDS_WORK) + F.wave * 2048;
                for (int it = F.bid; it < 4096; it += gridDim.x) { const int task = it * NWAVE + F.wave; p3_nsa_task(F, l, task >> 1, task & 1, wl); }
#else
                for (int it = F.bid; it < 256; it += gridDim.x) {
                    const int bk = it & 7, qq = it >> 3;
#pragma unroll 1
                    for (int hf = 0; hf < (((REP_PH >> 9) & 1) ? 4 : 2); ++hf) {
                        const int qb = (hf & 1) ? 63 - qq : qq;
#if NSA_MODE == 2
                        { LAS float* wl = (LAS float*)(F.lds + LDS_WORK) + F.wave * 2048;
                          for (int k = 0; k < 8; ++k) { const int task = k * NWAVE + F.wave; p3_nsa_task(F, l, (bk >> 1) * S + qb * 64 + task, bk & 1, wl); }
                          __threadfence_block(); __syncthreads(); }
#endif
                        asm volatile("" : "+v"(G.tid)); G.lane = G.tid & 63; G.wave = __builtin_amdgcn_readfirstlane(G.tid >> 6);
                        if (PHSEL & 32) p3_nsa_unit(F, l, bk >> 1, bk & 1, qb);
                    }
                }
#endif
            } else { if (PHSEL & 64) p4_outproj(F, l); }
        }
        if (rep_ + 1 < nrep_) xcd_barrier(bar);
      }
        if (ph + 1 < hi && !(ph + 2 == NPHASE && gridDim.x == 256)) xcd_barrier(bar);
    }
}

extern "C" void kernel_launch(void* const* d_in, const int* in_sizes, int n_in, void* d_out, int out_size, void* d_ws, size_t ws_size, hipStream_t stream) {
    static int grid = 0;
    if (grid == 0) {
        if (n_in != 18 || out_size != T * D || ws_size < WS_END) { fprintf(stderr, "kernel_launch: unexpected shapes (n_in %d out %d ws %zu need %zu)\n", n_in, out_size, ws_size, (size_t)WS_END); grid = -1; return; }
        int dev = 0, cus = 0;
        if (hipGetDevice(&dev) != hipSuccess || hipDeviceGetAttribute(&cus, hipDeviceAttributeMultiprocessorCount, dev) != hipSuccess) { grid = -1; return; }
        if (hipFuncSetAttribute((const void*)mk_fwd, hipFuncAttributeMaxDynamicSharedMemorySize, LDS_BYTES) != hipSuccess) { fprintf(stderr, "kernel_launch: hipFuncSetAttribute failed\n"); grid = -1; return; }
        grid = cus;
    }
    if (grid < 0) return;
    (void)hipMemsetAsync((char*)d_ws + WS_BAR, 0, 16384, stream);
    Params p{};
    const float** pp = (const float**)&p;
    for (int i = 0; i < 18; ++i) pp[i] = (const float*)d_in[i];
    p.out = (float*)d_out; p.ws = (unsigned char*)d_ws;
#if MK_N_LAUNCHES == 1
    p.ph_lo = 0; p.ph_hi = NPHASE;
    hipLaunchKernelGGL(mk_fwd, dim3(grid), dim3(NTHR), LDS_BYTES, stream, p);
#else
    for (int ph = 0; ph < NPHASE; ++ph) { p.ph_lo = ph; p.ph_hi = ph + 1; hipLaunchKernelGGL(mk_fwd, dim3(grid), dim3(NTHR), LDS_BYTES, stream, p); }
#endif
}
```

```cpp
#include <hip/hip_runtime.h>
#include <stdint.h>
#include <cstdio>

#ifndef NSA_MODE
#define NSA_MODE 1
#endif
#define NSA_PROBE (NSA_MODE == 2)
#ifndef REP_PH
#define REP_PH 0
#endif
#ifndef PHSEL
#define PHSEL 0xFF
#endif
#ifndef MK_N_LAUNCHES
#define MK_N_LAUNCHES 1
#endif

typedef unsigned short bf16_t;
typedef short bf16x8 __attribute__((ext_vector_type(8)));
typedef float f32x4 __attribute__((ext_vector_type(4)));
typedef unsigned u32x4 __attribute__((ext_vector_type(4)));
typedef unsigned u32x2 __attribute__((ext_vector_type(2)));
#define LAS __attribute__((address_space(3)))
#define GAS __attribute__((address_space(1)))
typedef GAS const float* gcf;
template <class Tp> __device__ __forceinline__ Tp* asg(Tp* p) { return (Tp*)(GAS Tp*)p; }

constexpr int NB = 4, S = 4096, T = NB * S, D = 1024, DEPTH = 4;
constexpr int DLRU = 512, HLRU = 8, DIN = 2840, NPAD = 3072, ZLD = 2848;
constexpr int ZU = 0, ZGL = 512, ZQ = 1024, ZGN = 1536, ZKC = 2048, ZVC = 2176, ZKS = 2304, ZVS = 2432, ZKW = 2560, ZVW = 2688, ZGATE = 2816;
constexpr int NC = 255, NCP = 256, CMPH = 256, CMPK = 2048;
constexpr float EPS = 1e-6f, NEGF = -1e30f, SCALE = 0.125f;
constexpr int NTHR = 512, NWAVE = 8;
constexpr int NPHASE = 2 + 4 * DEPTH;
#ifndef PREP_C
#define PREP_C 0
#endif

constexpr size_t al256(size_t x) { return (x + 255) & ~(size_t)255; }
constexpr size_t WS_PROBE = 15360;
constexpr size_t WS_BAR   = 0;
constexpr size_t WS_WTIN  = 16384;
constexpr size_t WS_WTOUT = WS_WTIN  + al256((size_t)DEPTH * NPAD * D * 2);
constexpr size_t WS_W1T   = WS_WTOUT + al256((size_t)DEPTH * D * D * 2);
constexpr size_t WS_W2T   = WS_W1T   + al256((size_t)DEPTH * 2 * CMPH * CMPK * 2);
constexpr size_t WS_WAT   = WS_W2T   + al256((size_t)DEPTH * 2 * 64 * CMPH * 2);
constexpr size_t WS_BIAS1 = WS_WAT   + al256((size_t)DEPTH * 2 * HLRU * 64 * 64 * 2);
constexpr size_t WS_LRUC  = WS_BIAS1 + al256((size_t)DEPTH * 2 * CMPH * 4);
constexpr size_t WS_ROPEC = WS_LRUC  + al256((size_t)DEPTH * DLRU * 4);
constexpr size_t WS_ROPES = WS_ROPEC + al256((size_t)S * 32 * 4);
constexpr size_t WS_XB    = WS_ROPES + al256((size_t)S * 32 * 4);
constexpr size_t WS_SSQ   = WS_XB    + al256((size_t)T * D * 2);
constexpr size_t WS_Z     = WS_SSQ   + al256((size_t)T * 16 * 4);
constexpr size_t WS_KR    = WS_Z     + al256((size_t)T * ZLD * 2);
constexpr size_t WS_KCMP  = WS_KR    + al256((size_t)T * 256 * 2);
constexpr size_t WS_VCMP  = WS_KCMP  + al256((size_t)NB * 2 * NCP * 64 * 2);
constexpr size_t WS_DBUF  = WS_VCMP  + al256((size_t)NB * 2 * NCP * 64 * 2);
constexpr size_t WS_AGG   = WS_DBUF  + al256((size_t)T * DLRU * 4);
constexpr size_t WS_YBUF  = WS_AGG   + al256((size_t)NB * 128 * DLRU * 2 * 4);
constexpr size_t WS_END   = WS_YBUF  + al256((size_t)T * D * 2);
static_assert(WS_END <= (size_t)256 * 1024 * 1024, "workspace map exceeds 256 MiB");
#ifndef WT_MASK
#define WT_MASK 255
#endif
typedef unsigned wt_u32x4 __attribute__((ext_vector_type(4)));
__device__ __forceinline__ void st16wt(const unsigned char* ws, const void* ptr, wt_u32x4 v) {
    const __amdgpu_buffer_rsrc_t r = __builtin_amdgcn_make_buffer_rsrc((void*)ws, (short)0, (int)WS_END, 0x00020000);
    __builtin_amdgcn_raw_buffer_store_b128(v, r, (unsigned)((const unsigned char*)ptr - ws), 0,   16);
}
__device__ __forceinline__ void st16wt_out(const float* out, const void* ptr, wt_u32x4 v) {
    const __amdgpu_buffer_rsrc_t r = __builtin_amdgcn_make_buffer_rsrc((void*)out, (short)0, (int)((size_t)T * D * 4), 0x00020000);
    __builtin_amdgcn_raw_buffer_store_b128(v, r, (unsigned)((const unsigned char*)ptr - (const unsigned char*)out), 0,   16);
}

constexpr int LDS_BYTES = 156 * 1024;
constexpr int LDS_CTL = 0;
constexpr int LDS_INP = 16;
constexpr int LDS_WORK = 256;

struct Params {
    const float *x, *norm_g, *w_in, *conv_w, *conv_b, *lru_wa, *lru_ba, *lru_wi, *lru_bi, *lru_lambda, *pos_k, *pos_v, *k_w1, *k_w2, *v_w1, *v_w2, *w_out, *final_g;
    float* out; unsigned char* ws;
    int ph_lo, ph_hi;
};


__device__ __forceinline__ float bf2f(bf16_t h) { return __uint_as_float(((unsigned)h) << 16); }

__device__ __forceinline__ unsigned cvtpk_(float lo, float hi) { unsigned r; asm("v_cvt_pk_bf16_f32 %0, %1, %2" : "=v"(r) : "v"(lo), "v"(hi)); return r; }
__device__ __forceinline__ bf16_t f2bf(float f) { return (bf16_t)cvtpk_(f, f); }
__device__ __forceinline__ unsigned pack2(float lo, float hi) { return cvtpk_(lo, hi); }
__device__ __forceinline__ float bflo(unsigned w) { return __uint_as_float(w << 16); }
__device__ __forceinline__ float bfhi(unsigned w) { return __uint_as_float(w & 0xffff0000u); }
__device__ __forceinline__ float sigmoidf_(float x) { return __builtin_amdgcn_rcpf(1.0f + __builtin_amdgcn_exp2f(x * -1.4426950408889634f)); }
__device__ __forceinline__ float siluf_(float x) { return x * __builtin_amdgcn_rcpf(1.0f + __builtin_amdgcn_exp2f(x * -1.4426950408889634f)); }
__device__ __forceinline__ float wave_max(float v) {
#pragma unroll
    for (int o = 32; o > 0; o >>= 1) v = fmaxf(v, __shfl_xor(v, o));
    return v; }
__device__ __forceinline__ float wave_sum(float v) {
#pragma unroll
    for (int o = 32; o > 0; o >>= 1) v += __shfl_xor(v, o);
    return v; }

#define XB_TMO      128
#define XB_XCNT(j)  (256  + 64 * (j))
#define XB_XSUB(j)  (1280 + 64 * (j))
#define XB_XGEN(j)  (2304 + 64 * (j))
#define XB_TOP      3328
#define XB_TOPGEN   3392
#define XCD_BAR_WORDS 3456
#define XB_SPIN_CAP (1u << 22)
__device__ __forceinline__ unsigned xb_ld(unsigned* p)              { return __hip_atomic_load(p, __ATOMIC_RELAXED, __HIP_MEMORY_SCOPE_AGENT); }
__device__ __forceinline__ unsigned xb_add(unsigned* p, unsigned v) { return __hip_atomic_fetch_add(p, v, __ATOMIC_RELAXED, __HIP_MEMORY_SCOPE_AGENT); }
__device__ __forceinline__ unsigned xb_xcc_id() { return (unsigned)__builtin_amdgcn_s_getreg((3 << 11) | 20) & 0xFu; }
#define XB_SPIN(cond, bar) do { unsigned _sp = 0; while (cond) { __builtin_amdgcn_s_sleep(1); \
    if ((++_sp & 255u) == 0u) { if (xb_ld(&(bar)[XB_TMO])) break; if (_sp > XB_SPIN_CAP) { atomicAdd(&(bar)[XB_TMO], 1u); break; } } } } while (0)
struct XcdBarrier { unsigned* bar; unsigned x; volatile LAS unsigned* st; };
__device__ __forceinline__ XcdBarrier xcd_barrier_post(unsigned* bar, volatile LAS unsigned* st) {
    XcdBarrier b; b.bar = bar; b.x = xb_xcc_id(); b.st = st;
    if (threadIdx.x == 0) (void)xb_add(&bar[XB_XCNT(b.x)], 1u);
    return b;
}
__device__ __forceinline__ void xcd_barrier_complete(unsigned* bar, unsigned x, unsigned& nloc, unsigned& nx) {
    const unsigned G = gridDim.x * gridDim.y * gridDim.z;
    unsigned sum, cnt, mine, sp = 0u;
    for (;;) {
        sum = 0u; cnt = 0u; mine = 0u;
#pragma unroll
        for (unsigned j = 0; j < 16; ++j) { const unsigned c = xb_ld(&bar[XB_XCNT(j)]); sum += c; cnt += (c > 0u) ? 1u : 0u; mine = (j == x) ? c : mine; }
        if (sum == G) break;
        __builtin_amdgcn_s_sleep(1);
        if ((++sp & 255u) == 0u) { if (xb_ld(&bar[XB_TMO])) break; if (sp > XB_SPIN_CAP) { atomicAdd(&bar[XB_TMO], 1u); break; } }
    }
    nloc = mine > 0u ? mine : 1u; nx = cnt > 0u ? cnt : 1u;
}
__device__ __forceinline__ void xcd_barrier(const XcdBarrier& b) {
    asm volatile("s_waitcnt vmcnt(0)" ::: "memory");
    __syncthreads();
    if (threadIdx.x == 0) {
        unsigned* bar = b.bar;
        __builtin_amdgcn_s_waitcnt(0);
        unsigned nloc = b.st[0], nx = b.st[1];
        if (nloc == 0u) { xcd_barrier_complete(bar, b.x, nloc, nx); b.st[0] = nloc; b.st[1] = nx; }
        const unsigned old = xb_add(&bar[XB_XSUB(b.x)], 1u);
        const unsigned gen = old / nloc;
        if (old + 1u == (gen + 1u) * nloc) {
            __builtin_amdgcn_fence(__ATOMIC_RELEASE, "agent");
            asm volatile("s_waitcnt vmcnt(0)" ::: "memory");
            const unsigned og = xb_add(&bar[XB_TOP], 1u);
            const unsigned tg = og / nx;
            if (og + 1u == (tg + 1u) * nx) xb_add(&bar[XB_TOPGEN], 1u);
            else XB_SPIN(xb_ld(&bar[XB_TOPGEN]) == tg, bar);
            __builtin_amdgcn_fence(__ATOMIC_ACQUIRE, "agent");
            xb_add(&bar[XB_XGEN(b.x)], 1u);
            asm volatile("s_waitcnt vmcnt(0)" ::: "memory");
        } else {
            XB_SPIN(xb_ld(&bar[XB_XGEN(b.x)]) == gen, bar);
            __builtin_amdgcn_fence(__ATOMIC_ACQUIRE, "agent");
            asm volatile("s_waitcnt vmcnt(0)" ::: "memory");
        }
    }
    __syncthreads();
}

struct Frame {
    Params p;
    LAS unsigned char* lds;
    int tid, lane, wave, bid;
    __device__ __forceinline__ gcf in(int i) const { const unsigned long long v = *(const LAS unsigned long long*)(lds + LDS_INP + 8 * i);
        const unsigned lo = __builtin_amdgcn_readfirstlane((unsigned)v), hi = __builtin_amdgcn_readfirstlane((unsigned)(v >> 32)); return (gcf)(((unsigned long long)hi << 32) | lo); }
    __device__ __forceinline__ bf16_t* wt_in()  const { return (bf16_t*)(p.ws + WS_WTIN); }
    __device__ __forceinline__ bf16_t* wt_out() const { return (bf16_t*)(p.ws + WS_WTOUT); }
    __device__ __forceinline__ bf16_t* w1t()    const { return (bf16_t*)(p.ws + WS_W1T); }
    __device__ __forceinline__ bf16_t* w2t()    const { return (bf16_t*)(p.ws + WS_W2T); }
    __device__ __forceinline__ bf16_t* wat()    const { return (bf16_t*)(p.ws + WS_WAT); }
    __device__ __forceinline__ float*  bias1()  const { return (float*)(p.ws + WS_BIAS1); }
    __device__ __forceinline__ float*  lruc()   const { return (float*)(p.ws + WS_LRUC); }
    __device__ __forceinline__ float*  ropec()  const { return (float*)(p.ws + WS_ROPEC); }
    __device__ __forceinline__ float*  ropes()  const { return (float*)(p.ws + WS_ROPES); }
    __device__ __forceinline__ bf16_t* xb()     const { return (bf16_t*)(p.ws + WS_XB); }
    __device__ __forceinline__ unsigned* lrus()  const { return (unsigned*)(p.ws + WS_DBUF); }
    __device__ __forceinline__ float*  abuf()   const { return (float*)(p.ws + WS_XB); }
    __device__ __forceinline__ float*  ssq()    const { return (float*)(p.ws + WS_SSQ); }
    __device__ __forceinline__ bf16_t* z()      const { return (bf16_t*)(p.ws + WS_Z); }
    __device__ __forceinline__ bf16_t* kr()     const { return (bf16_t*)(p.ws + WS_KR); }
    __device__ __forceinline__ bf16_t* kcmp()   const { return (bf16_t*)(p.ws + WS_KCMP); }
    __device__ __forceinline__ bf16_t* vcmp()   const { return (bf16_t*)(p.ws + WS_VCMP); }
    __device__ __forceinline__ float*  dbuf()   const { return (float*)(p.ws + WS_DBUF); }
    __device__ __forceinline__ float*  agg()    const { return (float*)(p.ws + WS_AGG); }
    __device__ __forceinline__ bf16_t* ybuf()   const { return (bf16_t*)(p.ws + WS_YBUF); }
};

template <int BM, int BN, int WM, int WN, int PF, class APtr>
__device__ __forceinline__ void gemm_mainloop(const APtr& aptr, const bf16_t* __restrict__ Bt, int ldb, int K, int n0, LAS unsigned char* smem,
                                              f32x4 (&acc)[BM / WM / 16][BN / WN / 16], int tid) {
    constexpr int MT = BM / WM / 16, NT = BN / WN / 16;
    constexpr int ACH = BM * 8 / NTHR, BCH = BN * 8 / NTHR;
    static_assert(ACH >= 1 && BCH >= 1, "tile too small for 512 threads");
    constexpr int ABYTES = BM * 128, BBYTES = BN * 128;
    const int lane = tid & 63, wave = tid >> 6, wm = wave / WN, wn = wave % WN;
    const int fr = lane & 15, fq = lane >> 4;
#pragma unroll
    for (int i = 0; i < MT; ++i)
#pragma unroll
        for (int j = 0; j < NT; ++j) acc[i][j] = (f32x4){0.f, 0.f, 0.f, 0.f};
    u32x4 ra[PF][ACH], rb[PF][BCH];
    const int nk = K / 64;
#define GM_LOAD(slot, kt_) do { const int k1_ = (kt_) * 64; \
        _Pragma("unroll") for (int i = 0; i < ACH; ++i) { const int idx = tid + NTHR * i, r = idx >> 3, c = idx & 7; ra[slot][i] = *(const u32x4*)(aptr(r, k1_) + c * 8); } \
        _Pragma("unroll") for (int i = 0; i < BCH; ++i) { const int idx = tid + NTHR * i, r = idx >> 3, c = idx & 7; rb[slot][i] = *(const u32x4*)(Bt + (size_t)(n0 + r) * ldb + k1_ + c * 8); } } while (0)
#define GM_WRITE(slot, buf_) do { LAS unsigned char* An = smem + (buf_) * ABYTES; LAS unsigned char* Bn = smem + 2 * ABYTES + (buf_) * BBYTES; \
        _Pragma("unroll") for (int i = 0; i < ACH; ++i) { const int idx = tid + NTHR * i, r = idx >> 3, c = idx & 7; *(LAS u32x4*)(An + r * 128 + ((c ^ (r & 7)) << 4)) = ra[slot][i]; } \
        _Pragma("unroll") for (int i = 0; i < BCH; ++i) { const int idx = tid + NTHR * i, r = idx >> 3, c = idx & 7; *(LAS u32x4*)(Bn + r * 128 + ((c ^ (r & 7)) << 4)) = rb[slot][i]; } } while (0)
#pragma unroll
    for (int s = 0; s < PF; ++s) if (s < nk) GM_LOAD(s, s);
    GM_WRITE(0, 0);
    __syncthreads();
    for (int kt0 = 0; kt0 < nk; kt0 += PF) {
#pragma unroll
        for (int u = 0; u < PF; ++u) {
            const int kt = kt0 + u;
            if (kt < nk) {
                const int cur = kt & 1;
                if (kt + PF < nk) GM_LOAD(u, kt + PF);
                const LAS unsigned char* As = smem + cur * ABYTES;
                const LAS unsigned char* Bs = smem + 2 * ABYTES + cur * BBYTES;
#pragma unroll
                for (int kk = 0; kk < 2; ++kk) {
                    bf16x8 af[MT], bfr[NT];
#pragma unroll
                    for (int i = 0; i < MT; ++i) { const int r = wm * MT * 16 + i * 16 + fr, c = kk * 4 + fq; af[i] = *(const LAS bf16x8*)(As + r * 128 + ((c ^ (r & 7)) << 4)); }
#pragma unroll
                    for (int j = 0; j < NT; ++j) { const int r = wn * NT * 16 + j * 16 + fr, c = kk * 4 + fq; bfr[j] = *(const LAS bf16x8*)(Bs + r * 128 + ((c ^ (r & 7)) << 4)); }
#pragma unroll
                    for (int i = 0; i < MT; ++i)
#pragma unroll
                        for (int j = 0; j < NT; ++j) acc[i][j] = __builtin_amdgcn_mfma_f32_16x16x32_bf16(bfr[j], af[i], acc[i][j], 0, 0, 0);
                }
                if (kt + 1 < nk) GM_WRITE((u + 1) % PF, cur ^ 1);
                __syncthreads();
            }
        }
    }
#undef GM_LOAD
#undef GM_WRITE
}

struct APlain { const bf16_t* A; int lda; int m0; __device__ __forceinline__ const bf16_t* operator()(int r, int k0) const { return A + (size_t)(m0 + r) * lda + k0; } };

namespace pg8 {
#define PG8_LAS __attribute__((address_space(3)))
typedef unsigned short bf16_t;
typedef short bf16x8 __attribute__((ext_vector_type(8)));
typedef float f32x4 __attribute__((ext_vector_type(4)));
typedef unsigned u32x4 __attribute__((ext_vector_type(4)));
constexpr int BM = 256, BK = 64, HALF = 128, HTB = HALF * BK * 2  , STAGE_BYTES = 8 * HTB, NXCD = 8, WGM = 8;

__host__ __device__ __forceinline__ int lds_byte(int r, int c) { const int st = (r >> 4) * 2 + (c >> 5), rr = r & 15, cc = c & 31, ob = rr * 64 + cc * 2; return st * 1024 + (ob ^ (((ob >> 9) & 1) << 5)); }
__host__ __device__ __forceinline__ void stage_rc(int b, int& R, int& C) { const int st = b / 1024, sb = b % 1024, swz = sb ^ (((sb >> 9) & 1) << 5); R = (st >> 1) * 16 + swz / 64; C = (st & 1) * 32 + (swz % 64) / 2; }
__host__ __device__ __forceinline__ int perm32(int rho) { const int n = rho >> 4, i = rho & 15; return 8 * (i >> 2) + 4 * n + (i & 3); }

struct Unit { int pm, pn, ord; };
struct Gemm { const bf16_t* A; const bf16_t* Bt; int M, N, K; };

struct StaticOrder {
    int nM, nN, nwg, G, c;
    __host__ __device__ void init(int M, int N, int G_, int c_) { nM = M / BM; nN = N / BM; nwg = nM * nN; G = G_; c = c_; }
    __host__ __device__ bool next(int i, Unit& u) const {
        const long L = (long)i * G + c; if (L >= nwg) return false;
        int wgid = (int)L; { const int q = nwg / NXCD, r = nwg % NXCD, xcd = wgid % NXCD, off = wgid / NXCD; wgid = (xcd < r ? xcd * (q + 1) : r * (q + 1) + (xcd - r) * q) + off; }
        const int nig = WGM * nN, gid = wgid / nig, fm = gid * WGM, gsz = (nM - fm) < WGM ? (nM - fm) : WGM;
        u.pm = fm + ((wgid % nig) % gsz); u.pn = (wgid % nig) / gsz; u.ord = i; return true;
    }
    __device__ __forceinline__ void a_ready(const Unit&) const {}
    __device__ __forceinline__ void done(const Unit&) const {}
};

__device__ __forceinline__ unsigned cvt_pk_bf16(float lo, float hi) { unsigned r; asm volatile("v_cvt_pk_bf16_f32 %0, %1, %2" : "=v"(r) : "v"(lo), "v"(hi)); return r; }
struct EpiInProj { static constexpr bool HAS_PRE = true;
    static constexpr bool PERM = true, AFTER_DRAIN = false;
    bf16_t* Z; const float* ssq; int ldz, ncol; const unsigned char* ws; PG8_LAS float* rst;
    template <class Sched> __device__ __forceinline__ void pre(const Sched& S, int tid) const {
#pragma unroll
        for (int k = 0; k < 3; ++k) {
            const int task = tid + 512 * k; Unit u;
            if (S.next(task >> 8, u)) {
                const f32x4* sp = (const f32x4*)(ssq + (size_t)(u.pm * BM + (task & 255)) * 16);
                const f32x4 s4 = (sp[0] + sp[1]) + (sp[2] + sp[3]);
                rst[task] = __builtin_amdgcn_rsqf(((s4[0] + s4[1]) + (s4[2] + s4[3])) * (1.0f / 1024.0f) + 1e-6f);
            }
        }
    }
    __device__ __forceinline__ void operator()(const f32x4 (&acc)[2][2][4][2], const Unit& u, int wr, int wc, int fr, int fq) const {
        const int row0 = u.pm * BM + wr * 64 + fr, col0 = u.pn * BM + wc * 32 + 8 * fq;
#pragma unroll
        for (int ai = 0; ai < 2; ++ai)
#pragma unroll
            for (int m = 0; m < 4; ++m) {
                const int row = row0 + ai * HALF + m * 16;
                const float rs = rst[u.ord * 256 + (row - u.pm * BM)];
                bf16_t* rowp = Z + (size_t)row * ldz;
#pragma unroll
                for (int bj = 0; bj < 2; ++bj) {
                    const int col = col0 + bj * HALF;
                    if (col < ncol) { const f32x4 v0 = acc[ai][bj][m][0] * rs, v1 = acc[ai][bj][m][1] * rs;
                        u32x4 w; w.x = cvt_pk_bf16(v0[0], v0[1]); w.y = cvt_pk_bf16(v0[2], v0[3]); w.z = cvt_pk_bf16(v1[0], v1[1]); w.w = cvt_pk_bf16(v1[2], v1[3]);
                        if constexpr ((WT_MASK & 1) != 0) st16wt(ws, rowp + col, w); else *(u32x4*)(rowp + col) = w; }
                }
            }
    }
};
template <bool FIRST> struct EpiOutProj { static constexpr bool HAS_PRE = false;
    static constexpr bool PERM = true, AFTER_DRAIN = false;
    GAS const float* xin; bf16_t* xb; float* ssq; const unsigned char* ws;
    __device__ __forceinline__ void operator()(const f32x4 (&acc)[2][2][4][2], const Unit& u, int wr, int wc, int fr, int fq) const {
        const int row0 = u.pm * BM + wr * 64 + fr, col0 = u.pn * BM + wc * 32 + 8 * fq;
#pragma unroll
        for (int ai = 0; ai < 2; ++ai)
#pragma unroll
            for (int m = 0; m < 4; ++m) {
                const int row = row0 + ai * HALF + m * 16;
                float ss = 0.f;
#pragma unroll
                for (int bj = 0; bj < 2; ++bj) {
                    const size_t o = (size_t)row * 1024 + col0 + bj * HALF;
                    f32x4 v0, v1;
                    if constexpr (FIRST) { v0 = __builtin_nontemporal_load((GAS const f32x4*)(xin + o)) + acc[ai][bj][m][0]; v1 = __builtin_nontemporal_load((GAS const f32x4*)(xin + o + 4)) + acc[ai][bj][m][1]; }
                    else { const u32x4 xw = *(const u32x4*)(xb + o);
                        v0 = (f32x4){__uint_as_float(xw.x << 16), __uint_as_float(xw.x & 0xffff0000u), __uint_as_float(xw.y << 16), __uint_as_float(xw.y & 0xffff0000u)} + acc[ai][bj][m][0];
                        v1 = (f32x4){__uint_as_float(xw.z << 16), __uint_as_float(xw.z & 0xffff0000u), __uint_as_float(xw.w << 16), __uint_as_float(xw.w & 0xffff0000u)} + acc[ai][bj][m][1]; }
                    u32x4 w; w.x = cvt_pk_bf16(v0[0], v0[1]); w.y = cvt_pk_bf16(v0[2], v0[3]); w.z = cvt_pk_bf16(v1[0], v1[1]); w.w = cvt_pk_bf16(v1[2], v1[3]);
                    if constexpr ((WT_MASK & 2) != 0) st16wt(ws, xb + o, w); else *(u32x4*)(xb + o) = w;
                    ss += ((v0[0] * v0[0] + v0[1] * v0[1]) + (v0[2] * v0[2] + v0[3] * v0[3])) + ((v1[0] * v1[0] + v1[1] * v1[1]) + (v1[2] * v1[2] + v1[3] * v1[3]));
                }
                ss += __shfl_xor(ss, 16); ss += __shfl_xor(ss, 32);
                if (fq == 0) ssq[(size_t)row * 16 + u.pn * 4 + wc] = ss;
            }
    }
};


template <class Epi, class Sched, bool ALIGN_EPI = false, bool SP2 = false>
__device__ __forceinline__ void gemm_phase(PG8_LAS unsigned char* lds, const Gemm g, const Sched& S, const Epi& E, const int tid_in) {
    const int tid = tid_in, wid = __builtin_amdgcn_readfirstlane(tid >> 6), lane = tid & 63, wr = wid >> 2, wc = wid & 3, fr = lane & 15, fq = lane >> 4;
    const int K = g.K, nt = K / BK;
    unsigned voffA[2], voffB[2];
#pragma unroll
    for (int i = 0; i < 2; ++i) { int R, C; stage_rc(tid * 16 + i * 8192, R, C); const int Rb = Epi::PERM ? ((R & ~31) + perm32(R & 31)) : R;
        voffA[i] = (unsigned)(R * K + C) * 2u; voffB[i] = (unsigned)(Rb * K + C) * 2u; }
    const size_t kstep = (size_t)(BK * 2);
    const size_t hstep = (size_t)HALF * K * 2;
    const size_t tstep = 2 * hstep;
    const unsigned ldsw = (unsigned)wid * 1024u;
    const int aoff = lds_byte(wr * 64 + fr, fq * 8), boff = lds_byte(wc * 32 + fr, fq * 8);
#define PG8_SA(b, h) (((b) * 2 + (h)) * HTB)
#define PG8_SB(b, h) ((4 + (b) * 2 + (h)) * HTB)
#define PG8_STAGE(bufoff, gbase, voff) do { _Pragma("unroll") for (int _i = 0; _i < 2; ++_i) \
        __builtin_amdgcn_global_load_lds((const unsigned*)((const char*)(gbase) + (voff)[_i]), (PG8_LAS unsigned*)(lds + (bufoff) + ldsw + _i * 8192), 16, 0, 0); } while (0)
#define PG8_LDA(dst, b, h) do { _Pragma("unroll") for (int m = 0; m < 4; ++m) _Pragma("unroll") for (int k = 0; k < 2; ++k) dst[m][k] = *(const PG8_LAS bf16x8*)(lds + PG8_SA(b, h) + aoff + m * 2048 + k * 1024); } while (0)
#define PG8_LDB(dst, b, h) do { _Pragma("unroll") for (int n = 0; n < 2; ++n) _Pragma("unroll") for (int k = 0; k < 2; ++k) dst[n][k] = *(const PG8_LAS bf16x8*)(lds + PG8_SB(b, h) + boff + n * 2048 + k * 1024); } while (0)
#define PG8_MMA(ai, bj, At, Bt) do { __builtin_amdgcn_s_setprio(1); _Pragma("unroll") for (int m = 0; m < 4; ++m) _Pragma("unroll") for (int n = 0; n < 2; ++n) _Pragma("unroll") for (int k = 0; k < 2; ++k) \
        acc[ai][bj][m][n] = __builtin_amdgcn_mfma_f32_16x16x32_bf16(Bt[n][k], At[m][k], acc[ai][bj][m][n], 0, 0, 0); __builtin_amdgcn_s_setprio(0); } while (0)
#define PG8_WAIT_V(n) asm volatile("s_waitcnt vmcnt(" #n ")" ::: "memory")
#define PG8_WAIT_L(n) asm volatile("s_waitcnt lgkmcnt(" #n ")" ::: "memory")
#define PG8_BAR __builtin_amdgcn_s_barrier()
#define PG8_SCHED __builtin_amdgcn_sched_barrier(0)
    Unit cur, nxt; int ui = 0;
    if (!S.next(0, cur)) return;
    f32x4 acc[2][2][4][2];
#pragma unroll
    for (int a = 0; a < 2; ++a)
#pragma unroll
        for (int b = 0; b < 2; ++b)
#pragma unroll
            for (int m = 0; m < 4; ++m)
#pragma unroll
                for (int n = 0; n < 2; ++n) acc[a][b][m][n] = (f32x4){0.f, 0.f, 0.f, 0.f};
    bf16x8 At[4][2], B0[2][2], B1[2][2];
    const char* cA = (const char*)g.A + (size_t)cur.pm * tstep; const char* cB = (const char*)g.Bt + (size_t)cur.pn * tstep;
    S.a_ready(cur);
    if constexpr (SP2) {
        PG8_STAGE(PG8_SB(0, 0), cB, voffB); PG8_STAGE(PG8_SB(0, 1), cB + hstep, voffB); PG8_STAGE(PG8_SA(0, 0), cA, voffA); PG8_STAGE(PG8_SA(0, 1), cA + hstep, voffA);
        if constexpr (Epi::HAS_PRE) E.pre(S, tid);
        if (wr == 1) PG8_BAR;
        PG8_WAIT_V(2); PG8_BAR;
        PG8_STAGE(PG8_SB(1, 0), cB + kstep, voffB); PG8_STAGE(PG8_SA(1, 0), cA + kstep, voffA); PG8_STAGE(PG8_SB(1, 1), cB + hstep + kstep, voffB);
        PG8_WAIT_V(6); PG8_BAR;
    } else {
        PG8_STAGE(PG8_SB(0, 0), cB, voffB); PG8_STAGE(PG8_SA(0, 0), cA, voffA); PG8_STAGE(PG8_SB(0, 1), cB + hstep, voffB); PG8_STAGE(PG8_SA(0, 1), cA + hstep, voffA);
        if constexpr (Epi::HAS_PRE) E.pre(S, tid);
        if (wr == 1) PG8_BAR;
        PG8_WAIT_V(4); PG8_BAR;
        PG8_STAGE(PG8_SB(1, 0), cB + kstep, voffB); PG8_STAGE(PG8_SA(1, 0), cA + kstep, voffA); PG8_STAGE(PG8_SB(1, 1), cB + hstep + kstep, voffB);
        PG8_WAIT_V(6); PG8_BAR;
    }
    for (;;) {
        const bool has_next = S.next(ui + 1, nxt);
        const char* nA = has_next ? (const char*)g.A + (size_t)nxt.pm * tstep : cA; const char* nB = has_next ? (const char*)g.Bt + (size_t)nxt.pn * tstep : cB;
        for (int t = 0; t < nt; t += 2) {
            const bool last = (t == nt - 2);
            const char* a1 = cA + (size_t)(t + 1) * kstep;
            const char* a2 = last ? nA : cA + (size_t)(t + 2) * kstep; const char* b2 = last ? nB : cB + (size_t)(t + 2) * kstep;
            const char* a3 = a2 + kstep; const char* b3 = b2 + kstep;
            if (last && has_next) S.a_ready(nxt);
            if constexpr (SP2) {
            PG8_LDB(B0, 0, 0); PG8_LDB(B1, 0, 1); PG8_SCHED; PG8_LDA(At, 0, 0); PG8_STAGE(PG8_SA(1, 1), a1 + hstep, voffA);
            PG8_WAIT_V(8); PG8_WAIT_L(0); PG8_BAR; PG8_MMA(0, 0, At, B0); PG8_MMA(0, 1, At, B1); PG8_BAR; PG8_SCHED;
            PG8_LDA(At, 0, 1); PG8_STAGE(PG8_SB(0, 0), b2, voffB); PG8_STAGE(PG8_SB(0, 1), b2 + hstep, voffB); PG8_STAGE(PG8_SA(0, 0), a2, voffA);
            PG8_WAIT_V(8); PG8_WAIT_L(0); PG8_BAR; PG8_MMA(1, 0, At, B0); PG8_MMA(1, 1, At, B1); PG8_BAR; PG8_SCHED;
            PG8_LDB(B0, 1, 0); PG8_LDB(B1, 1, 1); PG8_SCHED; PG8_LDA(At, 1, 0); PG8_STAGE(PG8_SA(0, 1), a2 + hstep, voffA);
            PG8_WAIT_V(8); PG8_WAIT_L(0); PG8_BAR; PG8_MMA(0, 0, At, B0); PG8_MMA(0, 1, At, B1); PG8_BAR; PG8_SCHED;
            PG8_LDA(At, 1, 1); PG8_STAGE(PG8_SB(1, 0), b3, voffB); PG8_STAGE(PG8_SB(1, 1), b3 + hstep, voffB); PG8_STAGE(PG8_SA(1, 0), a3, voffA);
            PG8_WAIT_V(8); PG8_WAIT_L(0); PG8_BAR; PG8_MMA(1, 0, At, B0); PG8_MMA(1, 1, At, B1); PG8_BAR; PG8_SCHED;
            } else {
            PG8_LDB(B0, 0, 0); PG8_SCHED; PG8_LDA(At, 0, 0); PG8_STAGE(PG8_SA(1, 1), a1 + hstep, voffA);
            PG8_WAIT_L(8); PG8_BAR; PG8_WAIT_L(0); PG8_MMA(0, 0, At, B0); PG8_BAR; PG8_SCHED;
            PG8_LDB(B1, 0, 1); PG8_STAGE(PG8_SB(0, 0), b2, voffB);
            PG8_BAR; PG8_WAIT_L(0); PG8_MMA(0, 1, At, B1); PG8_BAR;
            PG8_LDA(At, 0, 1); PG8_STAGE(PG8_SA(0, 0), a2, voffA);
            PG8_BAR; PG8_WAIT_L(0); PG8_MMA(1, 0, At, B0); PG8_BAR; PG8_SCHED;
            PG8_STAGE(PG8_SB(0, 1), b2 + hstep, voffB);
            PG8_WAIT_V(6); PG8_BAR; PG8_MMA(1, 1, At, B1); PG8_BAR;
            PG8_LDB(B0, 1, 0); PG8_SCHED; PG8_LDA(At, 1, 0); PG8_STAGE(PG8_SA(0, 1), a2 + hstep, voffA);
            PG8_WAIT_L(8); PG8_BAR; PG8_WAIT_L(0); PG8_MMA(0, 0, At, B0); PG8_BAR; PG8_SCHED;
            PG8_LDB(B1, 1, 1); PG8_STAGE(PG8_SB(1, 0), b3, voffB);
            PG8_BAR; PG8_WAIT_L(0); PG8_MMA(0, 1, At, B1); PG8_BAR;
            PG8_LDA(At, 1, 1); PG8_STAGE(PG8_SA(1, 0), a3, voffA);
            PG8_BAR; PG8_WAIT_L(0); PG8_MMA(1, 0, At, B0); PG8_BAR; PG8_SCHED;
            PG8_STAGE(PG8_SB(1, 1), b3 + hstep, voffB);
            PG8_WAIT_V(6); PG8_BAR; PG8_MMA(1, 1, At, B1); PG8_BAR;
            }
        }
        if constexpr (ALIGN_EPI) { if (wr == 0) PG8_BAR; }
        if constexpr (!Epi::AFTER_DRAIN) { E(acc, cur, wr, wc, fr, fq); S.done(cur); }
        if (!has_next) break;
#pragma unroll
        for (int a = 0; a < 2; ++a)
#pragma unroll
            for (int b = 0; b < 2; ++b)
#pragma unroll
                for (int m = 0; m < 4; ++m)
#pragma unroll
                    for (int n = 0; n < 2; ++n) acc[a][b][m][n] = (f32x4){0.f, 0.f, 0.f, 0.f};
        cur = nxt; cA = nA; cB = nB; ++ui;
        if constexpr (ALIGN_EPI) { if (wr == 1) PG8_BAR; }
    }
    PG8_WAIT_V(0);
    if constexpr (!ALIGN_EPI) { if (wr == 0) PG8_BAR; }
    PG8_BAR;
    if constexpr (Epi::AFTER_DRAIN) { E.fused(acc, cur, wr, wc, fr, fq, lds, wid, lane); S.done(cur); }
#undef PG8_SA
#undef PG8_SB
#undef PG8_STAGE
#undef PG8_LDA
#undef PG8_LDB
#undef PG8_MMA
#undef PG8_WAIT_V
#undef PG8_WAIT_L
#undef PG8_BAR
#undef PG8_SCHED
}
}

__device__ __forceinline__ void tr_tile(const Frame& F, gcf src, int R, int C, int ld_src, bf16_t* __restrict__ dst, int ld_dst, int Cpad, gcf rowscale, int r0, int c0) {
    LAS float* tile = (LAS float*)(F.lds + LDS_WORK);
#pragma unroll
    for (int i = 0; i < 2; ++i) {
        const int idx = F.tid + NTHR * i, rl = idx >> 4, c4 = (idx & 15) * 4;
        const int r = r0 + rl, c = c0 + c4;
        f32x4 v = (f32x4){0.f, 0.f, 0.f, 0.f};
        if (c < C) { v = __builtin_nontemporal_load((GAS const f32x4*)(src + (size_t)r * ld_src + c)); if (rowscale) v = v * rowscale[r]; }
        tile[rl * 65 + c4] = v[0]; tile[rl * 65 + c4 + 1] = v[1]; tile[rl * 65 + c4 + 2] = v[2]; tile[rl * 65 + c4 + 3] = v[3];
    }
    __syncthreads();
    {
        const int cl = F.tid >> 3, rg = (F.tid & 7) * 8;
        const int c = c0 + cl;
        if (c < Cpad) {
            u32x4 w;
            w.x = pack2(tile[(rg + 0) * 65 + cl], tile[(rg + 1) * 65 + cl]); w.y = pack2(tile[(rg + 2) * 65 + cl], tile[(rg + 3) * 65 + cl]);
            w.z = pack2(tile[(rg + 4) * 65 + cl], tile[(rg + 5) * 65 + cl]); w.w = pack2(tile[(rg + 6) * 65 + cl], tile[(rg + 7) * 65 + cl]);
            if constexpr ((WT_MASK & 4) != 0) st16wt(F.p.ws, dst + (size_t)c * ld_dst + r0 + rg, w); else *(u32x4*)(dst + (size_t)c * ld_dst + r0 + rg) = w;
        }
    }
    __syncthreads();
}

struct TrDesc { gcf src; gcf rowscale; bf16_t* dst; int C, ld_src, ld_dst, Cpad, r0, c0; };
__device__ __forceinline__ void tr_load(const Frame& F, const TrDesc& d, f32x4 (&v)[2], float (&rs)[2]) {
#pragma unroll
    for (int i = 0; i < 2; ++i) {
        const int idx = F.tid + NTHR * i, rl = idx >> 4, c4 = (idx & 15) * 4;
        const int r = d.r0 + rl, c = d.c0 + c4;
        v[i] = (f32x4){0.f, 0.f, 0.f, 0.f}; rs[i] = 1.0f;
        if (c < d.C) { v[i] = __builtin_nontemporal_load((GAS const f32x4*)(d.src + (size_t)r * d.ld_src + c)); if (d.rowscale) rs[i] = d.rowscale[r]; }
    }
}
__device__ __forceinline__ void tr_finish(const Frame& F, const TrDesc& d, const f32x4 (&v)[2], const float (&rs)[2], int buf) {
    LAS float* tile = (LAS float*)(F.lds + LDS_WORK) + buf * (64 * 65);
#pragma unroll
    for (int i = 0; i < 2; ++i) {
        const int idx = F.tid + NTHR * i, rl = idx >> 4, c4 = (idx & 15) * 4;
        const f32x4 w = v[i] * rs[i];
        tile[rl * 65 + c4] = w[0]; tile[rl * 65 + c4 + 1] = w[1]; tile[rl * 65 + c4 + 2] = w[2]; tile[rl * 65 + c4 + 3] = w[3];
    }
    __syncthreads();
    {
        const int cl = F.tid >> 3, rg = (F.tid & 7) * 8;
        const int c = d.c0 + cl;
        if (c < d.Cpad) {
            u32x4 w;
            w.x = pack2(tile[(rg + 0) * 65 + cl], tile[(rg + 1) * 65 + cl]); w.y = pack2(tile[(rg + 2) * 65 + cl], tile[(rg + 3) * 65 + cl]);
            w.z = pack2(tile[(rg + 4) * 65 + cl], tile[(rg + 5) * 65 + cl]); w.w = pack2(tile[(rg + 6) * 65 + cl], tile[(rg + 7) * 65 + cl]);
            if constexpr ((WT_MASK & 4) != 0) st16wt(F.p.ws, d.dst + (size_t)c * d.ld_dst + d.r0 + rg, w); else *(u32x4*)(d.dst + (size_t)c * d.ld_dst + d.r0 + rg) = w;
        }
    }
}
__device__ __forceinline__ TrDesc prep_desc(const Frame& F, int l, int it) {
    constexpr int T_IN = 16 * 48, T_OUT = 16 * 16, T_W1 = 32 * 4, T_W2 = 4, T_G = 8;
    int j = it;
    if (j < T_IN) return TrDesc{F.in(2) + (size_t)l * D * DIN, F.in(1) + l * D, F.wt_in() + (size_t)l * NPAD * D, DIN, DIN, D, NPAD, (j % 16) * 64, (j / 16) * 64};
    j -= T_IN;
    if (j < T_OUT) return TrDesc{F.in(16) + (size_t)l * D * D, nullptr, F.wt_out() + (size_t)l * D * D, D, D, D, D, (j % 16) * 64, (j / 16) * 64};
    j -= T_OUT;
    if (j < 2 * T_W1) { const int kv = j / T_W1, jj = j % T_W1; return TrDesc{(kv ? F.in(14) : F.in(12)) + (size_t)l * CMPK * CMPH, nullptr, F.w1t() + (size_t)(l * 2 + kv) * CMPH * CMPK, CMPH, CMPH, CMPK, CMPH, (jj % 32) * 64, (jj / 32) * 64}; }
    j -= 2 * T_W1;
    if (j < 2 * T_W2) { const int kv = j / T_W2, jj = j % T_W2; return TrDesc{(kv ? F.in(15) : F.in(13)) + (size_t)l * CMPH * 64, nullptr, F.w2t() + (size_t)(l * 2 + kv) * 64 * CMPH, 64, 64, CMPH, 64, jj * 64, 0}; }
    j -= 2 * T_W2;
    { const int gsel = j / T_G, h = j % T_G; return TrDesc{(gsel ? F.in(7) : F.in(5)) + ((size_t)l * HLRU + h) * 64 * 64, nullptr, F.wat() + ((size_t)(l * 2 + gsel) * HLRU + h) * 64 * 64, 64, 64, 64, 64, 0, 0}; }
}
template <bool SKEW> __device__ __forceinline__ void prep_layer(const Frame& F, int l) {
    const int G = gridDim.x, bid = F.bid;
    constexpr int T_IN = 16 * 48, T_OUT = 16 * 16, T_W1 = 32 * 4, T_W2 = 4, T_G = 8;
    constexpr int PER_L = T_IN + T_OUT + 2 * T_W1 + 2 * T_W2 + 2 * T_G;
    const bool sk = SKEW && G == 256;
    const int it0 = !sk ? bid : (bid < 64 ? bid : 64 * PREP_C + (bid - 64)), its = !sk ? G : (bid < 64 ? 64 : 192), itn = (sk && bid < 64) ? 64 * PREP_C : PER_L;
    if (it0 < itn) {
        f32x4 pv[2]; float prs[2];
        TrDesc dn = prep_desc(F, l, it0);
        tr_load(F, dn, pv, prs);
#pragma unroll 1
        for (int it = it0; it < itn; it += its) {
            const TrDesc dc = dn;
            f32x4 cv[2]; float crs[2];
#pragma unroll
            for (int i = 0; i < 2; ++i) { cv[i] = pv[i]; crs[i] = prs[i]; }
            if (it + its < itn) { dn = prep_desc(F, l, it + its); tr_load(F, dn, pv, prs); }
            tr_finish(F, dc, cv, crs, ((it - it0) / its) & 1);
        }
        __syncthreads();
    }
    {
        LAS float* red = (LAS float*)(F.lds + LDS_WORK);
        for (int it = sk ? (bid < 64 ? bid : 64) : G - 1 - bid; it < 64; it += G) {
            const int kv = (it >> 5) & 1, jb = it & 31;
            gcf w1 = (kv ? F.in(14) : F.in(12)) + (size_t)l * CMPK * CMPH;
            gcf pos = (kv ? F.in(11) : F.in(10)) + (size_t)l * CMPK;
            const int j = jb * 8 + (F.tid & 7), ks = F.tid >> 3;
            float s = 0.f;
#pragma unroll 1
            for (int k0 = ks * 32; k0 < ks * 32 + 32; k0 += 16) {
                float wv[16], pv[16];
#pragma unroll
                for (int i = 0; i < 16; ++i) { wv[i] = w1[(size_t)(k0 + i) * CMPH + j]; pv[i] = pos[k0 + i]; }
#pragma unroll
                for (int i = 0; i < 16; ++i) s += pv[i] * wv[i];
            }
            red[ks * 8 + (F.tid & 7)] = s;
            __syncthreads();
            if (F.tid < 8) { float t = 0.f;
#pragma unroll
                for (int q = 0; q < 64; ++q) t += red[q * 8 + F.tid];
                F.bias1()[(l * 2 + kv) * CMPH + j] = t; }
            __syncthreads();
        }
    }
    for (int i = bid * NTHR + F.tid; i < DLRU; i += G * NTHR) {
        const float lm = F.in(9)[l * DLRU + i];
        const float sp = (lm > 20.f) ? expf(-lm) : log1pf(expf(-lm));
        F.lruc()[l * DLRU + i] = -8.0f * sp * 1.4426950408889634f;
    }
}

__device__ __forceinline__ void p0_prologue(const Frame& F) {
    const int G = gridDim.x, bid = F.bid;
    prep_layer<false>(F, 0);
    for (int i = bid * NTHR + F.tid; i < S * 32; i += G * NTHR) {
        const int t = i >> 5, f = i & 31;
        const float inv = 1.0f / powf(10000.0f, (float)(2 * f) / 64.0f);
        const float ang = (float)t * inv;
        F.ropec()[i] = cosf(ang); F.ropes()[i] = sinf(ang);
    }
    for (int row = bid * NWAVE + F.wave; row < T; row += G * NWAVE) {
        gcf xr = F.in(0) + (size_t)row * D;
        float ss = 0.f;
#pragma unroll
        for (int i = 0; i < 2; ++i) {
            const f32x4 v = __builtin_nontemporal_load((GAS const f32x4*)(xr + (i * 64 + F.lane) * 8)), v2 = __builtin_nontemporal_load((GAS const f32x4*)(xr + (i * 64 + F.lane) * 8 + 4));
            ss += (v[0] * v[0] + v[1] * v[1] + v[2] * v[2] + v[3] * v[3]) + (v2[0] * v2[0] + v2[1] * v2[1] + v2[2] * v2[2] + v2[3] * v2[3]);
            u32x4 w; w.x = pack2(v[0], v[1]); w.y = pack2(v[2], v[3]); w.z = pack2(v2[0], v2[1]); w.w = pack2(v2[2], v2[3]);
            if constexpr ((WT_MASK & 64) != 0) st16wt(F.p.ws, F.xb() + (size_t)row * D + (i * 64 + F.lane) * 8, w); else *(u32x4*)(F.xb() + (size_t)row * D + (i * 64 + F.lane) * 8) = w;
        }
        ss = wave_sum(ss);
        if (F.lane < 16) F.ssq()[(size_t)row * 16 + F.lane] = (F.lane == 0) ? ss : 0.f;
    }
}

__device__ __forceinline__ void p1_inproj(const Frame& F, int l) {
    pg8::Gemm g{F.xb(), F.wt_in() + (size_t)l * NPAD * D, T, NPAD, D};
    pg8::StaticOrder So; So.init(T, NPAD, (int)gridDim.x, F.bid);
    LAS float* rst = (LAS float*)(F.lds + LDS_WORK + pg8::STAGE_BYTES);
    pg8::EpiInProj E{F.z(), F.ssq(), ZLD, DIN, F.p.ws, rst};
    pg8::gemm_phase<pg8::EpiInProj, pg8::StaticOrder, true, true>(F.lds + LDS_WORK, g, So, E, F.tid);
}

struct ACmp { const bf16_t* z; int zoff; int m0; __device__ __forceinline__ const bf16_t* operator()(int r, int k0) const {
    int m = m0 + r; if (m > NB * NC * 2 - 1) m = NB * NC * 2 - 1;
    const int h = m & 1, bc = m >> 1, b = bc / NC, c = bc % NC;
    return z + (size_t)(b * S + 16 * c + (k0 >> 6)) * ZLD + zoff + h * 64; } };

__device__ __forceinline__ void p2_compress_item(const Frame& F, int l, int item) {
    constexpr int BM = 64, BN = 256;
    const int kv = item & 1, mt0 = item >> 1;
    LAS unsigned char* smem = F.lds + LDS_WORK;
    LAS bf16_t* hid = (LAS bf16_t*)(smem + 2 * BM * 128 + 2 * BN * 128);
    constexpr int HLD = 264;
    f32x4 acc[4][2];
    ACmp ap{F.z(), kv ? ZVC : ZKC, mt0 * BM};
    gemm_mainloop<BM, BN, 1, 8, 6>(ap, F.w1t() + (size_t)(l * 2 + kv) * CMPH * CMPK, CMPK, CMPK, 0, smem, acc, F.tid);
    const int fr = F.lane & 15, fq = F.lane >> 4;
    const float* b1 = F.bias1() + (l * 2 + kv) * CMPH;
#pragma unroll
    for (int i = 0; i < 4; ++i)
#pragma unroll
        for (int j = 0; j < 2; ++j) {
            const int col = F.wave * 32 + j * 16 + 4 * fq, row = i * 16 + fr;
            const f32x4 bb = *(const f32x4*)(b1 + col);
            u32x2 w; w.x = pack2(siluf_(acc[i][j][0] + bb[0]), siluf_(acc[i][j][1] + bb[1])); w.y = pack2(siluf_(acc[i][j][2] + bb[2]), siluf_(acc[i][j][3] + bb[3]));
            *(LAS u32x2*)(hid + row * HLD + col) = w;
        }
    __syncthreads();
    const bf16_t* w2 = F.w2t() + (size_t)(l * 2 + kv) * 64 * CMPH;
    const int mt = F.wave >> 1;
    f32x4 o[2] = {(f32x4){0.f, 0.f, 0.f, 0.f}, (f32x4){0.f, 0.f, 0.f, 0.f}};
#pragma unroll
    for (int kk = 0; kk < 8; ++kk) {
        const bf16x8 a = *(const LAS bf16x8*)(hid + (mt * 16 + fr) * HLD + kk * 32 + fq * 8);
#pragma unroll
        for (int j = 0; j < 2; ++j) {
            const int n = ((F.wave & 1) * 2 + j) * 16 + fr;
            const bf16x8 b = *(const bf16x8*)(w2 + (size_t)n * CMPH + kk * 32 + fq * 8);
            o[j] = __builtin_amdgcn_mfma_f32_16x16x32_bf16(b, a, o[j], 0, 0, 0);
        }
    }
    const int m = mt0 * BM + mt * 16 + fr;
    if (m < NB * NC * 2) {
        const int h = m & 1, bc = m >> 1, b = bc / NC, c = bc % NC;
        bf16_t* dst = (kv ? F.vcmp() : F.kcmp()) + ((size_t)(b * 2 + h) * NCP + c) * 64;
#pragma unroll
        for (int j = 0; j < 2; ++j) { const int col = ((F.wave & 1) * 2 + j) * 16 + 4 * fq; u32x2 w; w.x = pack2(o[j][0], o[j][1]); w.y = pack2(o[j][2], o[j][3]); *(u32x2*)(dst + col) = w; }
    }
    __syncthreads();
}

struct LruPref { u32x4 v[5]; };
__device__ __forceinline__ void lru_prefetch(const Frame& F, LruPref& P, int item) {
    const int b = item >> 7, t0 = (item & 127) * 32;
#pragma unroll
    for (int i = 0; i < 5; ++i) {
        const int idx = F.tid + NTHR * i, r = idx >> 6, c = idx & 63, t = t0 - 3 + r;
        u32x4 v = (u32x4){0u, 0u, 0u, 0u};
        if (idx < 35 * 64 && t >= 0) v = *(const u32x4*)(F.z() + ((size_t)b * S + t) * ZLD + ZU + c * 8);
        P.v[i] = v;
    }
}
struct LruConst { float kw0[4], kw1[4], kw2[4], kw3[4], kbb[4], kbra[4], kbri[4], kc1[4]; };
__device__ __forceinline__ void lru_consts(const Frame& F, int l, LruConst& KC) {
    gcf cw_ = F.in(3) + (size_t)l * 4 * DLRU; gcf cb_ = F.in(4) + (size_t)l * DLRU; gcf ba_ = F.in(6) + (size_t)l * DLRU; gcf bi2_ = F.in(8) + (size_t)l * DLRU; const float* lc_ = F.lruc() + (size_t)l * DLRU;
#pragma unroll
    for (int j = 0; j < 4; ++j) { const int chn = 64 * F.wave + 16 * j + (F.lane & 15);
        KC.kw0[j] = cw_[chn]; KC.kw1[j] = cw_[DLRU + chn]; KC.kw2[j] = cw_[2 * DLRU + chn]; KC.kw3[j] = cw_[3 * DLRU + chn]; KC.kbb[j] = cb_[chn];
        KC.kbra[j] = ba_[chn] * -1.4426950408889634f; KC.kbri[j] = bi2_[chn] * -1.4426950408889634f; KC.kc1[j] = lc_[chn]; }
}
__device__ __forceinline__ void p2_lru_item(const Frame& F, int l, int item, LruPref& P, int next, const LruConst& KC) {
    const Params& p = F.p;
    const int b = item >> 7, ch = item & 127, t0 = ch * 32;
    const size_t tok0 = (size_t)b * S + t0;
    constexpr int ULD = 520;
    LAS bf16_t* U = (LAS bf16_t*)(F.lds + LDS_WORK);
    LAS bf16_t* UC = U + 35 * ULD + 8;
    constexpr int CLD = 72;
    const float (&kw0)[4] = KC.kw0, (&kw1)[4] = KC.kw1, (&kw2)[4] = KC.kw2, (&kw3)[4] = KC.kw3, (&kbb)[4] = KC.kbb, (&kbra)[4] = KC.kbra, (&kbri)[4] = KC.kbri, (&kc1)[4] = KC.kc1;
#pragma unroll
    for (int i = 0; i < 5; ++i) { const int idx = F.tid + NTHR * i, r = idx >> 6, c = idx & 63; if (idx < 35 * 64) *(LAS u32x4*)(U + r * ULD + c * 8) = P.v[i]; }
    lru_prefetch(F, P, next);
    __syncthreads();
    const int h = F.wave, fr = F.lane & 15, fq = F.lane >> 4;
    LAS bf16_t* uc = UC + F.wave * 32 * CLD;
    float cvk[4][2][4];
#pragma unroll
    for (int nt = 0; nt < 4; ++nt) {
        const int chn = 64 * h + 16 * nt + fr;
        const float w0 = kw0[nt], w1 = kw1[nt], w2 = kw2[nt], w3 = kw3[nt], bb = kbb[nt];
#pragma unroll
        for (int mt = 0; mt < 2; ++mt) {
            float u[7];
#pragma unroll
            for (int q = 0; q < 7; ++q) u[q] = bf2f(U[(16 * mt + 4 * fq + q) * ULD + chn]);
#pragma unroll
            for (int r = 0; r < 4; ++r) { const float cv = w0 * u[r] + w1 * u[r + 1] + w2 * u[r + 2] + w3 * u[r + 3] + bb; cvk[nt][mt][r] = cv; uc[(16 * mt + 4 * fq + r) * CLD + 16 * nt + fr] = f2bf(cv); }
        }
    }
    __builtin_amdgcn_s_waitcnt(0xC07F);
    __builtin_amdgcn_wave_barrier();
    const bf16_t* wr_ = F.wat() + ((size_t)(l * 2 + 0) * HLRU + h) * 4096;
    const bf16_t* wi_ = F.wat() + ((size_t)(l * 2 + 1) * HLRU + h) * 4096;
    unsigned* lrs = F.lrus();
    LAS unsigned* ost = (LAS unsigned*)(UC + 8 * 32 * CLD) + F.wave * (32 * 68);
    bf16x8 brn[2], bin[2];
#pragma unroll
    for (int kk = 0; kk < 2; ++kk) { brn[kk] = *(const bf16x8*)(wr_ + fr * 64 + kk * 32 + fq * 8); bin[kk] = *(const bf16x8*)(wi_ + fr * 64 + kk * 32 + fq * 8); }
#pragma unroll
    for (int j = 0; j < 4; ++j) {
        const int chn = 64 * h + 16 * j + fr;
        bf16x8 br[2], bi[2];
#pragma unroll
        for (int kk = 0; kk < 2; ++kk) { br[kk] = brn[kk]; bi[kk] = bin[kk]; }
        { const int jn = j < 3 ? j + 1 : 3;
#pragma unroll
          for (int kk = 0; kk < 2; ++kk) { brn[kk] = *(const bf16x8*)(wr_ + (16 * jn + fr) * 64 + kk * 32 + fq * 8); bin[kk] = *(const bf16x8*)(wi_ + (16 * jn + fr) * 64 + kk * 32 + fq * 8); } }
        const float w0 = kw0[j], w1 = kw1[j], w2 = kw2[j], w3 = kw3[j], bb = kbb[j];
        const float bra = kbra[j], bri = kbri[j], c1 = kc1[j];
        float Arun = 1.f, Hrun = 0.f;
        LAS unsigned* ap_ = ost + (4 * fq) * 68 + 16 * j + fr;
#pragma unroll
        for (int mt = 0; mt < 2; ++mt) {
            f32x4 ar = (f32x4){0.f, 0.f, 0.f, 0.f}, ai = (f32x4){0.f, 0.f, 0.f, 0.f};
#pragma unroll
            for (int kk = 0; kk < 2; ++kk) {
                const bf16x8 af = *(const LAS bf16x8*)(uc + (16 * mt + fr) * CLD + kk * 32 + fq * 8);
                ar = __builtin_amdgcn_mfma_f32_16x16x32_bf16(af, br[kk], ar, 0, 0, 0); ai = __builtin_amdgcn_mfma_f32_16x16x32_bf16(af, bi[kk], ai, 0, 0, 0);
            }
            float apf[4], hpf[4];
            float a4 = 1.f, h4 = 0.f;
#pragma unroll
            for (int r = 0; r < 4; ++r) {
                const float ucv = cvk[j][mt][r];
                const float rg = __builtin_amdgcn_rcpf(1.0f + __builtin_amdgcn_exp2f(__builtin_fmaf(ar[r], -1.4426950408889634f, bra)));
                const float ig = __builtin_amdgcn_rcpf(1.0f + __builtin_amdgcn_exp2f(__builtin_fmaf(ai[r], -1.4426950408889634f, bri)));
                const float e2 = c1 * rg;
                const float av = __builtin_amdgcn_exp2f(e2);
                const float y1 = fmaxf(__builtin_fmaf(-av, av, 1.0f), 1e-20f);
                const float dr = (y1 * __builtin_amdgcn_rsqf(y1)) * (ig * ucv);
                h4 = av * h4 + dr; a4 *= av;
                apf[r] = a4; hpf[r] = h4;
            }
            float Ea, Eh, Ta, Th;
            { const float pa = __shfl_xor(a4, 16), ph = __shfl_xor(h4, 16);
              const float pairA = a4 * pa, pairH = (fq & 1) ? (a4 * ph + h4) : (pa * h4 + ph);
              const float qa = __shfl_xor(pairA, 32), qh = __shfl_xor(pairH, 32);
              Ta = pairA * qa; Th = (fq & 2) ? (pairA * qh + pairH) : (qa * pairH + qh);
              const float e1a = (fq & 1) ? pa : 1.f, e1h = (fq & 1) ? ph : 0.f;
              const float e2a = (fq & 2) ? qa : 1.f, e2h = (fq & 2) ? qh : 0.f;
              Ea = e2a * e1a; Eh = e1a * e2h + e1h; }
            const float Ca = Arun * Ea, Ch = Ea * Hrun + Eh;
#pragma unroll
            for (int r = 0; r < 4; ++r) ap_[(16 * mt + r) * 68] = cvtpk_(Ca * apf[r], apf[r] * Ch + hpf[r]);
            Hrun = Ta * Hrun + Th; Arun *= Ta;
        }
        if (fq == 0) { float* ag = F.agg() + ((size_t)(b * 128 + ch) * DLRU + chn) * 2; *(float2*)ag = make_float2(Arun, Hrun); }
    }
    __builtin_amdgcn_s_waitcnt(0xC07F);
    __builtin_amdgcn_wave_barrier();
#pragma unroll
    for (int i = 0; i < 8; ++i) {
        const int id = i * 64 + F.lane, tk = id >> 4, c4 = (id & 15) * 4;
        if constexpr ((WT_MASK & 32) != 0) st16wt(F.p.ws, lrs + (tok0 + tk) * DLRU + 64 * h + c4, *(const LAS u32x4*)(ost + tk * 68 + c4)); else *(u32x4*)(lrs + (tok0 + tk) * DLRU + 64 * h + c4) = *(const LAS u32x4*)(ost + tk * 68 + c4);
    }
    __syncthreads();
}

__device__ __forceinline__ void p2_ropek_item(const Frame& F, int item) {
    for (int e = F.tid; e < 256 * 16; e += NTHR) {
        const int fg = e & 3, hh = (e >> 2) & 3, tl = e >> 4;
        const int tok = item * 256 + tl, t = tok & (S - 1);
        const bf16_t* zr = F.z() + (size_t)tok * ZLD + ((hh < 2 ? ZKS : ZKW) + (hh & 1) * 64) + fg * 8;
        const u32x4 a = *(const u32x4*)zr, bq = *(const u32x4*)(zr + 32);
        const float* cp = F.ropec() + t * 32 + fg * 8; const float* sp = F.ropes() + t * 32 + fg * 8;
        const f32x4 c0 = *(const f32x4*)cp, c1 = *(const f32x4*)(cp + 4), s0 = *(const f32x4*)sp, s1 = *(const f32x4*)(sp + 4);
        const float x1[8] = {bflo(a.x), bfhi(a.x), bflo(a.y), bfhi(a.y), bflo(a.z), bfhi(a.z), bflo(a.w), bfhi(a.w)};
        const float x2[8] = {bflo(bq.x), bfhi(bq.x), bflo(bq.y), bfhi(bq.y), bflo(bq.z), bfhi(bq.z), bflo(bq.w), bfhi(bq.w)};
        float o1[8], o2[8];
#pragma unroll
        for (int j = 0; j < 8; ++j) { const float c = j < 4 ? c0[j & 3] : c1[j & 3], s = j < 4 ? s0[j & 3] : s1[j & 3]; o1[j] = x1[j] * c - x2[j] * s; o2[j] = x2[j] * c + x1[j] * s; }
        bf16_t* d = F.kr() + (size_t)tok * 256 + hh * 64 + fg * 8;
        u32x4 w1, w2; w1.x = pack2(o1[0], o1[1]); w1.y = pack2(o1[2], o1[3]); w1.z = pack2(o1[4], o1[5]); w1.w = pack2(o1[6], o1[7]);
        w2.x = pack2(o2[0], o2[1]); w2.y = pack2(o2[2], o2[3]); w2.z = pack2(o2[4], o2[5]); w2.w = pack2(o2[6], o2[7]);
        if constexpr ((WT_MASK & 8) != 0) { st16wt(F.p.ws, d, w1); st16wt(F.p.ws, d + 32, w2); } else { *(u32x4*)d = w1; *(u32x4*)(d + 32) = w2; }
    }
}

__device__ __forceinline__ void dot4(const bf16_t* krow, const LAS float* qs, float& d0, float& d1, float& d2, float& d3) {
    d0 = 0.f; d1 = 0.f; d2 = 0.f; d3 = 0.f;
#pragma unroll
    for (int c = 0; c < 8; ++c) {
        const u32x4 kw = *(const u32x4*)(krow + c * 8);
        const float kf[8] = {bflo(kw.x), bfhi(kw.x), bflo(kw.y), bfhi(kw.y), bflo(kw.z), bfhi(kw.z), bflo(kw.w), bfhi(kw.w)};
#pragma unroll
        for (int e4 = 0; e4 < 2; ++e4) {
            const f32x4 q0 = *(const LAS f32x4*)(qs + c * 8 + e4 * 4), q1 = *(const LAS f32x4*)(qs + 64 + c * 8 + e4 * 4), q2 = *(const LAS f32x4*)(qs + 128 + c * 8 + e4 * 4), q3 = *(const LAS f32x4*)(qs + 192 + c * 8 + e4 * 4);
#pragma unroll
            for (int e = 0; e < 4; ++e) { const float kk = kf[e4 * 4 + e]; d0 += q0[e] * kk; d1 += q1[e] * kk; d2 += q2[e] * kk; d3 += q3[e] * kk; }
        }
    }
}

struct OS { float m[4], l[4], o[4]; };
__device__ __forceinline__ void os_init(OS& s) {
#pragma unroll
    for (int g = 0; g < 4; ++g) { s.m[g] = NEGF; s.l[g] = 0.f; s.o[g] = 0.f; } }
__device__ __forceinline__ void os_segment(OS& s, int st, const LAS float* qs_, LAS float* pb, const bf16_t* kbase, const bf16_t* vbase, int t, int lane) {
    const LAS float* qs = qs_; asm volatile("" : "+v"(qs));
    const int key = st + lane;
    const bool valid = key >= 0 && key <= t;
    float d[4] = {0.f, 0.f, 0.f, 0.f};
    if (valid) dot4(kbase + (size_t)key * 256, qs, d[0], d[1], d[2], d[3]);
    float pv[4];
#pragma unroll
    for (int g = 0; g < 4; ++g) {
        const float sc = valid ? d[g] * SCALE : NEGF;
        const float mn = fmaxf(s.m[g], wave_max(sc));
        const float alpha = __expf(s.m[g] - mn);
        pv[g] = valid ? __expf(sc - mn) : 0.f;
        s.l[g] = s.l[g] * alpha + wave_sum(pv[g]); s.o[g] *= alpha; s.m[g] = mn;
    }
    *(LAS f32x4*)(pb + lane * 4) = (f32x4){pv[0], pv[1], pv[2], pv[3]};
    __builtin_amdgcn_s_waitcnt(0xC07F);
    __builtin_amdgcn_wave_barrier();
    const int k0 = st < 0 ? -st : 0;
    const int k1 = (t - st + 1) < 64 ? (t - st + 1) : 64;
    for (int kx = k0; kx < k1; ++kx) {
        const f32x4 pq = *(const LAS f32x4*)(pb + kx * 4);
        const float vv = bf2f(vbase[(size_t)(st + kx) * ZLD + lane]);
        s.o[0] += pq[0] * vv; s.o[1] += pq[1] * vv; s.o[2] += pq[2] * vv; s.o[3] += pq[3] * vv;
    }
    __builtin_amdgcn_wave_barrier();
}

__device__ __forceinline__ void p3_nsa_task(const Frame& F, int l, int tok, int kvh, LAS float* wl  ) {
    const int lane = F.lane;
    const int b = tok >> 12, t = tok & (S - 1);
    LAS float* qs = wl; LAS float* qr = wl + 256; LAS float* pc = wl + 512; LAS float* pb = wl + 1536;
    const bf16_t* zr = F.z() + (size_t)tok * ZLD;
    if (lane < 32) {
        const bf16_t* qp = zr + ZQ + kvh * 256;
        const float c = F.ropec()[t * 32 + lane], s = F.ropes()[t * 32 + lane];
#pragma unroll
        for (int g = 0; g < 4; ++g) {
            const float x1 = bf2f(qp[g * 64 + lane]), x2 = bf2f(qp[g * 64 + lane + 32]);
            qs[g * 64 + lane] = x1; qs[g * 64 + lane + 32] = x2;
            qr[g * 64 + lane] = x1 * c - x2 * s; qr[g * 64 + lane + 32] = x2 * c + x1 * s;
        }
    }
    __builtin_amdgcn_s_waitcnt(0xC07F);
    __builtin_amdgcn_wave_barrier();
    const int nv = (t >= 31) ? (((t - 31) >> 4) + 1) : 0;
    const bf16_t* kc = F.kcmp() + (size_t)(b * 2 + kvh) * NCP * 64;
    const bf16_t* vc = F.vcmp() + (size_t)(b * 2 + kvh) * NCP * 64;
    float ocmp[4] = {0.f, 0.f, 0.f, 0.f};
#pragma unroll 1
    for (int ps = 0; ps < 4; ++ps) {
        const LAS float* qq = qs; asm volatile("" : "+v"(qq));
        const int c = lane + 64 * ps; const bool valid = c < nv;
        float d0 = 0.f, d1 = 0.f, d2 = 0.f, d3 = 0.f;
        if (valid) dot4(kc + (size_t)c * 64, qq, d0, d1, d2, d3);
        pc[c] = valid ? d0 * SCALE : NEGF; pc[256 + c] = valid ? d1 * SCALE : NEGF; pc[512 + c] = valid ? d2 * SCALE : NEGF; pc[768 + c] = valid ? d3 * SCALE : NEGF;
    }
    __builtin_amdgcn_s_waitcnt(0xC07F);
    __builtin_amdgcn_wave_barrier();
#pragma unroll
    for (int g = 0; g < 4; ++g) {
        float sc[4];
#pragma unroll
        for (int ps = 0; ps < 4; ++ps) sc[ps] = pc[g * 256 + lane + 64 * ps];
        const float mm = wave_max(fmaxf(fmaxf(sc[0], sc[1]), fmaxf(sc[2], sc[3])));
        float e[4], su = 0.f;
#pragma unroll
        for (int ps = 0; ps < 4; ++ps) { e[ps] = (sc[ps] > -1e29f) ? __expf(sc[ps] - mm) : 0.f; su += e[ps]; }
        su = wave_sum(su);
        const float inv = (nv > 0) ? 1.0f / su : 0.f;
#pragma unroll
        for (int ps = 0; ps < 4; ++ps) pc[g * 256 + lane + 64 * ps] = e[ps] * inv;
    }
    __builtin_amdgcn_s_waitcnt(0xC07F);
    __builtin_amdgcn_wave_barrier();
    for (int c = 0; c < nv; ++c) {
        const float vv = bf2f(vc[(size_t)c * 64 + lane]);
        ocmp[0] += pc[c] * vv; ocmp[1] += pc[256 + c] * vv; ocmp[2] += pc[512 + c] * vv; ocmp[3] += pc[768 + c] * vv;
    }
    unsigned long long selmask;
    {
        const int j = lane, cur = t >> 6;
        float pslc = 0.f;
#pragma unroll
        for (int q = -1; q <= 3; ++q) {
            const int c = 4 * j + q;
            if (c >= 0 && c < NC) { const float ps = (pc[c] + pc[256 + c]) + (pc[512 + c] + pc[768 + c]); pslc += (q == -1 || q == 3) ? 0.5f * ps : ps; }
        }
        const bool cand = j <= cur;
        const bool forced = (j == 0) || (j == cur) || (j == cur - 1);
        const float score = cand ? (forced ? pslc + 1e4f : pslc) : NEGF;
        int rank = 0;
        for (int i = 0; i < 64; ++i) { const float si = __shfl(score, i); rank += (si > score || (si == score && i < j)) ? 1 : 0; }
        selmask = __ballot(cand && rank < 16);
    }
    __builtin_amdgcn_wave_barrier();
    OS ss; os_init(ss);
    {
        const bf16_t* kb = F.kr() + (size_t)b * S * 256 + kvh * 64;
        const bf16_t* vb = F.z() + (size_t)b * S * ZLD + ZVS + kvh * 64;
        unsigned long long m = selmask;
        while (m) { const int j = (int)__builtin_ctzll(m); m &= (m - 1); os_segment(ss, j * 64, qr, pb, kb, vb, t, lane); }
    }
    OS sw; os_init(sw);
    {
        const bf16_t* kb = F.kr() + (size_t)b * S * 256 + 128 + kvh * 64;
        const bf16_t* vb = F.z() + (size_t)b * S * ZLD + ZVW + kvh * 64;
#pragma unroll 1
        for (int i = 0; i < 8; ++i) { const int st = t - 511 + 64 * i; if (st + 63 >= 0) os_segment(sw, st, qr, pb, kb, vb, t, lane); }
    }
    bf16_t* yb = F.ybuf();
#pragma unroll
    for (int g = 0; g < 4; ++g) {
        const int head = kvh * 4 + g;
        const float g0 = sigmoidf_(bf2f(zr[ZGATE + head * 3 + 0])), g1 = sigmoidf_(bf2f(zr[ZGATE + head * 3 + 1])), g2 = sigmoidf_(bf2f(zr[ZGATE + head * 3 + 2]));
        const float y = g0 * ocmp[g] + g1 * (ss.o[g] / ss.l[g]) + g2 * (sw.o[g] / sw.l[g]);
        const float gn = bf2f(zr[ZGN + head * 64 + lane]);
        yb[(size_t)tok * D + DLRU + head * 64 + lane] = f2bf(y * siluf_(gn));
    }
    __builtin_amdgcn_wave_barrier();
}

typedef float f32x16 __attribute__((ext_vector_type(16)));
typedef short v4i16_t __attribute__((ext_vector_type(4)));
#define MFMA32(a, b, c) __builtin_amdgcn_mfma_f32_32x32x16_bf16(a, b, c, 0, 0, 0)
constexpr float C2LOG = 0.125f * 1.4426950408889634f;
constexpr int SLP = 65;
constexpr int AT_KV = 0, AT_SLAB = 65536, AT_TOT = AT_SLAB + 8 * 32 * 68 * 4, AT_SEL = AT_TOT + 64 * SLP * 4;
__device__ __forceinline__ int crow(int r, int hi) { return (r & 3) + 8 * (r >> 2) + 4 * hi; }
__device__ __forceinline__ unsigned cvtpk(float lo, float hi) { unsigned r; asm("v_cvt_pk_bf16_f32 %0, %1, %2" : "=v"(r) : "v"(lo), "v"(hi)); return r; }
__device__ __forceinline__ float fexp2(float x) { return __builtin_amdgcn_exp2f(x); }
__device__ __forceinline__ u32x4 ldk(const bf16_t* kbase, int pitch, int row0, int wave, int lane) { return *(const u32x4*)(kbase + (size_t)(row0 + lane) * pitch + wave * 8); }
__device__ __forceinline__ u32x4 ldv(const bf16_t* vbase, int pitch, int row0, int wave, int lane) { return *(const u32x4*)(vbase + (size_t)(row0 + 16 * (wave & 3) + (lane >> 2)) * pitch + (wave >> 2) * 32 + (lane & 3) * 8); }
__device__ __forceinline__ void st_tile(LAS unsigned char* buf, int wave, int lane, u32x4 v) { *(LAS u32x4*)(buf + wave * 1024 + lane * 16) = v; }
__device__ __forceinline__ void kfrags(bf16x8 (&kf)[8], const LAS unsigned char* kbuf, int r32, int hi) {
#pragma unroll
    for (int d0 = 0; d0 < 4; ++d0) { kf[2 * d0] = *(const LAS bf16x8*)(kbuf + (2 * d0 + hi) * 1024 + r32 * 16); kf[2 * d0 + 1] = *(const LAS bf16x8*)(kbuf + (2 * d0 + hi) * 1024 + (32 + r32) * 16); }
}
__device__ __forceinline__ bf16x8 vfrag(const LAS unsigned char* vbuf, int ks, int dh, int lane) {
    const int hi = lane >> 5;
    const LAS unsigned char* p = vbuf + dh * 4096 + (16 * ks + 4 * hi + ((lane & 15) >> 2)) * 64 + ((lane >> 4) & 1) * 32 + (lane & 3) * 8;
    const v4i16_t lo = __builtin_amdgcn_ds_read_tr16_b64_v4i16((LAS v4i16_t*)p);
    const v4i16_t hh = __builtin_amdgcn_ds_read_tr16_b64_v4i16((LAS v4i16_t*)(p + 512));
    return (bf16x8){lo[0], lo[1], lo[2], lo[3], hh[0], hh[1], hh[2], hh[3]};
}
__device__ __forceinline__ void scores(f32x16& p0, f32x16& p1, const bf16x8 (&kf)[8], const bf16x8 (&qf)[4]) {
    p0 = (f32x16){0.f}; p1 = (f32x16){0.f};
#pragma unroll
    for (int d0 = 0; d0 < 4; ++d0) { p0 = MFMA32(kf[2 * d0], qf[d0], p0); p1 = MFMA32(kf[2 * d0 + 1], qf[d0], p1); }
}
__device__ __forceinline__ void band_mask(f32x16& p0, f32x16& p1, int mode, int tl, int hi) {
#pragma unroll
    for (int r = 0; r < 16; ++r) {
        const int k0 = crow(r, hi), k1 = k0 + 32;
        bool keep0, keep1;
        if (mode == 1) { keep0 = k0 <= tl; keep1 = k1 <= tl; } else if (mode == 2) { keep0 = k0 > tl; keep1 = k1 > tl; } else { keep0 = k0 < tl; keep1 = k1 < tl; }
        if (!keep0) p0[r] = -INFINITY; if (!keep1) p1[r] = -INFINITY;
    }
}
__device__ __forceinline__ float rowmax32(const f32x16& p0, const f32x16& p1) {
    float a = fmaxf(p0[0], p1[0]);
#pragma unroll
    for (int r = 1; r < 16; ++r) a = fmaxf(a, fmaxf(p0[r], p1[r]));
    return fmaxf(a, __shfl_xor(a, 32));
}
struct FlashState { f32x16 o0, o1; float m, l; };
__device__ __forceinline__ void fs_init(FlashState& s) { s.o0 = (f32x16){0.f}; s.o1 = (f32x16){0.f}; s.m = -1e30f; s.l = 0.f; }
__device__ __forceinline__ void pv_acc(f32x16& o0, f32x16& o1, const f32x16& p0, const f32x16& p1, const LAS unsigned char* vbuf, int lane) {
    bf16x8 pw[4];
#pragma unroll
    for (int s = 0; s < 2; ++s) {
        u32x4 a, b;
        a.x = cvtpk(p0[8 * s + 0], p0[8 * s + 1]); a.y = cvtpk(p0[8 * s + 2], p0[8 * s + 3]); a.z = cvtpk(p0[8 * s + 4], p0[8 * s + 5]); a.w = cvtpk(p0[8 * s + 6], p0[8 * s + 7]);
        b.x = cvtpk(p1[8 * s + 0], p1[8 * s + 1]); b.y = cvtpk(p1[8 * s + 2], p1[8 * s + 3]); b.z = cvtpk(p1[8 * s + 4], p1[8 * s + 5]); b.w = cvtpk(p1[8 * s + 6], p1[8 * s + 7]);
        pw[s] = __builtin_bit_cast(bf16x8, a); pw[2 + s] = __builtin_bit_cast(bf16x8, b);
    }
#pragma unroll
    for (int ks = 0; ks < 4; ++ks) { o0 = MFMA32(vfrag(vbuf, ks, 0, lane), pw[ks], o0); o1 = MFMA32(vfrag(vbuf, ks, 1, lane), pw[ks], o1); }
}
__device__ __forceinline__ void flash_tile(FlashState& st, const bf16x8 (&qf)[4], const LAS unsigned char* kbuf, const LAS unsigned char* vbuf, int lane, bool row_on, int mode, int tl) {
    const int r32 = lane & 31, hi = lane >> 5;
    bf16x8 kf[8]; kfrags(kf, kbuf, r32, hi);
    f32x16 p0, p1; scores(p0, p1, kf, qf);
    if (mode) band_mask(p0, p1, mode, tl, hi);
    float rm = rowmax32(p0, p1);
    if (!row_on) rm = -INFINITY;
    const float mn = fmaxf(st.m, rm);
    const float alpha = fexp2(st.m - mn);
    const float ms = row_on ? mn : INFINITY;
    float sum = 0.f;
#pragma unroll
    for (int r = 0; r < 16; ++r) { p0[r] = fexp2(p0[r] - ms); p1[r] = fexp2(p1[r] - ms); sum += p0[r] + p1[r]; }
    st.l = st.l * alpha + sum; st.m = mn;
    st.o0 *= alpha; st.o1 *= alpha;
    pv_acc(st.o0, st.o1, p0, p1, vbuf, lane);
}

namespace at64 {
typedef short s16x4 __attribute__((ext_vector_type(4)));
typedef LAS const char* lds_cptr;
constexpr int SLOTB = 8192, LDS_K = 0, LDS_V = 3 * SLOTB, STG = 68;
constexpr float C2 = 0.125f * 1.4426950408889634f;
#define A64_THR 8
#define SBAR() __builtin_amdgcn_sched_barrier(0)
#define PIN(x) asm volatile("" : "+v"(x))
#define WAIT_BAR(N) asm volatile("s_waitcnt vmcnt(" #N ") lgkmcnt(0)\n\ts_barrier" ::: "memory")
__device__ __forceinline__ void glds16(const void* g, unsigned lds_base) {
    unsigned sv; asm volatile("s_mov_b32 %0, m0\n\ts_mov_b32 m0, %2\n\ts_nop 0\n\tglobal_load_lds_dwordx4 %1, off\n\ts_mov_b32 m0, %0" : "=&s"(sv) : "v"(g), "s"(lds_base) : "memory"); }
__device__ __forceinline__ void kload2(bf16x8* kf, lds_cptr kp, int d0) { kf[2 * d0] = *(const LAS bf16x8*)(kp + d0 * 2048); kf[2 * d0 + 1] = *(const LAS bf16x8*)(kp + d0 * 2048 + 512); }
__device__ __forceinline__ s16x4 vtr(lds_cptr p) { return __builtin_bit_cast(s16x4, __builtin_amdgcn_ds_read_tr16_b64_v4i16((LAS v4i16_t*)p)); }
#define MX3(a, b, c) __builtin_fmaxf(__builtin_fmaxf((a), (b)), (c))
__device__ __forceinline__ float rowmax(const f32x16& p0, const f32x16& p1) {
    float a = MX3(p0[0], p0[1], p1[0]), b = MX3(p0[2], p0[3], p1[1]); a = MX3(a, p1[2], p1[3]);
#pragma unroll
    for (int r = 4; r < 16; r += 4) { a = MX3(a, p0[r], p0[r + 1]); b = MX3(b, p0[r + 2], p0[r + 3]); a = MX3(a, p1[r], p1[r + 1]); b = MX3(b, p1[r + 2], p1[r + 3]); }
    float m = __builtin_fmaxf(a, b); auto rr = __builtin_amdgcn_permlane32_swap(__float_as_uint(m), __float_as_uint(m), false, false);
    return __builtin_fmaxf(__uint_as_float(rr[0]), __uint_as_float(rr[1])); }
__device__ __forceinline__ void cmask_c(f32x16& p0, f32x16& p1, int qrel, int hi) {
#pragma unroll
    for (int r = 0; r < 16; ++r) { const int kv = 4 * hi + (r & 3) + 8 * (r >> 2); if (kv > qrel) p0[r] = -INFINITY; if (kv + 32 > qrel) p1[r] = -INFINITY; } }
__device__ __forceinline__ void cmask_f(f32x16& p0, f32x16& p1, int qrel, int hi) {
#pragma unroll
    for (int r = 0; r < 16; ++r) { const int kv = 4 * hi + (r & 3) + 8 * (r >> 2); if (kv <= qrel) p0[r] = -INFINITY; if (kv + 32 <= qrel) p1[r] = -INFINITY; } }

__device__ __forceinline__ void stream_head(LAS unsigned char* ring, const bf16_t* __restrict__ K, int KP, const bf16_t* __restrict__ V, int VP, int tid) {
    const int lane = tid & 63; const int wid = __builtin_amdgcn_readfirstlane(tid >> 6);
    const unsigned lds0 = (unsigned)(uintptr_t)ring;
    const bf16_t* ksrc = K + (long)lane * KP + wid * 8;
    const bf16_t* vsrc = V + (long)(16 * (wid & 3) + (lane >> 2)) * VP + (wid >> 2) * 32 + (lane & 3) * 8;
    const unsigned kdst = lds0 + LDS_K + wid * 1024, vdst = lds0 + LDS_V + wid * 1024;
    glds16(ksrc, (unsigned)__builtin_amdgcn_readfirstlane(kdst));
    glds16(vsrc, (unsigned)__builtin_amdgcn_readfirstlane(vdst));
    glds16(ksrc + (long)64 * KP, (unsigned)__builtin_amdgcn_readfirstlane(kdst + SLOTB));
}
constexpr int PARK_K = 7 * SLOTB, PARK_V = 3 * SLOTB;
__device__ __forceinline__ void stream_park(LAS unsigned char* ring, const bf16_t* __restrict__ K, int KP, const bf16_t* __restrict__ V, int VP, int tid) {
    const int lane = tid & 63; const int wid = __builtin_amdgcn_readfirstlane(tid >> 6);
    const unsigned lds0 = (unsigned)(uintptr_t)ring;
    const bf16_t* ksrc = K + (long)lane * KP + wid * 8;
    const bf16_t* vsrc = V + (long)(16 * (wid & 3) + (lane >> 2)) * VP + (wid >> 2) * 32 + (lane & 3) * 8;
    glds16(ksrc, (unsigned)__builtin_amdgcn_readfirstlane(lds0 + LDS_K + PARK_K + wid * 1024));
    glds16(vsrc, (unsigned)__builtin_amdgcn_readfirstlane(lds0 + LDS_V + PARK_V + wid * 1024));
}
__device__ __forceinline__ void stream(LAS unsigned char* ring, LAS float* wsf  , LAS float* stage  , const bf16x8 (&qr)[4],
                                       const bf16_t* __restrict__ K, int KP, const bf16_t* __restrict__ V, int VP, int NT, bool far0, unsigned long long selw, int qrel, int tid, int pre_issued = 0) {
    const int lane = tid & 63, r32 = lane & 31, hi = lane >> 5; const int wid = __builtin_amdgcn_readfirstlane(tid >> 6);
    const unsigned lds0 = (unsigned)(uintptr_t)ring;
    const bf16_t* ksrc = K + (long)lane * KP + wid * 8;
    const bf16_t* vsrc = V + (long)(16 * (wid & 3) + (lane >> 2)) * VP + (wid >> 2) * 32 + (lane & 3) * 8;
    const unsigned kdst = lds0 + LDS_K + wid * 1024, vdst = lds0 + LDS_V + wid * 1024;
#define MFMA(a, b, c) __builtin_amdgcn_mfma_f32_32x32x16_bf16(a, b, c, 0, 0, 0)
#define DMA_K(t, slot) glds16(ksrc + (long)(t) * 64 * KP, (unsigned)__builtin_amdgcn_readfirstlane(kdst + (slot)))
#define DMA_V(t, slot) glds16(vsrc + (long)(t) * 64 * VP, (unsigned)__builtin_amdgcn_readfirstlane(vdst + (slot)))
    const lds_cptr vp0 = (lds_cptr)ring + LDS_V + ((lane >> 4) & 1) * 32 + (lane & 3) * 8 + (4 * hi + ((lane & 15) >> 2)) * 64;
    const lds_cptr kp0 = (lds_cptr)ring + LDS_K + hi * 1024 + r32 * 16;
    if (pre_issued == 0) { DMA_K(0, 0); DMA_V(0, 0); DMA_K(1, SLOTB); }
    else if (pre_issued == 2) { DMA_K(1, SLOTB); }
    float mhat = 0.f, l_reg = 0.f; f32x16 o[2]; o[0] = f32x16{}; o[1] = f32x16{};
    const f32x16 zero16 = f32x16{};
    bool resc = false;
    f32x16 pA0, pA1, pB0, pB1; bf16x8 kf[8]; s16x4 vlo[8], vhi[8]; u32x4 pw0, pw1, pw2, pw3;
    const int park = (pre_issued == 2);
    int sl_prev = park ? PARK_V : 0, sl_cur = sl_prev, sl_next = SLOTB;
#define ROT() do { sl_prev = sl_cur; sl_cur = sl_next; sl_next = (sl_next == 2 * SLOTB) ? 0 : sl_next + SLOTB; } while (0)
#define EX(v) __builtin_amdgcn_exp2f(v)
    unsigned mpk = 0u;
    const bf16x8 kone = __builtin_bit_cast(bf16x8, (u32x4){hi == 0 ? 0x3F803F80u : 0u, 0u, 0u, 0u});
#define MPK() do { const float nm_ = -mhat; const unsigned hb_ = __float_as_uint(nm_) & 0xffff0000u; const float lo_ = nm_ - __uint_as_float(hb_); mpk = (hb_ >> 16) | (cvtpk(lo_, lo_) << 16); } while (0)
#define RESC() do { if (resc) { _Pragma("unroll") for (int d_ = 0; d_ < 2; ++d_) _Pragma("unroll") for (int r = 0; r < 16; ++r) o[d_][r] *= wsf[crow(r, hi)]; } } while (0)
    DMA_K(2, 2 * SLOTB);
    WAIT_BAR(3);
    _Pragma("unroll") for (int d0 = 0; d0 < 4; ++d0) kload2(kf, kp0 + (park ? PARK_K : 0), d0);
    pA0 = MFMA(kf[0], qr[0], zero16); pA1 = MFMA(kf[1], qr[0], zero16); pA0 = MFMA(kf[2], qr[1], pA0); pA1 = MFMA(kf[3], qr[1], pA1);
    pA0 = MFMA(kf[4], qr[2], pA0); pA1 = MFMA(kf[5], qr[2], pA1); pA0 = MFMA(kf[6], qr[3], pA0); pA1 = MFMA(kf[7], qr[3], pA1);
    if (NT == 1) cmask_c(pA0, pA1, qrel, hi);
    if (far0) cmask_f(pA0, pA1, qrel, hi);
    { const float rm = rowmax(pA0, pA1); mhat = __builtin_fmaxf(rm, -1.0e4f);
#pragma unroll
      for (int r = 0; r < 16; ++r) { pA0[r] = __builtin_amdgcn_exp2f(pA0[r] - mhat); pA1[r] = __builtin_amdgcn_exp2f(pA1[r] - mhat); } }
    MPK();
    WAIT_BAR(0);
    DMA_K(3, 0); DMA_V(1, SLOTB); ROT();
    _Pragma("unroll") for (int d0 = 0; d0 < 4; ++d0) kload2(kf, kp0 + sl_cur, d0);
    WAIT_BAR(2);
#define PKW(P, i) cvtpk(P[i], P[i + 1])
#define PAF(k) __builtin_bit_cast(bf16x8, pw##k)
#define VFR(i) (bf16x8){vlo[i][0], vlo[i][1], vlo[i][2], vlo[i][3], vhi[i][0], vhi[i][1], vhi[i][2], vhi[i][3]}
#define VRD(i) do { vlo[i] = vtr(vp_ + (((i) >> 2) * 4096 + ((i) & 3) * 1024)); vhi[i] = vtr(vp_ + (((i) >> 2) * 4096 + ((i) & 3) * 1024 + 512)); } while (0)
#define KRD(G, d0) do { if (G) { kload2(kf, kp0 + sl_next, d0); SBAR(); } } while (0)
#define GAPA(MF, a0, a1, a2, a3, W0, W1, PW) do { MF; sacc += a0; sacc += a1; sacc += a2; sacc += a3; W0; W1; PIN(PW); PIN(sacc); SBAR(); } while (0)
#define GAPB(MF, X, i) do { MF; X[i] = EX(X[i]); X[i + 1] = EX(X[i + 1]); X[i + 2] = EX(X[i + 2]); X[i + 3] = EX(X[i + 3]); PIN(X); SBAR(); } while (0)
#define STEP(C0, C1, P0, P1, t, MASK, GK, GV, GL) do { SBAR(); \
    const lds_cptr vp_ = vp0 + sl_prev; \
    const bool ron_ = ((selw >> (t)) & 1ull) != 0ull; \
    const bf16x8 qex_ = __builtin_bit_cast(bf16x8, (u32x4){hi == 0 ? (ron_ ? mpk : 0x0000C6EAu) : 0u, 0u, 0u, 0u});     \
    C0 = MFMA(kone, qex_, zero16); C1 = MFMA(kone, qex_, zero16); SBAR(); \
    VRD(0); SBAR(); float sacc = P0[0] + P0[1]; \
                    GAPA(C0 = MFMA(kf[0], qr[0], C0), P0[2], P0[3], P0[4], P0[5],     pw0[0] = PKW(P0, 0),  pw0[1] = PKW(P0, 2),  pw0); \
    VRD(4); SBAR(); GAPA(C1 = MFMA(kf[1], qr[0], C1), P0[6], P0[7], P0[8], P0[9],     pw0[2] = PKW(P0, 4),  pw0[3] = PKW(P0, 6),  pw0); \
    VRD(1); SBAR(); GAPA(C0 = MFMA(kf[2], qr[1], C0),    P0[10], P0[11], P0[12], P0[13], pw1[0] = PKW(P0, 8),  pw1[1] = PKW(P0, 10), pw1); \
    VRD(5); SBAR(); GAPA(C1 = MFMA(kf[3], qr[1], C1),    P0[14], P0[15], P1[0], P1[1],   pw1[2] = PKW(P0, 12), pw1[3] = PKW(P0, 14), pw1); \
    VRD(2); SBAR(); GAPA(C0 = MFMA(kf[4], qr[2], C0),    P1[2], P1[3], P1[4], P1[5],     pw2[0] = PKW(P1, 0),  pw2[1] = PKW(P1, 2),  pw2); \
    VRD(6); SBAR(); GAPA(C1 = MFMA(kf[5], qr[2], C1),    P1[6], P1[7], P1[8], P1[9],     pw2[2] = PKW(P1, 4),  pw2[3] = PKW(P1, 6),  pw2); \
    VRD(3); SBAR(); GAPA(C0 = MFMA(kf[6], qr[3], C0),    P1[10], P1[11], P1[12], P1[13], pw3[0] = PKW(P1, 8),  pw3[1] = PKW(P1, 10), pw3); \
    VRD(7); SBAR(); GAPA(C1 = MFMA(kf[7], qr[3], C1),    P1[14], P1[15], 0.f, 0.f,       pw3[2] = PKW(P1, 12), pw3[3] = PKW(P1, 14), pw3); \
    l_reg += sacc; \
    if (GK) DMA_K((t) + 3, sl_cur); if (GV) DMA_V((t) + 1, sl_next); \
    if (MASK) { if ((t) == NT - 1) cmask_c(C0, C1, qrel, hi); } \
    { float rm = rowmax(C0, C1); if (!ron_) rm = -INFINITY; resc = false; \
      if (__builtin_expect(__any(rm > (float)A64_THR), 0)) { const float dl = __builtin_fmaxf(rm, 0.f); mhat += dl; \
          const float f = __builtin_amdgcn_exp2f(-dl); l_reg *= f; if (hi == 0) wsf[r32] = f; resc = true; \
          _Pragma("unroll") for (int r_ = 0; r_ < 16; ++r_) { C0[r_] -= dl; C1[r_] -= dl; } MPK(); } } \
    SBAR(); \
    GAPB(o[0] = MFMA(PAF(0), VFR(0), o[0]), C0, 0);              GAPB(o[1] = MFMA(PAF(0), VFR(4), o[1]), C0, 4); \
    KRD(GL, 0); GAPB(o[0] = MFMA(PAF(1), VFR(1), o[0]), C0, 8);  KRD(GL, 1); GAPB(o[1] = MFMA(PAF(1), VFR(5), o[1]), C0, 12); \
    KRD(GL, 2); GAPB(o[0] = MFMA(PAF(2), VFR(2), o[0]), C1, 0);  KRD(GL, 3); GAPB(o[1] = MFMA(PAF(2), VFR(6), o[1]), C1, 4); \
    GAPB(o[0] = MFMA(PAF(3), VFR(3), o[0]), C1, 8);              GAPB(o[1] = MFMA(PAF(3), VFR(7), o[1]), C1, 12); \
    } while (0)
    int t = 1;
    for (; t + 5 < NT; t += 2) {
        STEP(pB0, pB1, pA0, pA1, t, false, true, true, true);     WAIT_BAR(2); RESC(); ROT();
        STEP(pA0, pA1, pB0, pB1, t + 1, false, true, true, true); WAIT_BAR(2); RESC(); ROT();
    }
#define ENDW(tt) do { if ((tt) + 3 < NT) { WAIT_BAR(2); } else if ((tt) + 2 < NT) { WAIT_BAR(1); } else { WAIT_BAR(0); } } while (0)
    for (; t + 1 < NT; t += 2) {
        STEP(pB0, pB1, pA0, pA1, t, true, (t + 3 < NT), (t + 1 < NT), (t + 1 < NT));         ENDW(t);     RESC(); ROT();
        STEP(pA0, pA1, pB0, pB1, t + 1, true, (t + 4 < NT), (t + 2 < NT), (t + 2 < NT));     ENDW(t + 1); RESC(); ROT();
    }
    int sl_last;
    if (t < NT) { STEP(pB0, pB1, pA0, pA1, t, true, false, false, false); RESC(); sl_last = sl_cur; }
    else { pB0 = pA0; pB1 = pA1; sl_last = sl_prev; }
    { float sacc = pB0[0] + pB0[1];
#pragma unroll
      for (int r = 2; r < 16; ++r) sacc += pB0[r];
#pragma unroll
      for (int r = 0; r < 16; ++r) sacc += pB1[r];
      l_reg += sacc;
      pw0 = (u32x4){PKW(pB0, 0), PKW(pB0, 2), PKW(pB0, 4), PKW(pB0, 6)}; pw1 = (u32x4){PKW(pB0, 8), PKW(pB0, 10), PKW(pB0, 12), PKW(pB0, 14)};
      pw2 = (u32x4){PKW(pB1, 0), PKW(pB1, 2), PKW(pB1, 4), PKW(pB1, 6)}; pw3 = (u32x4){PKW(pB1, 8), PKW(pB1, 10), PKW(pB1, 12), PKW(pB1, 14)};
      const lds_cptr vp_ = vp0 + sl_last; _Pragma("unroll") for (int i = 0; i < 8; ++i) VRD(i);
      o[0] = MFMA(PAF(0), VFR(0), o[0]); o[1] = MFMA(PAF(0), VFR(4), o[1]); o[0] = MFMA(PAF(1), VFR(1), o[0]); o[1] = MFMA(PAF(1), VFR(5), o[1]);
      o[0] = MFMA(PAF(2), VFR(2), o[0]); o[1] = MFMA(PAF(2), VFR(6), o[1]); o[0] = MFMA(PAF(3), VFR(3), o[0]); o[1] = MFMA(PAF(3), VFR(7), o[1]); }
    { auto rr = __builtin_amdgcn_permlane32_swap(__float_as_uint(l_reg), __float_as_uint(l_reg), false, false); l_reg = __uint_as_float(rr[0]) + __uint_as_float(rr[1]); }
    if (hi == 0) wsf[32 + r32] *= __builtin_amdgcn_rcpf(l_reg);
    asm volatile("s_waitcnt lgkmcnt(0)" ::: "memory");
#pragma unroll
    for (int r = 0; r < 16; ++r) { const int orow = crow(r, hi); const float sc = wsf[32 + orow];
#pragma unroll
        for (int d0 = 0; d0 < 2; ++d0) stage[orow * STG + d0 * 32 + r32] += o[d0][r] * sc; }
    asm volatile("s_waitcnt vmcnt(0) lgkmcnt(0)\n\ts_barrier" ::: "memory");
#undef MFMA
#undef DMA_K
#undef DMA_V
#undef ROT
#undef EX
#undef RESC
#undef PKW
#undef PAF
#undef VFR
#undef VRD
#undef KRD
#undef ENDW
#undef GAPA
#undef GAPB
#undef STEP
}
#undef SBAR
#undef PIN
#undef WAIT_BAR
#undef MX3
}

__device__ __forceinline__ void rank8(unsigned ki, const unsigned (&my)[8], int (&rank)[8]) {
    asm volatile(
        "v_cmp_gt_u32_e64 s[36:37], %8, %9\n\t"  "v_cmp_gt_u32_e64 s[38:39], %8, %10\n\t" "v_cmp_gt_u32_e64 s[40:41], %8, %11\n\t" "v_cmp_gt_u32_e64 s[42:43], %8, %12\n\t"
        "v_cmp_gt_u32_e64 s[44:45], %8, %13\n\t" "v_cmp_gt_u32_e64 s[46:47], %8, %14\n\t" "v_cmp_gt_u32_e64 s[48:49], %8, %15\n\t" "v_cmp_gt_u32_e64 s[50:51], %8, %16\n\t"
        "v_addc_co_u32_e64 %0, s[36:37], 0, %0, s[36:37]\n\t" "v_addc_co_u32_e64 %1, s[38:39], 0, %1, s[38:39]\n\t" "v_addc_co_u32_e64 %2, s[40:41], 0, %2, s[40:41]\n\t" "v_addc_co_u32_e64 %3, s[42:43], 0, %3, s[42:43]\n\t"
        "v_addc_co_u32_e64 %4, s[44:45], 0, %4, s[44:45]\n\t" "v_addc_co_u32_e64 %5, s[46:47], 0, %5, s[46:47]\n\t" "v_addc_co_u32_e64 %6, s[48:49], 0, %6, s[48:49]\n\t" "v_addc_co_u32_e64 %7, s[50:51], 0, %7, s[50:51]"
        : "+v"(rank[0]), "+v"(rank[1]), "+v"(rank[2]), "+v"(rank[3]), "+v"(rank[4]), "+v"(rank[5]), "+v"(rank[6]), "+v"(rank[7])
        : "v"(ki), "v"(my[0]), "v"(my[1]), "v"(my[2]), "v"(my[3]), "v"(my[4]), "v"(my[5]), "v"(my[6]), "v"(my[7])
        : "s36", "s37", "s38", "s39", "s40", "s41", "s42", "s43", "s44", "s45", "s46", "s47", "s48", "s49", "s50", "s51");
}
__device__ __forceinline__ void p3_nsa_unit(const Frame& F, int l, int b, int kvh, int qb) {
    const int tid = F.tid, lane = F.lane, wave = F.wave, r32 = lane & 31, hi = lane >> 5;
    LAS unsigned char* base = F.lds + LDS_WORK;
    LAS unsigned char* kvr = base + AT_KV;
    LAS float* slab = (LAS float*)(base + AT_SLAB);
    LAS float* tot = (LAS float*)(base + AT_TOT);
    LAS unsigned long long* sel = (LAS unsigned long long*)(base + AT_SEL);
    LAS float* sinv = (LAS float*)(base + AT_SEL + 512);
    LAS float* stash = slab;
    const int g = wave >> 1, tl = 32 * (wave & 1) + r32, head = 4 * kvh + g;
    const int t0 = qb * 64, t = t0 + tl; const size_t tok = (size_t)b * S + t;
    const bf16_t* zr = F.z() + tok * ZLD;
    bf16x8 qc[4], qr[4]; float g0v, g1v, g2v; unsigned long long selw = 0ull; LAS float* stage = nullptr; LAS float* wsf = nullptr;
#pragma unroll 1
    for (int rpu_ = 0; rpu_ < (((REP_PH >> 12) & 1) ? 2 : 1); ++rpu_) {
    if (rpu_) __syncthreads();
    {
        const bf16_t* kc = F.kcmp() + (size_t)(b * 2 + kvh) * NCP * 64;
        const bf16_t* vc = F.vcmp() + (size_t)(b * 2 + kvh) * NCP * 64;
        const int ntc0 = (4 * qb + 3 + 63) >> 6;
#pragma unroll
        for (int tt = 0; tt < 4; ++tt) if (tt < ntc0) { st_tile(kvr + tt * 8192, wave, lane, ldk(kc, 64, tt * 64, wave, lane)); st_tile(kvr + 32768 + tt * 8192, wave, lane, ldv(vc, 64, tt * 64, wave, lane)); }
    }
    {
        float qv[4][8];
#pragma unroll
        for (int d0 = 0; d0 < 4; ++d0) {
            const u32x4 w = *(const u32x4*)(zr + ZQ + head * 64 + d0 * 16 + hi * 8);
            qv[d0][0] = bflo(w.x); qv[d0][1] = bfhi(w.x); qv[d0][2] = bflo(w.y); qv[d0][3] = bfhi(w.y); qv[d0][4] = bflo(w.z); qv[d0][5] = bfhi(w.z); qv[d0][6] = bflo(w.w); qv[d0][7] = bfhi(w.w);
            u32x4 o; o.x = cvtpk(qv[d0][0] * C2LOG, qv[d0][1] * C2LOG); o.y = cvtpk(qv[d0][2] * C2LOG, qv[d0][3] * C2LOG); o.z = cvtpk(qv[d0][4] * C2LOG, qv[d0][5] * C2LOG); o.w = cvtpk(qv[d0][6] * C2LOG, qv[d0][7] * C2LOG);
            qc[d0] = __builtin_bit_cast(bf16x8, o);
        }
#pragma unroll
        for (int d0 = 0; d0 < 2; ++d0) {
            const float* cp = F.ropec() + t * 32 + d0 * 16 + hi * 8; const float* sp = F.ropes() + t * 32 + d0 * 16 + hi * 8;
            const f32x4 c0 = *(const f32x4*)cp, c1 = *(const f32x4*)(cp + 4), s0 = *(const f32x4*)sp, s1 = *(const f32x4*)(sp + 4);
            float a[8], bb[8];
#pragma unroll
            for (int j = 0; j < 8; ++j) { const float c = j < 4 ? c0[j & 3] : c1[j & 3], s = j < 4 ? s0[j & 3] : s1[j & 3]; const float x1 = qv[d0][j], x2 = qv[d0 + 2][j];
                a[j] = (x1 * c - x2 * s) * C2LOG; bb[j] = (x2 * c + x1 * s) * C2LOG; }
            u32x4 o1, o2; o1.x = cvtpk(a[0], a[1]); o1.y = cvtpk(a[2], a[3]); o1.z = cvtpk(a[4], a[5]); o1.w = cvtpk(a[6], a[7]);
            o2.x = cvtpk(bb[0], bb[1]); o2.y = cvtpk(bb[2], bb[3]); o2.z = cvtpk(bb[4], bb[5]); o2.w = cvtpk(bb[6], bb[7]);
            qr[d0] = __builtin_bit_cast(bf16x8, o1); qr[d0 + 2] = __builtin_bit_cast(bf16x8, o2);
        }
        g0v = sigmoidf_(bf2f(zr[ZGATE + head * 3 + 0])); g1v = sigmoidf_(bf2f(zr[ZGATE + head * 3 + 1])); g2v = sigmoidf_(bf2f(zr[ZGATE + head * 3 + 2]));
    }
    __syncthreads();
    const int nv = (t >= 31) ? (((t - 31) >> 4) + 1) : 0;
    const int ntc = (4 * qb + 3 + 63) >> 6;
#ifndef CMP_THR
#define CMP_THR 8
#endif
    float mrow = -1e30f;
    f32x16 yacc0, yacc1;
    {
        f32x16 oc0 = (f32x16){0.f}, oc1 = (f32x16){0.f};
        float lsum = 0.f, carry = 0.f;
        LAS float* myslab = slab + (g * 64 + tl) * SLP;
#pragma unroll 1
        for (int tt = 0; tt < ntc; ++tt) {
            bf16x8 kf[8]; kfrags(kf, kvr + tt * 8192, r32, hi);
            f32x16 p0, p1; scores(p0, p1, kf, qc);
            if (!__all(nv - 64 * tt >= 64)) band_mask(p0, p1, 3, nv - 64 * tt, hi);
            { const float rm = rowmax32(p0, p1);
              if (tt == 0) mrow = fmaxf(rm, -1e30f);
              else if (__any(rm > mrow + (float)CMP_THR)) {
                  const float dl = fmaxf(rm - mrow, 0.f), f = fexp2(-dl);
                  mrow += dl; lsum *= f; carry *= f; oc0 = oc0 * f; oc1 = oc1 * f;
                  for (int j = hi; j < 16 * tt; j += 2) myslab[j] *= f;
              } }
#pragma unroll
            for (int r = 0; r < 16; ++r) { p0[r] = fexp2(p0[r] - mrow); p1[r] = fexp2(p1[r] - mrow); lsum += p0[r] + p1[r]; }
#pragma unroll
            for (int n = 0; n < 2; ++n)
#pragma unroll
                for (int q = 0; q < 4; ++q) {
                    const f32x16& pp = n ? p1 : p0;
                    const float tl_ = 0.5f * pp[4 * q + 3];
                    const float inner = (pp[4 * q] + pp[4 * q + 1]) + (pp[4 * q + 2] + tl_);
                    const float rcv = __shfl_xor(tl_, 32);
                    myslab[16 * tt + 8 * n + 2 * q + hi] = inner + (hi ? rcv : carry);
                    carry = rcv;
                }
            pv_acc(oc0, oc1, p0, p1, kvr + 32768 + tt * 8192, lane);
        }
        lsum += __shfl_xor(lsum, 32);
        const float inv = lsum > 0.f ? 1.0f / lsum : 0.f;
        if (hi == 0) sinv[g * 64 + tl] = inv;
        const float g0 = g0v * inv;
        yacc0 = oc0 * g0; yacc1 = oc1 * g0;
    }
    __syncthreads();
    { const int tbw_ = qb >= 8 ? qb - 8 : 0;
      at64::stream_park(kvr, F.kr() + ((size_t)b * S + tbw_ * 64) * 256 + 128 + kvh * 64, 256, F.z() + ((size_t)b * S + tbw_ * 64) * ZLD + ZVW + kvh * 64, ZLD, tid); }
    at64::stream_head(kvr, F.kr() + (size_t)b * S * 256 + kvh * 64, 256, F.z() + (size_t)b * S * ZLD + ZVS + kvh * 64, ZLD, tid);
    {
        LAS unsigned* tkey = (LAS unsigned*)tot;
        const int tk = tid & 63, part = wave, cur = qb;
        unsigned my[8]; int rank[8];
#pragma unroll
        for (int jj = 0; jj < 8; ++jj) { const int j = part * 8 + jj;
            const float v = (j >= 16 * ntc) ? 0.f : (slab[(0 * 64 + tk) * SLP + j] * sinv[tk] + slab[(1 * 64 + tk) * SLP + j] * sinv[64 + tk]) + (slab[(2 * 64 + tk) * SLP + j] * sinv[128 + tk] + slab[(3 * 64 + tk) * SLP + j] * sinv[192 + tk]);
            const bool forced = (j == 0) || (j == cur) || (j == cur - 1);
            my[jj] = (forced ? 0x80000000u : 0u) | ((__float_as_uint(v) >> 6) << 6) | (unsigned)(63 - j); rank[jj] = 0;
            tkey[tk * SLP + j] = my[jj]; }
        __syncthreads();
        if (cur >= 16 && part * 8 <= cur)
        for (int i0 = 0; i0 <= cur; i0 += 4) {
            unsigned kq[4];
#pragma unroll
            for (int q = 0; q < 4; ++q) kq[q] = tkey[tk * SLP + i0 + q];
#pragma unroll
            for (int q = 0; q < 4; ++q) rank8(i0 + q <= cur ? kq[q] : 0u, my, rank);
        }
        unsigned bits = 0;
#pragma unroll
        for (int jj = 0; jj < 8; ++jj) { const int j = part * 8 + jj; if (j <= cur && rank[jj] < 16) bits |= 1u << jj; }
        ((LAS unsigned char*)sel)[tk * 8 + part] = (unsigned char)bits;
        __syncthreads();
    }
    selw = sel[tl];
    stage = (LAS float*)(base + AT_SLAB) + wave * (32 * at64::STG);
    wsf = (LAS float*)(base + AT_SEL + 1536) + wave * 64;
#pragma unroll
    for (int dh = 0; dh < 2; ++dh)
#pragma unroll
        for (int q = 0; q < 4; ++q) { const f32x16& ya = dh ? yacc1 : yacc0; *(LAS f32x4*)(stage + r32 * at64::STG + 32 * dh + 8 * q + 4 * hi) = (f32x4){ya[4 * q], ya[4 * q + 1], ya[4 * q + 2], ya[4 * q + 3]}; }
    }
#pragma unroll 1
    for (int rp_ = 0; rp_ < (((REP_PH >> 10) & 1) ? 2 : 1); ++rp_) {
    if (hi == 0) wsf[32 + r32] = rp_ ? 0.f : g1v;
    at64::stream(kvr, wsf, stage, qr, F.kr() + (size_t)b * S * 256 + kvh * 64, 256, F.z() + (size_t)b * S * ZLD + ZVS + kvh * 64, ZLD, qb + 1, false, selw, tl, tid, rp_ == 0 ? 1 : 0);
    }
    {
        const int tb = qb >= 8 ? qb - 8 : 0;
#pragma unroll 1
        for (int rp_ = 0; rp_ < (((REP_PH >> 11) & 1) ? 2 : 1); ++rp_) {
        if (hi == 0) wsf[32 + r32] = rp_ ? 0.f : g2v;
        at64::stream(kvr, wsf, stage, qr, F.kr() + ((size_t)b * S + tb * 64) * 256 + 128 + kvh * 64, 256, F.z() + ((size_t)b * S + tb * 64) * ZLD + ZVW + kvh * 64, ZLD, qb - tb + 1, qb >= 8, ~0ull, tl, tid, rp_ == 0 ? 2 : 0);
        }
    }
    {
        u32x4 gwv[4];
#pragma unroll
        for (int i = 0; i < 4; ++i) gwv[i] = *(const u32x4*)(F.z() + ((size_t)b * S + t0 + 32 * (wave & 1) + i * 8 + (lane >> 3)) * ZLD + ZGN + head * 64 + (lane & 7) * 8);
#pragma unroll
        for (int i = 0; i < 4; ++i) {
            const int row = i * 8 + (lane >> 3), ch = lane & 7;
            const size_t tk2 = (size_t)b * S + t0 + 32 * (wave & 1) + row;
            const f32x4 y0 = *(const LAS f32x4*)(stage + row * at64::STG + ch * 8), y1 = *(const LAS f32x4*)(stage + row * at64::STG + ch * 8 + 4);
            const u32x4 gw = gwv[i];
            u32x4 w;
            w.x = cvtpk(y0[0] * siluf_(bflo(gw.x)), y0[1] * siluf_(bfhi(gw.x))); w.y = cvtpk(y0[2] * siluf_(bflo(gw.y)), y0[3] * siluf_(bfhi(gw.y)));
            w.z = cvtpk(y1[0] * siluf_(bflo(gw.z)), y1[1] * siluf_(bfhi(gw.z))); w.w = cvtpk(y1[2] * siluf_(bflo(gw.w)), y1[3] * siluf_(bfhi(gw.w)));
            bf16_t* yo = F.ybuf() + tk2 * D + DLRU + head * 64 + ch * 8;
#if NSA_PROBE
            { const u32x4 ref = *(const u32x4*)yo;
              const unsigned rw[4] = {ref.x, ref.y, ref.z, ref.w}, nw[4] = {w.x, w.y, w.z, w.w};
              float dd = 0.f, rr = 0.f;
#pragma unroll
              for (int e = 0; e < 4; ++e) { const float r0 = bflo(rw[e]), r1 = bfhi(rw[e]), n0 = bflo(nw[e]), n1 = bfhi(nw[e]); dd += (n0 - r0) * (n0 - r0) + (n1 - r1) * (n1 - r1); rr += r0 * r0 + r1 * r1; }
              dd = wave_sum(dd); rr = wave_sum(rr);
              if (lane == 0) { atomicAdd((float*)(F.p.ws + WS_PROBE), dd); atomicAdd((float*)(F.p.ws + WS_PROBE) + 1, rr); } }
#else
            if constexpr ((WT_MASK & 16) != 0) st16wt(F.p.ws, yo, w); else *(u32x4*)yo = w;
#endif
        }
    }
    __syncthreads();
}

__device__ __forceinline__ void p3_lru_item(const Frame& F, int item) {
    const int b = item >> 6, ch = item & 63;
    LAS float* cs = (LAS float*)(F.lds + LDS_WORK);
    {
        const int chn = F.tid;
        float hh = 0.f;
        const float* agb = F.agg() + ((size_t)(b * 128) * DLRU + chn) * 2;
        for (int c0 = 0; c0 < 2 * ch; c0 += 32) {
            float2 ag[32];
#pragma unroll
            for (int i = 0; i < 32; ++i) ag[i] = (c0 + i < 2 * ch) ? *(const float2*)(agb + (size_t)(c0 + i) * DLRU * 2) : make_float2(1.f, 0.f);
#pragma unroll
            for (int i = 0; i < 32; ++i) hh = ag[i].x * hh + ag[i].y;
        }
        cs[chn] = hh;
        const float2 am = *(const float2*)(agb + (size_t)(2 * ch) * DLRU * 2);
        cs[512 + chn] = am.x * hh + am.y;
    }
    __syncthreads();
    const size_t tok0 = (size_t)b * S + ch * 64;
#pragma unroll 2
    for (int e = F.tid; e < 64 * 64; e += NTHR) {
        const int tl = e >> 6, cg = (e & 63) * 8;
        const u32x4 sw = __builtin_nontemporal_load((const u32x4*)(F.lrus() + (tok0 + tl) * DLRU + cg));
        const u32x4 sx = __builtin_nontemporal_load((const u32x4*)(F.lrus() + (tok0 + tl) * DLRU + cg + 4));
        const u32x4 gw = *(const u32x4*)(F.z() + (tok0 + tl) * ZLD + ZGL + cg);
        const f32x4 c0 = *(const LAS f32x4*)(cs + (tl >> 5) * 512 + cg), c1 = *(const LAS f32x4*)(cs + (tl >> 5) * 512 + cg + 4);
        const float h0 = bflo(sw.x) * c0[0] + bfhi(sw.x), h1 = bflo(sw.y) * c0[1] + bfhi(sw.y), h2 = bflo(sw.z) * c0[2] + bfhi(sw.z), h3 = bflo(sw.w) * c0[3] + bfhi(sw.w);
        const float h4 = bflo(sx.x) * c1[0] + bfhi(sx.x), h5 = bflo(sx.y) * c1[1] + bfhi(sx.y), h6 = bflo(sx.z) * c1[2] + bfhi(sx.z), h7 = bflo(sx.w) * c1[3] + bfhi(sx.w);
        u32x4 ow; ow.x = cvtpk_(h0 * siluf_(bflo(gw.x)), h1 * siluf_(bfhi(gw.x))); ow.y = cvtpk_(h2 * siluf_(bflo(gw.y)), h3 * siluf_(bfhi(gw.y)));
        ow.z = cvtpk_(h4 * siluf_(bflo(gw.z)), h5 * siluf_(bfhi(gw.z))); ow.w = cvtpk_(h6 * siluf_(bflo(gw.w)), h7 * siluf_(bfhi(gw.w)));
        if constexpr ((WT_MASK & 128) != 0) st16wt(F.p.ws, F.ybuf() + (tok0 + tl) * D + cg, ow); else *(u32x4*)(F.ybuf() + (tok0 + tl) * D + cg) = ow;
    }
    __syncthreads();
}

__device__ __forceinline__ void p4_outproj(const Frame& F, int l) {
    pg8::Gemm g{F.ybuf(), F.wt_out() + (size_t)l * D * D, T, D, D};
    pg8::StaticOrder So; So.init(T, D, (int)gridDim.x, F.bid);
    pg8::EpiOutProj<false> E{nullptr, F.xb(), F.ssq(), F.p.ws}; pg8::gemm_phase<pg8::EpiOutProj<false>, pg8::StaticOrder, true, true>(F.lds + LDS_WORK, g, So, E, F.tid);
}

__device__ __forceinline__ void p5_final(const Frame& F) {
    for (int row = F.bid * NWAVE + F.wave; row < T; row += gridDim.x * NWAVE) {
        const bf16_t* xr = F.xb() + (size_t)row * D;
        float* orow = F.p.out + (size_t)row * D;
        const f32x4* sp = (const f32x4*)(F.ssq() + (size_t)row * 16);
        const f32x4 s4 = (sp[0] + sp[1]) + (sp[2] + sp[3]);
        float rs = rsqrtf(((s4[0] + s4[1]) + (s4[2] + s4[3])) * (1.0f / D) + EPS);
#if NSA_PROBE
        { const float* pr = (const float*)(F.p.ws + WS_PROBE); rs *= 1.0f + sqrtf(pr[0] / fmaxf(pr[1], 1e-30f)); }
#endif
#pragma unroll
        for (int i = 0; i < 2; ++i) {
            const int c = (i * 64 + F.lane) * 8;
            const u32x4 xw = __builtin_nontemporal_load((const u32x4*)(xr + c));
            const f32x4 g0 = *(GAS const f32x4*)(F.in(17) + c), g1 = *(GAS const f32x4*)(F.in(17) + c + 4);
            const f32x4 o0 = (f32x4){bflo(xw.x), bfhi(xw.x), bflo(xw.y), bfhi(xw.y)} * rs * g0, o1 = (f32x4){bflo(xw.z), bfhi(xw.z), bflo(xw.w), bfhi(xw.w)} * rs * g1;
            if constexpr ((WT_MASK & 256) != 0) { st16wt_out(F.p.out, orow + c, __builtin_bit_cast(u32x4, o0)); st16wt_out(F.p.out, orow + c + 4, __builtin_bit_cast(u32x4, o1)); }
            else { *(f32x4*)(orow + c) = o0; *(f32x4*)(orow + c + 4) = o1; }
        }
    }
}

__global__ void __launch_bounds__(NTHR, 2) mk_fwd(Params p) {
    extern __shared__ __attribute__((aligned(16))) unsigned char lds[];
    Frame F0;
    F0.p = Params{}; F0.p.ws = p.ws; F0.p.out = p.out; F0.lds = (LAS unsigned char*)lds; F0.tid = threadIdx.x; F0.lane = F0.tid & 63; F0.wave = __builtin_amdgcn_readfirstlane(F0.tid >> 6); F0.bid = (int)blockIdx.x;
    unsigned char* ws = p.ws;
    volatile LAS unsigned* ctl = (volatile LAS unsigned*)F0.lds;
    if (F0.tid < 4) ctl[F0.tid] = 0u;
    if (F0.tid == 0) { LAS unsigned long long* it_ = (LAS unsigned long long*)(F0.lds + LDS_INP);
        it_[0] = (unsigned long long)p.x;
        it_[1] = (unsigned long long)p.norm_g;
        it_[2] = (unsigned long long)p.w_in;
        it_[3] = (unsigned long long)p.conv_w;
        it_[4] = (unsigned long long)p.conv_b;
        it_[5] = (unsigned long long)p.lru_wa;
        it_[6] = (unsigned long long)p.lru_ba;
        it_[7] = (unsigned long long)p.lru_wi;
        it_[8] = (unsigned long long)p.lru_bi;
        it_[9] = (unsigned long long)p.lru_lambda;
        it_[10] = (unsigned long long)p.pos_k;
        it_[11] = (unsigned long long)p.pos_v;
        it_[12] = (unsigned long long)p.k_w1;
        it_[13] = (unsigned long long)p.k_w2;
        it_[14] = (unsigned long long)p.v_w1;
        it_[15] = (unsigned long long)p.v_w2;
        it_[16] = (unsigned long long)p.w_out;
        it_[17] = (unsigned long long)p.final_g;
    }
    __syncthreads();
    const int lo = p.ph_lo, hi = p.ph_hi;
    XcdBarrier bar; bar.bar = (unsigned*)(ws + WS_BAR); bar.x = 0; bar.st = ctl;
    if (hi - lo > 1) bar = xcd_barrier_post((unsigned*)(ws + WS_BAR), ctl);

#if (REP_PH >> 13) & 1
    if (hi - lo > 1) for (int xb_ = 0; xb_ < 20; ++xb_) xcd_barrier(bar);
#endif
    for (int ph = lo; ph < hi; ++ph) {
      const int phs_ = (ph == 0) ? 4 : ((ph == NPHASE - 1) ? 5 : ((ph - 1) & 3));
      const int nrep_ = (phs_ < 5 && phs_ != 3 && ((REP_PH >> phs_) & 1)) ? 2 : 1;
      for (int rep_ = 0; rep_ < nrep_; ++rep_) {
        Frame G = F0;
        asm volatile("" : "+s"(G.lds), "+s"(G.bid));
        G.tid = (G.wave << 6) | (int)__builtin_amdgcn_mbcnt_hi(~0u, __builtin_amdgcn_mbcnt_lo(~0u, 0u));
        asm volatile("" : "+v"(G.tid));
        G.lane = G.tid & 63; G.wave = __builtin_amdgcn_readfirstlane(G.tid >> 6);
        const Frame& F = G;
        if (ph == 0) { if (PHSEL & 1) p0_prologue(F); }
        else if (ph == NPHASE - 1) { if (PHSEL & 2) p5_final(F); }
        else {
            const int l = (ph - 1) >> 2, s = (ph - 1) & 3;
            if (s == 0) { if (PHSEL & 4) p1_inproj(F, l); }
            else if (s == 1) {
                const bool g256 = (gridDim.x == 256);
                if (g256 && F.bid < 64) {
                    if (l + 1 < DEPTH) prep_layer<true>(F, l + 1);
                    asm volatile("" : "+s"(G.lds)); asm volatile("" : "+v"(G.tid)); G.lane = G.tid & 63; G.wave = __builtin_amdgcn_readfirstlane(G.tid >> 6);
                    if (PHSEL & 8) p2_compress_item(F, l, F.bid);
                } else if (g256) {
                    LruPref PF; LruConst KC;
                    lru_consts(F, l, KC);
                    lru_prefetch(F, PF, F.bid - 64);
                    if (l + 1 < DEPTH) prep_layer<true>(F, l + 1);
#pragma unroll 1
                    for (int r3 = 0; r3 < 3; ++r3) {
                        const int k = (F.bid - 64) + 192 * r3;
                        asm volatile("" : "+s"(G.lds)); asm volatile("" : "+v"(G.tid)); G.lane = G.tid & 63; G.wave = __builtin_amdgcn_readfirstlane(G.tid >> 6);
                        if (k < 512) { if (PHSEL & 16) p2_lru_item(F, l, k, PF, k + 192 < 512 ? k + 192 : k, KC); }
                        else { if (PHSEL & 1) p2_ropek_item(F, k - 512); }
                    }
                } else {
                    if (l + 1 < DEPTH) prep_layer<true>(F, l + 1);
                    for (int r3 = 0; r3 < (640 + (int)gridDim.x - 1) / (int)gridDim.x; ++r3) {
                        const int k = F.bid + (int)gridDim.x * r3; if (k >= 640) break;
                        const int kind = k < 64 ? 0 : (k < 576 ? 1 : 2), idx = k < 64 ? k : (k < 576 ? k - 64 : k - 576);
                        asm volatile("" : "+s"(G.lds)); asm volatile("" : "+v"(G.tid)); G.lane = G.tid & 63; G.wave = __builtin_amdgcn_readfirstlane(G.tid >> 6);
                        if (kind == 0) p2_compress_item(F, l, idx);
                        else if (kind == 1) { LruPref PF; LruConst KC; lru_consts(F, l, KC); lru_prefetch(F, PF, idx); p2_lru_item(F, l, idx, PF, idx, KC); }
                        else p2_ropek_item(F, idx);
                    }
                }
            } else if (s == 2) {
                for (int it = F.bid; it < 256; it += gridDim.x) {
                    const int li_ = it < 64 ? ((it & 3) << 6) | (63 - 2 * (it >> 3) - ((it & 7) >> 2)) : (((it - 64) & 3) << 6) | ((it - 64) >> 2);
                    if (PHSEL & 1) p3_lru_item(F, li_);
#if (REP_PH >> 8) & 1
                    p3_lru_item(F, it);
#endif
                }
#if NSA_MODE == 0
                LAS float* wl = (LAS float*)(F.lds + LDS_WORK) + F.wave * 2048;
                for (int it = F.bid; it < 4096; it += gridDim.x) { const int task = it * NWAVE + F.wave; p3_nsa_task(F, l, task >> 1, task & 1, wl); }
#else
                for (int it = F.bid; it < 256; it += gridDim.x) {
                    const int bk = it & 7, qq = it >> 3;
#pragma unroll 1
                    for (int hf = 0; hf < (((REP_PH >> 9) & 1) ? 4 : 2); ++hf) {
                        const int qb = (hf & 1) ? 63 - qq : qq;
#if NSA_MODE == 2
                        { LAS float* wl = (LAS float*)(F.lds + LDS_WORK) + F.wave * 2048;
                          for (int k = 0; k < 8; ++k) { const int task = k * NWAVE + F.wave; p3_nsa_task(F, l, (bk >> 1) * S + qb * 64 + task, bk & 1, wl); }
                          __threadfence_block(); __syncthreads(); }
#endif
                        asm volatile("" : "+v"(G.tid)); G.lane = G.tid & 63; G.wave = __builtin_amdgcn_readfirstlane(G.tid >> 6);
                        if (PHSEL & 32) p3_nsa_unit(F, l, bk >> 1, bk & 1, qb);
                    }
                }
#endif
            } else { if (PHSEL & 64) p4_outproj(F, l); }
        }
        if (rep_ + 1 < nrep_) xcd_barrier(bar);
      }
        if (ph + 1 < hi) xcd_barrier(bar);
    }
}

extern "C" void kernel_launch(void* const* d_in, const int* in_sizes, int n_in, void* d_out, int out_size, void* d_ws, size_t ws_size, hipStream_t stream) {
    static int grid = 0;
    if (grid == 0) {
        if (n_in != 18 || out_size != T * D || ws_size < WS_END) { fprintf(stderr, "kernel_launch: unexpected shapes (n_in %d out %d ws %zu need %zu)\n", n_in, out_size, ws_size, (size_t)WS_END); grid = -1; return; }
        int dev = 0, cus = 0;
        if (hipGetDevice(&dev) != hipSuccess || hipDeviceGetAttribute(&cus, hipDeviceAttributeMultiprocessorCount, dev) != hipSuccess) { grid = -1; return; }
        if (hipFuncSetAttribute((const void*)mk_fwd, hipFuncAttributeMaxDynamicSharedMemorySize, LDS_BYTES) != hipSuccess) { fprintf(stderr, "kernel_launch: hipFuncSetAttribute failed\n"); grid = -1; return; }
        grid = cus;
    }
    if (grid < 0) return;
    (void)hipMemsetAsync((char*)d_ws + WS_BAR, 0, 16384, stream);
    Params p{};
    const float** pp = (const float**)&p;
    for (int i = 0; i < 18; ++i) pp[i] = (const float*)d_in[i];
    p.out = (float*)d_out; p.ws = (unsigned char*)d_ws;
#if MK_N_LAUNCHES == 1
    p.ph_lo = 0; p.ph_hi = NPHASE;
    hipLaunchKernelGGL(mk_fwd, dim3(grid), dim3(NTHR), LDS_BYTES, stream, p);
#else
    for (int ph = 0; ph < NPHASE; ++ph) { p.ph_lo = ph; p.ph_hi = ph + 1; hipLaunchKernelGGL(mk_fwd, dim3(grid), dim3(NTHR), LDS_BYTES, stream, p); }
#endif
}
```
